# Optimizing an MI355X kernel written in HIP

```python
import jax, jax.numpy as jnp
from jax import lax
import numpy as np

D_MODEL = 1024
BATCH = 8
SEQ = 2048
DEPTH = 2

CHUNK = 64
Q_BLOCK = 128
ROPE_THETA = 10000.0
LN_EPS = 1e-5
RMS_EPS = 1e-6
NEG = -1e30

A_HEADS = 8
A_NOPE = 64
A_ROPE = 32
A_VDIM = 64
A_Q_RANK = 384
A_KV_RANK = 256

B_HEADS = 8
B_KV_HEADS = 2
B_HDIM = 64
IDX_HEADS = 4
IDX_DIM = 64
TOPK_MAX = 256

C_HEADS = 8
C_KV_HEADS = 2
C_HDIM = 64
WINDOW = 128
WIN_CHUNKS = WINDOW // CHUNK

N_BRANCH = 3
BRANCH_WIDTH = 512

N_EXPERTS = 16
N_GROUPS = 4
EXPERTS_PER_GROUP = N_EXPERTS // N_GROUPS
TOP_K = 2
D_EXPERT = 512

ALPHA = (2.0 * DEPTH) ** 0.25
BETA = (8.0 * DEPTH) ** -0.25

SPLIT_SIZES = (
    A_Q_RANK, A_KV_RANK, A_ROPE,
    B_HEADS * B_HDIM, B_KV_HEADS * B_HDIM, B_KV_HEADS * B_HDIM,
    IDX_HEADS * IDX_DIM, IDX_DIM, IDX_HEADS,
    C_HEADS * C_HDIM, C_KV_HEADS * C_HDIM, C_KV_HEADS * C_HDIM,
    N_BRANCH * D_MODEL,
)
IN_COLS = sum(SPLIT_SIZES)

kernel_name = "hybrid_mla_dsa_swa_grouped_moe_deepnorm"


def layer_norm(x, g, b):
    xf = x.astype(jnp.float32)
    mu = jnp.mean(xf, axis=-1, keepdims=True)
    var = jnp.mean(jnp.square(xf - mu), axis=-1, keepdims=True)
    return ((xf - mu) * lax.rsqrt(var + LN_EPS) * g + b).astype(x.dtype)


def rms_norm(x, g):
    xf = x.astype(jnp.float32)
    return (xf * lax.rsqrt(jnp.mean(jnp.square(xf), axis=-1, keepdims=True) + RMS_EPS) * g).astype(x.dtype)


def rope(x, pos):
    half = x.shape[-1] // 2
    inv = ROPE_THETA ** (-jnp.arange(half, dtype=jnp.float32) / half)
    ang = pos.astype(jnp.float32)[:, None] * inv[None, :]
    cos = jnp.cos(ang)[:, None, :].astype(x.dtype)
    sin = jnp.sin(ang)[:, None, :].astype(x.dtype)
    x1, x2 = x[..., :half], x[..., half:]
    return jnp.concatenate([x1 * cos - x2 * sin, x2 * cos + x1 * sin], axis=-1)


def to_blocks(a):
    b, t = a.shape[:2]
    return jnp.moveaxis(a.reshape((b, t // Q_BLOCK, Q_BLOCK) + a.shape[2:]), 1, 0)


def from_blocks(a):
    nb, b, qb = a.shape[:3]
    return jnp.moveaxis(a, 0, 1).reshape((b, nb * qb) + a.shape[3:])


def mla_branch(q_lat, kv_lat, k_pe, q_ln_g, kv_ln_g, w_uq, w_ukv, pos):
    B, T, _ = q_lat.shape
    q = (rms_norm(q_lat, q_ln_g) @ w_uq).reshape(B, T, A_HEADS, A_NOPE + A_ROPE)
    q_nope, q_pe = q[..., :A_NOPE], rope(q[..., A_NOPE:], pos)
    kv = (rms_norm(kv_lat, kv_ln_g) @ w_ukv).reshape(B, T, A_HEADS, A_NOPE + A_VDIM)
    k_nope, v = kv[..., :A_NOPE], kv[..., A_NOPE:]
    k_pe = rope(k_pe[:, :, None, :], pos)[:, :, 0, :]
    scale = (A_NOPE + A_ROPE) ** -0.5
    key_chunk = jnp.arange(T) // CHUNK

    def block(args):
        qn, qp, qpos = args
        s = (jnp.einsum('bqhd,bshd->bhqs', qn, k_nope)
             + jnp.einsum('bqhd,bsd->bhqs', qp, k_pe)).astype(jnp.float32) * scale
        mask = key_chunk[None, :] <= (qpos // CHUNK)[:, None]
        p = jax.nn.softmax(jnp.where(mask, s, NEG), axis=-1).astype(v.dtype)
        return jnp.einsum('bhqs,bshd->bqhd', p, v)

    out = lax.map(block, (to_blocks(q_nope), to_blocks(q_pe), pos.reshape(-1, Q_BLOCK)))
    return from_blocks(out).reshape(B, T, A_HEADS * A_VDIM)


def dsa_branch(q, k, v, q_idx, k_idx, w_idx, pos):
    B, T, _ = q.shape
    rep = B_HEADS // B_KV_HEADS
    q = rope(q.reshape(B, T, B_HEADS, B_HDIM), pos)
    k = rope(k.reshape(B, T, B_KV_HEADS, B_HDIM), pos)
    v = v.reshape(B, T, B_KV_HEADS, B_HDIM)
    q_idx = rope(q_idx.reshape(B, T, IDX_HEADS, IDX_DIM), pos)
    k_idx = rope(k_idx[:, :, None, :], pos)[:, :, 0, :]
    w_idx = w_idx * (IDX_HEADS * IDX_DIM) ** -0.5
    n_sel = min(TOPK_MAX, T // 4)
    scale = B_HDIM ** -0.5
    key_chunk = jnp.arange(T) // CHUNK
    gather = jax.vmap(lambda a, i: a[i])

    def block(args):
        qb, qib, wb, qpos = args
        qchunk = qpos // CHUNK
        rel = jax.nn.relu(jnp.einsum('bqhd,bsd->bqhs', qib, k_idx).astype(jnp.float32))
        score = jnp.einsum('bqh,bqhs->bqs', wb.astype(jnp.float32), rel)
        score = jnp.where(key_chunk[None, None, :] <= qchunk[None, :, None], score, NEG)
        _, idx = lax.top_k(score, n_sel)
        ks, vs = gather(k, idx), gather(v, idx)
        valid = (idx // CHUNK) <= qchunk[None, :, None]
        qg = qb.reshape(B, Q_BLOCK, B_KV_HEADS, rep, B_HDIM)
        s = jnp.einsum('bqgrd,bqkgd->bgrqk', qg, ks).astype(jnp.float32) * scale
        s = jnp.where(valid[:, None, None], s, NEG)
        p = jax.nn.softmax(s, axis=-1).astype(vs.dtype)
        o = jnp.einsum('bgrqk,bqkgd->bqgrd', p, vs)
        return o.reshape(B, Q_BLOCK, B_HEADS * B_HDIM)

    out = lax.map(block, (to_blocks(q), to_blocks(q_idx), to_blocks(w_idx), pos.reshape(-1, Q_BLOCK)))
    return from_blocks(out)


def swa_branch(q, k, v, sinks, pos):
    B, T, _ = q.shape
    nC = T // CHUNK
    rep = C_HEADS // C_KV_HEADS
    q = rope(q.reshape(B, T, C_HEADS, C_HDIM), pos).reshape(B, nC, CHUNK, C_KV_HEADS, rep, C_HDIM)
    k = rope(k.reshape(B, T, C_KV_HEADS, C_HDIM), pos)
    v = v.reshape(B, T, C_KV_HEADS, C_HDIM)
    pad = WIN_CHUNKS * CHUNK
    band_len = (WIN_CHUNKS + 1) * CHUNK

    def band(a):
        ap = jnp.pad(a, ((0, 0), (pad, 0), (0, 0), (0, 0)))
        ap = ap.reshape(B, nC + WIN_CHUNKS, CHUNK, C_KV_HEADS, C_HDIM)
        return jnp.concatenate([ap[:, j:j + nC] for j in range(WIN_CHUNKS + 1)], axis=2)

    kb, vb = band(k), band(v)
    key_pos = jnp.arange(nC)[:, None] * CHUNK - pad + jnp.arange(band_len)[None, :]
    valid = (key_pos >= 0)[:, None, :]
    s = jnp.einsum('bcqgrd,bckgd->bgrcqk', q, kb).astype(jnp.float32) * C_HDIM ** -0.5
    s = jnp.where(valid, s, NEG)
    sink = jnp.broadcast_to(sinks.astype(jnp.float32).reshape(C_KV_HEADS, rep, 1, 1, 1), s.shape[:-1] + (1,))
    p = jax.nn.softmax(jnp.concatenate([s, sink], axis=-1), axis=-1)[..., :-1].astype(vb.dtype)
    o = jnp.einsum('bgrcqk,bckgd->bcqgrd', p, vb)
    return o.reshape(B, T, C_HEADS * C_HDIM)


def mixer(h, w_in, a_q_ln_g, a_kv_ln_g, a_w_uq, a_w_ukv, c_sinks, w_br_a, w_br_b, w_br_c, w_out, pos):
    B, T, D = h.shape
    points = [int(p) for p in np.cumsum(SPLIT_SIZES)[:-1]]
    (a_q, a_kv, a_kpe, b_q, b_k, b_v, b_qi, b_ki, b_wi,
     c_q, c_k, c_v, gates) = jnp.split(h @ w_in, points, axis=-1)
    y_a = mla_branch(a_q, a_kv, a_kpe, a_q_ln_g, a_kv_ln_g, a_w_uq, a_w_ukv, pos) @ w_br_a
    y_b = dsa_branch(b_q, b_k, b_v, b_qi, b_ki, b_wi, pos) @ w_br_b
    y_c = swa_branch(c_q, c_k, c_v, c_sinks, pos) @ w_br_c
    g = jax.nn.sigmoid(gates).reshape(B, T, N_BRANCH, D)
    merged = g[:, :, 0] * y_a + g[:, :, 1] * y_b + g[:, :, 2] * y_c
    return merged @ w_out


def moe(h, w_router, router_bias, w_gate, w_up, w_down):
    B, T, D = h.shape
    hf = h.reshape(B * T, D)
    scores = jax.nn.sigmoid((hf @ w_router).astype(jnp.float32))
    biased = scores + router_bias.astype(jnp.float32)
    grp = biased.reshape(-1, N_GROUPS, EXPERTS_PER_GROUP)
    group_score = lax.top_k(grp, TOP_K)[0].sum(-1)
    g_sel = jnp.argmax(group_score, axis=-1)
    in_group = (jnp.arange(N_EXPERTS) // EXPERTS_PER_GROUP)[None, :] == g_sel[:, None]
    _, top_idx = lax.top_k(jnp.where(in_group, biased, NEG), TOP_K)
    w = jnp.take_along_axis(scores, top_idx, axis=-1)
    w = w / jnp.sum(w, axis=-1, keepdims=True)
    gate = jnp.sum(jax.nn.one_hot(top_idx, N_EXPERTS, dtype=jnp.float32) * w[..., None], axis=1)
    act = jax.nn.silu(jnp.einsum('nd,edf->nef', hf, w_gate)) * jnp.einsum('nd,edf->nef', hf, w_up)
    act = act * gate.astype(act.dtype)[:, :, None]
    return jnp.einsum('nef,efd->nd', act, w_down).reshape(B, T, D)


def setup_inputs(seed: int = 0) -> dict:
    key = jax.random.key(seed)
    ks = jax.random.split(key, 24)
    f32 = jnp.float32
    L, D = DEPTH, D_MODEL

    def nrm(k, shape, fan_in, scale=1.0):
        return jax.random.normal(k, shape, f32) * (scale * fan_in ** -0.5)

    def gain(k, shape):
        return 1.0 + 0.05 * jax.random.normal(k, shape, f32)

    return {
        "x": jax.random.normal(ks[0], (BATCH, SEQ, D), f32),
        "ln_in_g": gain(ks[1], (D,)),
        "ln_in_b": 0.02 * jax.random.normal(ks[2], (D,), f32),
        "w_in": nrm(ks[3], (L, D, IN_COLS), D),
        "a_q_ln_g": gain(ks[4], (L, A_Q_RANK)),
        "a_kv_ln_g": gain(ks[5], (L, A_KV_RANK)),
        "a_w_uq": nrm(ks[6], (L, A_Q_RANK, A_HEADS * (A_NOPE + A_ROPE)), A_Q_RANK),
        "a_w_ukv": nrm(ks[7], (L, A_KV_RANK, A_HEADS * (A_NOPE + A_VDIM)), A_KV_RANK),
        "c_sinks": 0.5 * jax.random.normal(ks[8], (L, C_HEADS), f32),
        "w_br_a": nrm(ks[9], (L, A_HEADS * A_VDIM, D), A_HEADS * A_VDIM),
        "w_br_b": nrm(ks[10], (L, B_HEADS * B_HDIM, D), B_HEADS * B_HDIM),
        "w_br_c": nrm(ks[11], (L, C_HEADS * C_HDIM, D), C_HEADS * C_HDIM),
        "w_out": nrm(ks[12], (L, D, D), D, BETA),
        "ln1_g": gain(ks[13], (L, D)),
        "ln1_b": 0.02 * jax.random.normal(ks[14], (L, D), f32),
        "w_router": nrm(ks[15], (D, N_EXPERTS), D),
        "router_bias": 0.01 * jax.random.normal(ks[16], (N_EXPERTS,), f32),
        "w_exp_gate": nrm(ks[17], (L, N_EXPERTS, D, D_EXPERT), D),
        "w_exp_up": nrm(ks[18], (L, N_EXPERTS, D, D_EXPERT), D),
        "w_exp_down": nrm(ks[19], (L, N_EXPERTS, D_EXPERT, D), D_EXPERT, BETA),
        "ln2_g": gain(ks[20], (L, D)),
        "ln2_b": 0.02 * jax.random.normal(ks[21], (L, D), f32),
    }


def reference(x, ln_in_g, ln_in_b, w_in, a_q_ln_g, a_kv_ln_g, a_w_uq, a_w_ukv, c_sinks,
              w_br_a, w_br_b, w_br_c, w_out, ln1_g, ln1_b, w_router, router_bias,
              w_exp_gate, w_exp_up, w_exp_down, ln2_g, ln2_b):
    pos = jnp.arange(x.shape[1], dtype=jnp.int32)
    x = layer_norm(x, ln_in_g, ln_in_b)
    for l in range(DEPTH):
        mix = mixer(x, w_in[l], a_q_ln_g[l], a_kv_ln_g[l], a_w_uq[l], a_w_ukv[l], c_sinks[l],
                    w_br_a[l], w_br_b[l], w_br_c[l], w_out[l], pos)
        x = layer_norm(ALPHA * x + mix, ln1_g[l], ln1_b[l])
        ffn = moe(x, w_router, router_bias, w_exp_gate[l], w_exp_up[l], w_exp_down[l])
        x = layer_norm(ALPHA * x + ffn, ln2_g[l], ln2_b[l])
    return x
```

```cpp
#include <hip/hip_runtime.h>
#include <hip/hip_cooperative_groups.h>
#include <cstdio>
#include <cstdint>
namespace cg = cooperative_groups;

#define LAS __attribute__((address_space(3)))
typedef unsigned short bf16_t;
typedef short bf16x8 __attribute__((ext_vector_type(8)));
typedef short s16x4 __attribute__((ext_vector_type(4)));
typedef float f32x2 __attribute__((ext_vector_type(2)));
typedef float f32x4 __attribute__((ext_vector_type(4)));
typedef float f32x16 __attribute__((ext_vector_type(16)));
typedef unsigned u32x2 __attribute__((ext_vector_type(2)));
typedef unsigned u32x4 __attribute__((ext_vector_type(4)));
typedef __bf16 bf2_t __attribute__((ext_vector_type(2)));
typedef unsigned long long u64;

constexpr int NT = 16384, SEQ = 2048, NB = 8, DM = 1024, INC = 5604, DEPTH = 2;
constexpr int NEXP = 16, DEXP = 512;
constexpr float ALPHA = 1.4142135623730951f;
constexpr float LN_EPS = 1e-5f, RMS_EPS = 1e-6f;
constexpr float LOG2E = 1.4426950408889634f;
constexpr float QS64 = 0.125f * LOG2E;
constexpr float QS96 = 0.10206207261596575f * LOG2E;
constexpr float SSQ_SCALE = 16777216.0f;
constexpr int XS_ROWS = 36864;

constexpr size_t al256(size_t x) { return (x + 255) & ~(size_t)255; }
constexpr size_t WS_CNT   = 0;
constexpr size_t WS_WGCNT = 1024;
constexpr size_t WS_BAR   = 17408;
constexpr size_t WS_PCNT  = 32768;
constexpr size_t WS_HRDY  = 65536;
constexpr size_t WS_CVQ   = 139264;
constexpr size_t WS_SSQ   = 147456;
constexpr size_t WS_CS64  = WS_SSQ + (size_t)DEPTH * 2 * NT * 8;
constexpr size_t WS_CS32  = WS_CS64 + (size_t)SEQ * 32 * 8;
constexpr size_t WS_ROUTE = WS_CS32 + (size_t)SEQ * 16 * 8;
constexpr size_t WS_ROWTOK = WS_ROUTE + (size_t)NT * 24;
constexpr size_t WS_ROWW  = WS_ROWTOK + (size_t)XS_ROWS * 4;
constexpr size_t WS_XBUF  = al256(WS_ROWW + (size_t)XS_ROWS * 4);
constexpr size_t WS_WB    = al256(WS_XBUF + (size_t)NT * 4 * 8);
constexpr size_t WB_W1   = WS_WB;
constexpr size_t WB_WG   = WB_W1 + (size_t)2816 * 1024 * 2;
constexpr size_t WB_WUQ  = WB_WG + (size_t)3072 * 1024 * 2;
constexpr size_t WB_WUKV = WB_WUQ + (size_t)768 * 384 * 2;
constexpr size_t WB_WBR  = WB_WUKV + (size_t)1024 * 256 * 2;
constexpr size_t WB_WOUT = WB_WBR + (size_t)3 * 1024 * 512 * 2;
constexpr size_t WB_WGU  = WB_WOUT + (size_t)1024 * 1024 * 2;
constexpr size_t WB_WDN  = WB_WGU + (size_t)16 * 1024 * 1024 * 2;
constexpr size_t WS_XB   = WB_WDN + (size_t)16 * 1024 * 512 * 2;
constexpr size_t WS_OABC = WS_XB + (size_t)NT * 1024 * 2;
constexpr size_t WS_R    = WS_OABC + (size_t)3 * NT * 512 * 2;
constexpr size_t R_QLAT  = WS_R;
constexpr size_t R_KVLAT = R_QLAT + (size_t)NT * 384 * 2;
constexpr size_t R_KPE   = R_KVLAT + (size_t)NT * 256 * 2;
constexpr size_t R_BQ    = R_KPE + (size_t)NT * 32 * 2;
constexpr size_t R_BK    = R_BQ + (size_t)NT * 512 * 2;
constexpr size_t R_BVT   = R_BK + (size_t)NT * 128 * 2;
constexpr size_t R_BQI   = R_BVT + (size_t)NT * 128 * 2;
constexpr size_t R_BKI   = R_BQI + (size_t)NT * 256 * 2;
constexpr size_t R_WIDX  = R_BKI + (size_t)NT * 64 * 2;
constexpr size_t R_CQ    = R_WIDX + (size_t)NT * 4 * 4;
constexpr size_t R_CK    = R_CQ + (size_t)NT * 512 * 2;
constexpr size_t R_CVT   = R_CK + (size_t)NT * 128 * 2;
constexpr size_t R_AQ    = R_CVT + (size_t)NT * 128 * 2;
constexpr size_t R_AKN   = R_AQ + (size_t)NT * 768 * 2;
constexpr size_t R_AVT   = R_AKN + (size_t)NT * 512 * 2;
constexpr size_t R_MASK  = R_AVT + (size_t)NT * 512 * 2;
constexpr size_t R_BV    = R_MASK + (size_t)NT * 64 * 4;
constexpr size_t R_CV    = R_BV + (size_t)NT * 128 * 2;
constexpr size_t R_AV    = R_CV + (size_t)NT * 128 * 2;
constexpr size_t R_XB8   = R_BV;
constexpr size_t R_END1  = R_AV + (size_t)NT * 512 * 2;
constexpr size_t R_GATES = WS_R;
constexpr size_t R_MERGED = R_GATES + (size_t)NT * 3072 * 2;
constexpr size_t R_END2  = R_MERGED + (size_t)NT * 1024 * 2;
constexpr size_t R_Y2    = WS_R;
constexpr size_t R_END3  = R_Y2 + (size_t)NT * 2 * 1024 * 2;
constexpr size_t WS_H    = WS_OABC;
constexpr size_t cmax(size_t a, size_t b) { return a > b ? a : b; }
constexpr size_t WS_END  = cmax(R_END1, cmax(R_END2, R_END3));
static_assert((size_t)XS_ROWS * 512 * 2 <= (size_t)3 * NT * 512 * 2, "H fits in OABC");
static_assert(WS_END <= (size_t)332 * 1024 * 1024, "workspace budget");
static_assert(R_XB8 >= R_END2 && R_XB8 >= R_END3 && R_XB8 + (size_t)NT * 1024 <= R_END1, "fp8 x copy placement");

constexpr int LDS_BYTES = 147456;
constexpr int LDS_MISC = 147456 - 64;

struct Params {
    const float* x; const float* ln_in_g; const float* ln_in_b; const float* w_in; const float* a_q_ln_g; const float* a_kv_ln_g;
    const float* a_w_uq; const float* a_w_ukv; const float* c_sinks; const float* w_br_a; const float* w_br_b; const float* w_br_c; const float* w_out;
    const float* ln1_g; const float* ln1_b; const float* w_router; const float* router_bias; const float* w_exp_gate; const float* w_exp_up; const float* w_exp_down;
    const float* ln2_g; const float* ln2_b;
    float* out; unsigned char* ws;
};

typedef const __attribute__((address_space(4))) Params* KernArgP;
__device__ __forceinline__ unsigned pk2(float lo, float hi) { f32x2 v = {lo, hi}; return __builtin_bit_cast(unsigned, __builtin_convertvector(v, bf2_t)); }
__device__ __forceinline__ float bf_lo(unsigned w) { return __uint_as_float(w << 16); }
__device__ __forceinline__ float bf_hi(unsigned w) { return __uint_as_float(w & 0xffff0000u); }
__device__ __forceinline__ float shx(float v, int mask, int lane) { return __int_as_float(__builtin_amdgcn_ds_bpermute((lane ^ mask) << 2, __float_as_int(v))); }
__device__ __forceinline__ unsigned shxu(unsigned v, int mask, int lane) { return (unsigned)__builtin_amdgcn_ds_bpermute((lane ^ mask) << 2, (int)v); }
__device__ __forceinline__ float wave_sum(float v, int lane) {
#pragma unroll
    for (int o = 1; o < 64; o <<= 1) v += shx(v, o, lane);
    return v;
}
template <class T> __device__ __forceinline__ T* uniform_ptr(T* p) {
    const unsigned long long v = (unsigned long long)p; const unsigned lo = __builtin_amdgcn_readfirstlane((unsigned)v), hi = __builtin_amdgcn_readfirstlane((unsigned)(v >> 32));
    return (T*)(((unsigned long long)hi << 32) | lo); }
__device__ __forceinline__ int f8x4(float a, float b, float c, float d) {
    a = __builtin_amdgcn_fmed3f(a, -440.0f, 440.0f); b = __builtin_amdgcn_fmed3f(b, -440.0f, 440.0f); c = __builtin_amdgcn_fmed3f(c, -440.0f, 440.0f); d = __builtin_amdgcn_fmed3f(d, -440.0f, 440.0f);
    int p = 0; p = __builtin_amdgcn_cvt_pk_fp8_f32(a, b, p, false); p = __builtin_amdgcn_cvt_pk_fp8_f32(c, d, p, true); return p; }
__device__ __forceinline__ float fast_sigmoid(float v) { return __builtin_amdgcn_rcpf(1.0f + __builtin_amdgcn_exp2f(-v * LOG2E)); }
namespace pg8 {
#define PG8_LAS __attribute__((address_space(3)))
constexpr int BM = 256, BK = 64, HALF = 128, HTB = HALF * BK * 2, STAGE_BYTES = 8 * HTB, NXCD = 8, WGM = 8;
__host__ __device__ __forceinline__ int lds_byte(int r, int c) { const int st = (r >> 4) * 2 + (c >> 5), rr = r & 15, cc = c & 31, ob = rr * 64 + cc * 2; return st * 1024 + (ob ^ (((ob >> 9) & 1) << 5)); }
__host__ __device__ __forceinline__ void stage_rc(int b, int& R, int& C) { const int st = b / 1024, sb = b % 1024, swz = sb ^ (((sb >> 9) & 1) << 5); R = (st >> 1) * 16 + swz / 64; C = (st & 1) * 32 + (swz % 64) / 2; }
__host__ __device__ __forceinline__ int perm32(int rho) { const int n = rho >> 4, i = rho & 15; return 8 * (i >> 2) + 4 * n + (i & 3); }
struct Unit { int pm, pn; };
struct Gemm { const bf16_t* A; const bf16_t* Bt; int K; const int* rowmap; };
struct StaticOrder {
    int nM, nN, nwg, G, c;
    __device__ void init(int M, int N, int G_, int c_) { nM = M / BM; nN = N / BM; nwg = nM * nN; G = G_; c = c_; }
    __device__ bool next(int i, Unit& u) const {
        const long L = (long)i * G + c; if (L >= nwg) return false;
        int wgid = (int)L; { const int q = nwg / NXCD, r = nwg % NXCD, xcd = wgid % NXCD, off = wgid / NXCD; wgid = (xcd < r ? xcd * (q + 1) : r * (q + 1) + (xcd - r) * q) + off; }
        const int nig = WGM * nN, gid = wgid / nig, fm = gid * WGM, gsz = (nM - fm) < WGM ? (nM - fm) : WGM;
        u.pm = fm + ((wgid % nig) % gsz); u.pn = (wgid % nig) / gsz; return true;
    }
    __device__ __forceinline__ void a_ready(const Unit&, int) const {}
    __device__ __forceinline__ void done(const Unit&, int) const {}
};
template <class Epi, class Sched, bool ALIGN_EPI, bool SP2, bool GATHER = false, bool F8 = false>
__device__ __forceinline__ void gemm_phase(PG8_LAS unsigned char* lds, const Gemm g, const Sched& S, const Epi& E, const int tid) {
    const int wid = __builtin_amdgcn_readfirstlane(tid >> 6), lane = tid & 63, wr = wid >> 2, wc = wid & 3, fr = lane & 15, fq = lane >> 4;
    const int K = g.K, nt = K / BK;
    unsigned voffA[2], voffB[2];
#pragma unroll
    for (int i = 0; i < 2; ++i) { int R, C; stage_rc(tid * 16 + i * 8192, R, C); const int Rb = (R & ~31) + perm32(R & 31);
        voffA[i] = (unsigned)(R * K + C) * 2u; voffB[i] = (unsigned)(Rb * K + C) * 2u; }
    unsigned cOff[2][2];
    PG8_LAS u32x4* nslot = (PG8_LAS u32x4*)(lds + STAGE_BYTES) + tid;
#define PG8_GOFF(U, OFF) do { const int* rm_ = g.rowmap + (U).pm * 256; _Pragma("unroll") for (int _h = 0; _h < 2; ++_h) _Pragma("unroll") for (int _i = 0; _i < 2; ++_i) { int R_, C_; stage_rc(tid * 16 + _i * 8192, R_, C_); \
        const int tk_ = rm_[128 * _h + R_]; const int tok_ = tk_ < 0 ? 0 : (tk_ >> 1); OFF[_h][_i] = (unsigned)(tok_ * K + C_) * 2u; } } while (0)
    const size_t kstep = (size_t)(BK * 2);
    const size_t hstep = (size_t)HALF * K * 2;
    const size_t tstep = 2 * hstep;
    const unsigned ldsw = (unsigned)wid * 1024u;
    const int aoff = lds_byte(wr * 64 + fr, fq * 8), boff = lds_byte(wc * 32 + fr, fq * 8);
#define PG8_SA(b, h) (((b) * 2 + (h)) * HTB)
#define PG8_SB(b, h) ((4 + (b) * 2 + (h)) * HTB)
#define PG8_STAGE(bufoff, gbase, voff) do { _Pragma("unroll") for (int _i = 0; _i < 2; ++_i) { unsigned vo_ = (voff)[_i]; if (F8) asm volatile("" : "+v"(vo_));     \
        __builtin_amdgcn_global_load_lds((const unsigned*)((F8 ? uniform_ptr((const char*)(gbase)) : (const char*)(gbase)) + vo_), (PG8_LAS unsigned*)(lds + (bufoff) + ldsw + _i * 8192), 16, 0, 0); } } while (0)
#define PG8_LD8(p) __builtin_shufflevector(*(const PG8_LAS v4i32*)(p), *(const PG8_LAS v4i32*)((p) + 1024), 0, 1, 2, 3, 4, 5, 6, 7)
#define PG8_LDA(dst, b, h) do { if constexpr (F8) { _Pragma("unroll") for (int m = 0; m < 4; ++m) dst##8[m] = PG8_LD8(lds + PG8_SA(b, h) + aoff + m * 2048); } \
        else { _Pragma("unroll") for (int m = 0; m < 4; ++m) _Pragma("unroll") for (int k = 0; k < 2; ++k) dst[m][k] = *(const PG8_LAS bf16x8*)(lds + PG8_SA(b, h) + aoff + m * 2048 + k * 1024); } } while (0)
#define PG8_LDB(dst, b, h) do { if constexpr (F8) { _Pragma("unroll") for (int n = 0; n < 2; ++n) dst##8[n] = PG8_LD8(lds + PG8_SB(b, h) + boff + n * 2048); } \
        else { _Pragma("unroll") for (int n = 0; n < 2; ++n) _Pragma("unroll") for (int k = 0; k < 2; ++k) dst[n][k] = *(const PG8_LAS bf16x8*)(lds + PG8_SB(b, h) + boff + n * 2048 + k * 1024); } } while (0)
#define PG8_MMA(ai, bj, At, Bt) do { __builtin_amdgcn_s_setprio(1); _Pragma("unroll") for (int m = 0; m < 4; ++m) _Pragma("unroll") for (int n = 0; n < 2; ++n) { \
        if constexpr (F8) acc[ai][bj][m][n] = __builtin_amdgcn_mfma_scale_f32_16x16x128_f8f6f4(Bt##8[n], At##8[m], acc[ai][bj][m][n], 0, 0, 0, 0x7F7F7F7F, 0, 0x7F7F7F7F); \
        else { _Pragma("unroll") for (int k = 0; k < 2; ++k) acc[ai][bj][m][n] = __builtin_amdgcn_mfma_f32_16x16x32_bf16(Bt[n][k], At[m][k], acc[ai][bj][m][n], 0, 0, 0); } } \
        __builtin_amdgcn_s_setprio(0); } while (0)
#define PG8_WAIT_V(n) asm volatile("s_waitcnt vmcnt(" #n ")" ::: "memory")
#define PG8_WAIT_L(n) asm volatile("s_waitcnt lgkmcnt(" #n ")" ::: "memory")
#define PG8_BAR __builtin_amdgcn_s_barrier()
#define PG8_SCHED __builtin_amdgcn_sched_barrier(0)
    Unit cur, nxt; int ui = 0;
    if (!S.next(0, cur)) return;
    if constexpr (F8) { cur.pm = __builtin_amdgcn_readfirstlane(cur.pm); cur.pn = __builtin_amdgcn_readfirstlane(cur.pn); }
    S.a_ready(cur, tid);
    f32x4 acc[2][2][4][2];
#pragma unroll
    for (int a = 0; a < 2; ++a)
#pragma unroll
        for (int b = 0; b < 2; ++b)
#pragma unroll
            for (int m = 0; m < 4; ++m)
#pragma unroll
                for (int n = 0; n < 2; ++n) acc[a][b][m][n] = (f32x4){0.f, 0.f, 0.f, 0.f};
    typedef int v8i32 __attribute__((ext_vector_type(8))); typedef int v4i32 __attribute__((ext_vector_type(4)));
    bf16x8 At[4][2], B0[2][2], B1[2][2]; v8i32 At8[4], B08[2], B18[2];
    const char* cA = GATHER ? (const char*)g.A : (const char*)g.A + (size_t)cur.pm * tstep; const char* cB = (const char*)g.Bt + (size_t)cur.pn * tstep;
    if constexpr (GATHER) { PG8_GOFF(cur, cOff); asm volatile("s_waitcnt vmcnt(0)" ::: "memory"); }
    if constexpr (SP2) {
        PG8_STAGE(PG8_SB(0, 0), cB, voffB); PG8_STAGE(PG8_SB(0, 1), cB + hstep, voffB);
        if constexpr (GATHER) { PG8_STAGE(PG8_SA(0, 0), cA, cOff[0]); PG8_STAGE(PG8_SA(0, 1), cA, cOff[1]); } else { PG8_STAGE(PG8_SA(0, 0), cA, voffA); PG8_STAGE(PG8_SA(0, 1), cA + hstep, voffA); }
        if (wr == 1) PG8_BAR;
        PG8_WAIT_V(2); PG8_BAR;
        PG8_STAGE(PG8_SB(1, 0), cB + kstep, voffB); if constexpr (GATHER) PG8_STAGE(PG8_SA(1, 0), cA + kstep, cOff[0]); else PG8_STAGE(PG8_SA(1, 0), cA + kstep, voffA); PG8_STAGE(PG8_SB(1, 1), cB + hstep + kstep, voffB);
        PG8_WAIT_V(6); PG8_BAR;
    } else {
        PG8_STAGE(PG8_SB(0, 0), cB, voffB); PG8_STAGE(PG8_SA(0, 0), cA, voffA); PG8_STAGE(PG8_SB(0, 1), cB + hstep, voffB); PG8_STAGE(PG8_SA(0, 1), cA + hstep, voffA);
        if (wr == 1) PG8_BAR;
        PG8_WAIT_V(4); PG8_BAR;
        PG8_STAGE(PG8_SB(1, 0), cB + kstep, voffB); PG8_STAGE(PG8_SA(1, 0), cA + kstep, voffA); PG8_STAGE(PG8_SB(1, 1), cB + hstep + kstep, voffB);
        PG8_WAIT_V(6); PG8_BAR;
    }
    for (;;) {
        const bool has_next = S.next(ui + 1, nxt);
        if constexpr (F8) { nxt.pm = __builtin_amdgcn_readfirstlane(nxt.pm); nxt.pn = __builtin_amdgcn_readfirstlane(nxt.pn); }
        const char* nA = GATHER ? cA : (has_next ? (const char*)g.A + (size_t)nxt.pm * tstep : cA); const char* nB = has_next ? (const char*)g.Bt + (size_t)nxt.pn * tstep : cB;
        if constexpr (GATHER) { unsigned t_[2][2]; if (has_next) PG8_GOFF(nxt, t_); else { _Pragma("unroll") for (int _h = 0; _h < 2; ++_h) _Pragma("unroll") for (int _i = 0; _i < 2; ++_i) t_[_h][_i] = cOff[_h][_i]; }
            u32x4 pk_; pk_.x = t_[0][0]; pk_.y = t_[0][1]; pk_.z = t_[1][0]; pk_.w = t_[1][1]; *nslot = pk_; }
#pragma unroll 1
        for (int t = 0; t < nt; t += 2) {
            const bool last = (t == nt - 2);
            const char* a1 = cA + (size_t)(t + 1) * kstep;
            const char* a2 = last ? nA : cA + (size_t)(t + 2) * kstep; const char* b2 = last ? nB : cB + (size_t)(t + 2) * kstep;
            const char* a3 = a2 + kstep; const char* b3 = b2 + kstep;
            if (last && has_next) S.a_ready(nxt, tid);
            if constexpr (SP2 && GATHER) {
#define PG8_STAGE_SEL(bufoff, gbase, H) PG8_STAGE(bufoff, gbase, cOff[H])
            const char* g2 = last ? cA : cA + (size_t)(t + 2) * kstep; const char* g3 = g2 + kstep;
            PG8_LDB(B0, 0, 0); PG8_LDB(B1, 0, 1); PG8_SCHED; PG8_LDA(At, 0, 0); PG8_STAGE(PG8_SA(1, 1), a1, cOff[1]);
            if (last) { const u32x4 nf_ = *nslot; cOff[0][0] = nf_.x; cOff[0][1] = nf_.y; cOff[1][0] = nf_.z; cOff[1][1] = nf_.w; }
            PG8_WAIT_V(8); PG8_WAIT_L(0); PG8_BAR; PG8_MMA(0, 0, At, B0); PG8_MMA(0, 1, At, B1); PG8_BAR; PG8_SCHED;
            PG8_LDA(At, 0, 1); PG8_STAGE(PG8_SB(0, 0), b2, voffB); PG8_STAGE(PG8_SB(0, 1), b2 + hstep, voffB); PG8_STAGE_SEL(PG8_SA(0, 0), g2, 0);
            PG8_WAIT_V(8); PG8_WAIT_L(0); PG8_BAR; PG8_MMA(1, 0, At, B0); PG8_MMA(1, 1, At, B1); PG8_BAR; PG8_SCHED;
            PG8_LDB(B0, 1, 0); PG8_LDB(B1, 1, 1); PG8_SCHED; PG8_LDA(At, 1, 0); PG8_STAGE_SEL(PG8_SA(0, 1), g2, 1);
            PG8_WAIT_V(8); PG8_WAIT_L(0); PG8_BAR; PG8_MMA(0, 0, At, B0); PG8_MMA(0, 1, At, B1); PG8_BAR; PG8_SCHED;
            PG8_LDA(At, 1, 1); PG8_STAGE(PG8_SB(1, 0), b3, voffB); PG8_STAGE(PG8_SB(1, 1), b3 + hstep, voffB); PG8_STAGE_SEL(PG8_SA(1, 0), g3, 0);
            PG8_WAIT_V(8); PG8_WAIT_L(0); PG8_BAR; PG8_MMA(1, 0, At, B0); PG8_MMA(1, 1, At, B1); PG8_BAR; PG8_SCHED;
            } else             if constexpr (SP2) {
            PG8_LDB(B0, 0, 0); PG8_LDB(B1, 0, 1); PG8_SCHED; PG8_LDA(At, 0, 0); PG8_STAGE(PG8_SA(1, 1), a1 + hstep, voffA);
            PG8_WAIT_V(8); PG8_WAIT_L(0); PG8_BAR; PG8_MMA(0, 0, At, B0); PG8_MMA(0, 1, At, B1); PG8_BAR; PG8_SCHED;
            PG8_LDA(At, 0, 1); PG8_STAGE(PG8_SB(0, 0), b2, voffB); PG8_STAGE(PG8_SB(0, 1), b2 + hstep, voffB); PG8_STAGE(PG8_SA(0, 0), a2, voffA);
            PG8_WAIT_V(8); PG8_WAIT_L(0); PG8_BAR; PG8_MMA(1, 0, At, B0); PG8_MMA(1, 1, At, B1); PG8_BAR; PG8_SCHED;
            PG8_LDB(B0, 1, 0); PG8_LDB(B1, 1, 1); PG8_SCHED; PG8_LDA(At, 1, 0); PG8_STAGE(PG8_SA(0, 1), a2 + hstep, voffA);
            PG8_WAIT_V(8); PG8_WAIT_L(0); PG8_BAR; PG8_MMA(0, 0, At, B0); PG8_MMA(0, 1, At, B1); PG8_BAR; PG8_SCHED;
            PG8_LDA(At, 1, 1); PG8_STAGE(PG8_SB(1, 0), b3, voffB); PG8_STAGE(PG8_SB(1, 1), b3 + hstep, voffB); PG8_STAGE(PG8_SA(1, 0), a3, voffA);
            PG8_WAIT_V(8); PG8_WAIT_L(0); PG8_BAR; PG8_MMA(1, 0, At, B0); PG8_MMA(1, 1, At, B1); PG8_BAR; PG8_SCHED;
            } else {
            PG8_LDB(B0, 0, 0); PG8_SCHED; PG8_LDA(At, 0, 0); PG8_STAGE(PG8_SA(1, 1), a1 + hstep, voffA);
            PG8_WAIT_L(8); PG8_BAR; PG8_WAIT_L(0); PG8_MMA(0, 0, At, B0); PG8_BAR; PG8_SCHED;
            PG8_LDB(B1, 0, 1); PG8_STAGE(PG8_SB(0, 0), b2, voffB);
            PG8_BAR; PG8_WAIT_L(0); PG8_MMA(0, 1, At, B1); PG8_BAR;
            PG8_LDA(At, 0, 1); PG8_STAGE(PG8_SA(0, 0), a2, voffA);
            PG8_BAR; PG8_WAIT_L(0); PG8_MMA(1, 0, At, B0); PG8_BAR; PG8_SCHED;
            PG8_STAGE(PG8_SB(0, 1), b2 + hstep, voffB);
            PG8_WAIT_V(6); PG8_BAR; PG8_MMA(1, 1, At, B1); PG8_BAR;
            PG8_LDB(B0, 1, 0); PG8_SCHED; PG8_LDA(At, 1, 0); PG8_STAGE(PG8_SA(0, 1), a2 + hstep, voffA);
            PG8_WAIT_L(8); PG8_BAR; PG8_WAIT_L(0); PG8_MMA(0, 0, At, B0); PG8_BAR; PG8_SCHED;
            PG8_LDB(B1, 1, 1); PG8_STAGE(PG8_SB(1, 0), b3, voffB);
            PG8_BAR; PG8_WAIT_L(0); PG8_MMA(0, 1, At, B1); PG8_BAR;
            PG8_LDA(At, 1, 1); PG8_STAGE(PG8_SA(1, 0), a3, voffA);
            PG8_BAR; PG8_WAIT_L(0); PG8_MMA(1, 0, At, B0); PG8_BAR; PG8_SCHED;
            PG8_STAGE(PG8_SB(1, 1), b3 + hstep, voffB);
            PG8_WAIT_V(6); PG8_BAR; PG8_MMA(1, 1, At, B1); PG8_BAR;
            }
        }
        if constexpr (ALIGN_EPI) { if (wr == 0) PG8_BAR; }
        bool keep = false;
        if constexpr (!Epi::AFTER_DRAIN) { keep = E(acc, cur, wr, wc, fr, fq); S.done(cur, tid); }
        if (!has_next) break;
        if (!keep) {
#pragma unroll
        for (int a = 0; a < 2; ++a)
#pragma unroll
            for (int b = 0; b < 2; ++b)
#pragma unroll
                for (int m = 0; m < 4; ++m)
#pragma unroll
                    for (int n = 0; n < 2; ++n) acc[a][b][m][n] = (f32x4){0.f, 0.f, 0.f, 0.f};
        }
        cur = nxt; cA = nA; cB = nB; ++ui;
        if constexpr (ALIGN_EPI) { if (wr == 1) PG8_BAR; }
    }
    PG8_WAIT_V(0);
    if constexpr (!ALIGN_EPI) { if (wr == 0) PG8_BAR; }
    PG8_BAR;
    if constexpr (Epi::AFTER_DRAIN) E.fused(acc, cur, wr, wc, fr, fq, lds, wid, lane);
#undef PG8_GOFF
#undef PG8_STAGE_SEL
#undef PG8_SA
#undef PG8_SB
#undef PG8_STAGE
#undef PG8_LDA
#undef PG8_LD8
#undef PG8_LDB
#undef PG8_MMA
#undef PG8_WAIT_V
#undef PG8_WAIT_L
#undef PG8_BAR
#undef PG8_SCHED
}
}
using pg8::Unit;
#define EPI_ROWS(ai, m) (row0 + 128 * (ai) + 16 * (m))
#ifndef EPI_WT
#define EPI_WT 0
#endif
__device__ __forceinline__ void store8_bf16(bf16_t* p, const f32x4& a, const f32x4& b) {
    u32x4 w; w.x = pk2(a[0], a[1]); w.y = pk2(a[2], a[3]); w.z = pk2(b[0], b[1]); w.w = pk2(b[2], b[3]);
    if (EPI_WT) asm volatile("global_store_dwordx4 %0, %1, off sc1\n\ts_nop 1" :: "v"(p), "v"(w) : "memory"); else *(u32x4*)p = w;
}
__device__ __forceinline__ void rope8_store(const f32x4& a0, const f32x4& a1, const f32x4& b0, const f32x4& b1, const f32x4* cs, float sc, bf16_t* p1, bf16_t* p2) {
    const f32x4 c0 = cs[0], c1 = cs[1], c2 = cs[2], c3 = cs[3];
    f32x4 o1a, o1b, o2a, o2b;
    o1a[0] = (a0[0] * c0[0] - b0[0] * c0[1]) * sc; o2a[0] = (b0[0] * c0[0] + a0[0] * c0[1]) * sc;
    o1a[1] = (a0[1] * c0[2] - b0[1] * c0[3]) * sc; o2a[1] = (b0[1] * c0[2] + a0[1] * c0[3]) * sc;
    o1a[2] = (a0[2] * c1[0] - b0[2] * c1[1]) * sc; o2a[2] = (b0[2] * c1[0] + a0[2] * c1[1]) * sc;
    o1a[3] = (a0[3] * c1[2] - b0[3] * c1[3]) * sc; o2a[3] = (b0[3] * c1[2] + a0[3] * c1[3]) * sc;
    o1b[0] = (a1[0] * c2[0] - b1[0] * c2[1]) * sc; o2b[0] = (b1[0] * c2[0] + a1[0] * c2[1]) * sc;
    o1b[1] = (a1[1] * c2[2] - b1[1] * c2[3]) * sc; o2b[1] = (b1[1] * c2[2] + a1[1] * c2[3]) * sc;
    o1b[2] = (a1[2] * c3[0] - b1[2] * c3[1]) * sc; o2b[2] = (b1[2] * c3[0] + a1[2] * c3[1]) * sc;
    o1b[3] = (a1[3] * c3[2] - b1[3] * c3[3]) * sc; o2b[3] = (b1[3] * c3[2] + a1[3] * c3[3]) * sc;
    store8_bf16(p1, o1a, o1b); store8_bf16(p2, o2a, o2b);
}
__device__ __forceinline__ float sumsq8(const f32x4& a, const f32x4& b) { return (a[0] * a[0] + a[1] * a[1]) + (a[2] * a[2] + a[3] * a[3]) + (b[0] * b[0] + b[1] * b[1]) + (b[2] * b[2] + b[3] * b[3]); }
__device__ __forceinline__ void vt_store8(bf16_t* p  , const f32x4& a, const f32x4& b) {
    const unsigned w0 = pk2(a[0], a[1]), w1 = pk2(a[2], a[3]), w2 = pk2(b[0], b[1]), w3 = pk2(b[2], b[3]);
    p[0 * 64] = (bf16_t)w0; p[1 * 64] = (bf16_t)(w0 >> 16); p[2 * 64] = (bf16_t)w1; p[3 * 64] = (bf16_t)(w1 >> 16);
    p[4 * 64] = (bf16_t)w2; p[5 * 64] = (bf16_t)(w2 >> 16); p[6 * 64] = (bf16_t)w3; p[7 * 64] = (bf16_t)(w3 >> 16);
}

struct Epi1 {
    static constexpr bool AFTER_DRAIN = false;
    unsigned char* ws; int layer;
    __device__ __forceinline__ bool operator()(f32x4 (&acc)[2][2][4][2], const Unit& u, int wr, int wc, int fr, int fq) const {
        const int pn = u.pn, row0 = u.pm * 256 + wr * 64 + fr;
        if (pn <= 6) {
            bf16_t* dst; int ld, hc, half = 32; float sc = 1.f; bool valid = true;
            if (pn == 0)      { dst = (bf16_t*)(ws + R_BQ);  ld = 512; hc = 64 * wc;       sc = QS64; }
            else if (pn == 1) { dst = (bf16_t*)(ws + R_BQ);  ld = 512; hc = 64 * (4 + wc); sc = QS64; }
            else if (pn == 2) { dst = (bf16_t*)(ws + R_CQ);  ld = 512; hc = 64 * wc;       sc = QS64; }
            else if (pn == 3) { dst = (bf16_t*)(ws + R_CQ);  ld = 512; hc = 64 * (4 + wc); sc = QS64; }
            else if (pn == 4) { dst = (bf16_t*)(ws + R_BQI); ld = 256; hc = 64 * wc; }
            else if (pn == 5) { if (wc < 2) { dst = (bf16_t*)(ws + R_BK); ld = 128; hc = 64 * wc; } else { dst = (bf16_t*)(ws + R_CK); ld = 128; hc = 64 * (wc - 2); } }
            else { if (wc == 0) { dst = (bf16_t*)(ws + R_BKI); ld = 64; hc = 0; } else { dst = (bf16_t*)(ws + R_KPE); ld = 32; hc = 0; half = 16; valid = (wc == 1) && (fq < 2); } }
            const f32x2* tab = (const f32x2*)(ws + (half == 32 ? WS_CS64 : WS_CS32));
            const int ci = (half == 32) ? 8 * fq : 8 * (fq & 1);
            if (valid) {
#pragma unroll
                for (int ai = 0; ai < 2; ++ai) {
                    f32x4 csv[4][4];
#pragma unroll
                    for (int m = 0; m < 4; ++m) { const int t = EPI_ROWS(ai, m) & (SEQ - 1); const f32x4* cs = (const f32x4*)(tab + (size_t)t * half + ci);
#pragma unroll
                        for (int q = 0; q < 4; ++q) csv[m][q] = cs[q]; }
                    __builtin_amdgcn_sched_barrier(0);
#pragma unroll
                    for (int m = 0; m < 4; ++m) {
                        const int r = EPI_ROWS(ai, m);
                        bf16_t* p = dst + (size_t)r * ld + hc + ci;
                        rope8_store(acc[ai][0][m][0], acc[ai][0][m][1], acc[ai][1][m][0], acc[ai][1][m][1], csv[m], sc, p, p + half);
                        asm volatile("" ::: "memory");
                    }
                }
            }
            return false;
        }
        u64* ssq = (u64*)(ws + WS_SSQ) + (size_t)layer * 2 * NT;
        bf16_t* QLAT = (bf16_t*)(ws + R_QLAT); bf16_t* KVLAT = (bf16_t*)(ws + R_KVLAT);
        const int c8 = 32 * wc + 8 * fq;
#pragma unroll
        for (int ai = 0; ai < 2; ++ai)
#pragma unroll
            for (int m = 0; m < 4; ++m) {
                const int r = EPI_ROWS(ai, m);
                const f32x4 &v00 = acc[ai][0][m][0], &v01 = acc[ai][0][m][1], &v10 = acc[ai][1][m][0], &v11 = acc[ai][1][m][1];
                if (pn == 7) {
                    store8_bf16(QLAT + (size_t)r * 384 + c8, v00, v01); store8_bf16(QLAT + (size_t)r * 384 + 128 + c8, v10, v11);
                    float ss = sumsq8(v00, v01) + sumsq8(v10, v11); ss += shx(ss, 16, fr + 16 * fq); ss += shx(ss, 32, fr + 16 * fq);
                    if (fq == 0) atomicAdd(ssq + r, (u64)(ss * SSQ_SCALE));
                } else if (pn == 8) {
                    store8_bf16(QLAT + (size_t)r * 384 + 256 + c8, v00, v01);
                    float ss = sumsq8(v00, v01); ss += shx(ss, 16, fr + 16 * fq); ss += shx(ss, 32, fr + 16 * fq);
                    if (fq == 0) atomicAdd(ssq + r, (u64)(ss * SSQ_SCALE));
                    vt_store8((bf16_t*)(ws + R_BVT) + ((size_t)(((r >> 11) * 2 + (c8 >> 6)) * 32 + ((r & 2047) >> 6)) * 64 + (c8 & 63)) * 64 + (r & 63), v10, v11);
                } else if (pn == 9) {
                    store8_bf16(KVLAT + (size_t)r * 256 + c8, v00, v01); store8_bf16(KVLAT + (size_t)r * 256 + 128 + c8, v10, v11);
                    float ss = sumsq8(v00, v01) + sumsq8(v10, v11); ss += shx(ss, 16, fr + 16 * fq); ss += shx(ss, 32, fr + 16 * fq);
                    if (fq == 0) atomicAdd(ssq + NT + r, (u64)(ss * SSQ_SCALE));
                } else {
                    vt_store8((bf16_t*)(ws + R_CVT) + ((size_t)(((r >> 11) * 2 + (c8 >> 6)) * 32 + ((r & 2047) >> 6)) * 64 + (c8 & 63)) * 64 + (r & 63), v00, v01);
                    if (wc == 0 && fq == 0) *(f32x4*)((float*)(ws + R_WIDX) + (size_t)r * 4) = v10 * 0.0625f;
                }
            }
        return false;
    }
};
struct EpiGate {
    static constexpr bool AFTER_DRAIN = false;
    bf16_t* G; float osc = 1.0f;
    __device__ __forceinline__ bool operator()(f32x4 (&acc)[2][2][4][2], const Unit& u, int wr, int wc, int fr_in, int fq_in) const {
        (void)fr_in; (void)fq_in;
        int ln_; asm volatile("v_mbcnt_lo_u32_b32 %0, -1, 0\n\tv_mbcnt_hi_u32_b32 %0, -1, %0" : "=v"(ln_));
        const int fr = ln_ & 15, fq = ln_ >> 4;
        const int row0 = u.pm * 256 + wr * 64 + fr, col0 = u.pn * 256 + 32 * wc + 8 * fq;
#pragma unroll
        for (int ai = 0; ai < 2; ++ai)
#pragma unroll
            for (int m = 0; m < 4; ++m) { bf16_t* rp = G + (size_t)EPI_ROWS(ai, m) * 3072 + col0;
#pragma unroll
                for (int bj = 0; bj < 2; ++bj) { f32x4 a = acc[ai][bj][m][0], b = acc[ai][bj][m][1];
#pragma unroll
                    for (int e = 0; e < 4; ++e) { a[e] = fast_sigmoid(a[e] * osc); b[e] = fast_sigmoid(b[e] * osc); }
                    store8_bf16(rp + 128 * bj, a, b); } }
        return false;
    }
};
struct SchedSub {
    pg8::StaticOrder S; bool on;
    __device__ bool next(int i, Unit& u) const { return on && S.next(i, u); }
    __device__ __forceinline__ void a_ready(const Unit&, int) const {}
    __device__ __forceinline__ void done(const Unit&, int) const {}
};
struct EpiUQ {
    static constexpr bool AFTER_DRAIN = false;
    unsigned char* ws; int layer;
    __device__ __forceinline__ bool operator()(f32x4 (&acc)[2][2][4][2], const Unit& u, int wr, int wc, int fr, int fq) const {
        const int pn = u.pn, row0 = u.pm * 256 + wr * 64 + fr;
        const u64* ssq = (const u64*)(ws + WS_SSQ) + (size_t)layer * 2 * NT;
        bf16_t* AQ = (bf16_t*)(ws + R_AQ);
        u64 sv[2][4];
#pragma unroll
        for (int ai = 0; ai < 2; ++ai)
#pragma unroll
            for (int m = 0; m < 4; ++m) sv[ai][m] = ssq[EPI_ROWS(ai, m)];
        __builtin_amdgcn_sched_barrier(0);
        if (pn < 2) {
            const int d0 = 32 * (wc & 1) + 8 * fq, h0 = 4 * pn + (wc >> 1);
#pragma unroll
            for (int ai = 0; ai < 2; ++ai)
#pragma unroll
                for (int m = 0; m < 4; ++m) {
                    const int r = EPI_ROWS(ai, m);
                    const float rs = __builtin_amdgcn_rsqf((float)(unsigned)(sv[ai][m] >> 12) * (4096.0f / (SSQ_SCALE * 384.0f)) + RMS_EPS) * QS96;
                    bf16_t* p = AQ + (size_t)r * 768 + h0 * 96 + d0;
                    store8_bf16(p, acc[ai][0][m][0] * rs, acc[ai][0][m][1] * rs);
                    store8_bf16(p + 2 * 96, acc[ai][1][m][0] * rs, acc[ai][1][m][1] * rs);
                    asm volatile("" ::: "memory");
                }
        } else {
            const int head = 2 * wc + (fq >> 1), i0 = 8 * (fq & 1);
#pragma unroll
            for (int ai = 0; ai < 2; ++ai)
#pragma unroll
                for (int m = 0; m < 4; ++m) {
                    const int r = EPI_ROWS(ai, m), t = r & (SEQ - 1);
                    const float rs = __builtin_amdgcn_rsqf((float)(unsigned)(sv[ai][m] >> 12) * (4096.0f / (SSQ_SCALE * 384.0f)) + RMS_EPS) * QS96;
                    const f32x4* cs = (const f32x4*)((const f32x2*)(ws + WS_CS32) + (size_t)t * 16 + i0);
                    bf16_t* p = AQ + (size_t)r * 768 + head * 96 + 64 + i0;
                    rope8_store(acc[ai][0][m][0], acc[ai][0][m][1], acc[ai][1][m][0], acc[ai][1][m][1], cs, rs, p, p + 16);
                    asm volatile("" ::: "memory");
                }
        }
        return false;
    }
};
struct EpiUKV {
    static constexpr bool AFTER_DRAIN = false;
    unsigned char* ws; int layer; bool nov = false;
    __device__ __forceinline__ bool operator()(f32x4 (&acc)[2][2][4][2], const Unit& u, int wr, int wc, int fr, int fq) const {
        const int pn = u.pn, row0 = u.pm * 256 + wr * 64 + fr, c8 = 32 * wc + 8 * fq;
        const u64* ssq = (const u64*)(ws + WS_SSQ) + (size_t)layer * 2 * NT + NT;
        u64 sv[2][4];
#pragma unroll
        for (int ai = 0; ai < 2; ++ai)
#pragma unroll
            for (int m = 0; m < 4; ++m) sv[ai][m] = ssq[EPI_ROWS(ai, m)];
        __builtin_amdgcn_sched_barrier(0);
#pragma unroll
        for (int ai = 0; ai < 2; ++ai)
#pragma unroll
            for (int m = 0; m < 4; ++m) {
                const int r = EPI_ROWS(ai, m);
                const float rs = __builtin_amdgcn_rsqf((float)(unsigned)(sv[ai][m] >> 12) * (4096.0f / (SSQ_SCALE * 256.0f)) + RMS_EPS);
#pragma unroll
                for (int bj = 0; bj < 2; ++bj) { const int tc = 128 * bj + c8;
                    if (pn < 2) store8_bf16((bf16_t*)(ws + R_AKN) + (size_t)r * 512 + 256 * pn + tc, acc[ai][bj][m][0] * rs, acc[ai][bj][m][1] * rs);
                    else if (!nov) vt_store8((bf16_t*)(ws + R_AVT) + ((size_t)(((r >> 11) * 8 + 4 * (pn - 2) + (tc >> 6)) * 32 + ((r & 2047) >> 6)) * 64 + (tc & 63)) * 64 + (r & 63), acc[ai][bj][m][0] * rs, acc[ai][bj][m][1] * rs); }
            }
        return false;
    }
};
struct EpiBr {
    static constexpr bool AFTER_DRAIN = false;
    const bf16_t* G; bf16_t* MERGED; float osc = 1.0f; bool m8 = false;
    __device__ __forceinline__ bool operator()(f32x4 (&acc)[2][2][4][2], const Unit& u, int wr, int wc, int fr_in, int fq_in) const {
        (void)fr_in; (void)fq_in;
        int ln_; asm volatile("v_mbcnt_lo_u32_b32 %0, -1, 0\n\tv_mbcnt_hi_u32_b32 %0, -1, %0" : "=v"(ln_));
        const int fr = ln_ & 15, fq = ln_ >> 4;
        int upm_ = u.pm, upn_ = u.pn; asm volatile("" : "+s"(upm_), "+s"(upn_));
        const int sub = upm_ >> 6, pm = upm_ & 63, pn = upn_ & 3;
        const int row0 = pm * 256 + wr * 64 + fr, col0 = pn * 256 + 32 * wc + 8 * fq;
#pragma unroll
        for (int ai = 0; ai < 2; ++ai) {
            u32x4 gv[4][2], hv[4][2];
#pragma unroll
            for (int m = 0; m < 4; ++m) { const int r = EPI_ROWS(ai, m);
#pragma unroll
                for (int bj = 0; bj < 2; ++bj) { gv[m][bj] = *(const u32x4*)(G + (size_t)r * 3072 + 1024 * sub + col0 + 128 * bj);
                    if (sub < 2) hv[m][bj] = *(const u32x4*)(G + (size_t)r * 3072 + 1024 * (sub + 1) + col0 + 128 * bj); else hv[m][bj] = gv[m][bj]; } }
            __builtin_amdgcn_sched_barrier(0);
#pragma unroll
            for (int m = 0; m < 4; ++m) { const int r = EPI_ROWS(ai, m);
#pragma unroll
                for (int bj = 0; bj < 2; ++bj) {
                    const u32x4 g = gv[m][bj];
                    f32x4 ga = {bf_lo(g.x), bf_hi(g.x), bf_lo(g.y), bf_hi(g.y)}, gb = {bf_lo(g.z), bf_hi(g.z), bf_lo(g.w), bf_hi(g.w)};
                    if (sub < 2) {
                        const u32x4 h = hv[m][bj];
                        const f32x4 ha = {bf_lo(h.x), bf_hi(h.x), bf_lo(h.y), bf_hi(h.y)}, hb = {bf_lo(h.z), bf_hi(h.z), bf_lo(h.w), bf_hi(h.w)};
#pragma unroll
                        for (int e = 0; e < 4; ++e) { ga[e] = ga[e] * __builtin_amdgcn_rcpf(ha[e]); gb[e] = gb[e] * __builtin_amdgcn_rcpf(hb[e]); }
                        acc[ai][bj][m][0] = acc[ai][bj][m][0] * ga; acc[ai][bj][m][1] = acc[ai][bj][m][1] * gb;
                    } else {
                        if (m8) { const f32x4 ya = acc[ai][bj][m][0] * (ga * (osc * 16.0f)), yb = acc[ai][bj][m][1] * (gb * (osc * 16.0f)); u32x2 q8; q8.x = (unsigned)f8x4(ya[0], ya[1], ya[2], ya[3]); q8.y = (unsigned)f8x4(yb[0], yb[1], yb[2], yb[3]);
                            *(u32x2*)((unsigned char*)MERGED + (size_t)r * 1024 + col0 + 128 * bj) = q8; }
                        else store8_bf16(MERGED + (size_t)r * 1024 + col0 + 128 * bj, acc[ai][bj][m][0] * (ga * osc), acc[ai][bj][m][1] * (gb * osc));
                    }
                } }
            __builtin_amdgcn_sched_barrier(0);
        }
        return sub < 2;
    }
};
struct SchedGate {
    pg8::StaticOrder S;
    __device__ bool next(int i, Unit& u) const { const int q = (i * 43) >> 7, sub = i - 3 * q; if (!S.next(q, u)) return false; u.pn += 4 * sub; return true; }
    __device__ __forceinline__ void a_ready(const Unit&, int) const {}
    __device__ __forceinline__ void done(const Unit&, int) const {}
};
struct SchedBr {
    pg8::StaticOrder S;
    __device__ bool next(int i, Unit& u) const { const int q = i / 3, sub = i - 3 * q; if (!S.next(q, u)) return false; u.pm += 64 * sub; u.pn += 4 * sub; return true; }
    __device__ __forceinline__ void a_ready(const Unit&, int) const {}
    __device__ __forceinline__ void done(const Unit&, int) const {}
};
struct EpiOut {
    static constexpr bool AFTER_DRAIN = false;
    const float* X; float* Z;
    __device__ __forceinline__ bool operator()(f32x4 (&acc)[2][2][4][2], const Unit& u, int wr, int wc, int fr, int fq) const {
        const int row0 = u.pm * 256 + wr * 64 + fr, col0 = u.pn * 256 + 32 * wc + 8 * fq;
#pragma unroll
        for (int ai = 0; ai < 2; ++ai)
#pragma unroll
            for (int m = 0; m < 4; ++m) { const size_t o = (size_t)EPI_ROWS(ai, m) * 1024 + col0;
#pragma unroll
                for (int bj = 0; bj < 2; ++bj) {
                    const f32x4 x0 = *(const f32x4*)(X + o + 128 * bj), x1 = *(const f32x4*)(X + o + 128 * bj + 4);
                    *(f32x4*)(Z + o + 128 * bj) = x0 * ALPHA + acc[ai][bj][m][0]; *(f32x4*)(Z + o + 128 * bj + 4) = x1 * ALPHA + acc[ai][bj][m][1]; }
                asm volatile("" ::: "memory"); }
        return false;
    }
};
struct PanelStats {
    u64* xbuf; unsigned* cnt; float eps;
    __device__ __forceinline__ void run(const f32x4 (&v)[2][2][4][2], const Unit& u, int wr, int wc, int fr, int fq, LAS unsigned char* lds, int wid, int lane) const {
        LAS f32x2* Pt = (LAS f32x2*)lds;
        LAS f32x2* St = (LAS f32x2*)(lds + 8192);
#pragma unroll
        for (int ai = 0; ai < 2; ++ai)
#pragma unroll
            for (int m = 0; m < 4; ++m) {
                float s = 0.f;
#pragma unroll
                for (int bj = 0; bj < 2; ++bj)
#pragma unroll
                    for (int n = 0; n < 2; ++n) { const f32x4 x = v[ai][bj][m][n]; s += (x[0] + x[1]) + (x[2] + x[3]); }
                s += shx(s, 16, lane); s += shx(s, 32, lane);
                const float mw = s * (1.0f / 64.0f); float q = 0.f;
#pragma unroll
                for (int bj = 0; bj < 2; ++bj)
#pragma unroll
                    for (int n = 0; n < 2; ++n) { const f32x4 d = v[ai][bj][m][n] - mw; q += (d[0] * d[0] + d[1] * d[1]) + (d[2] * d[2] + d[3] * d[3]); }
                q += shx(q, 16, lane); q += shx(q, 32, lane);
                if (fq == 0) Pt[(ai * 128 + wr * 64 + m * 16 + fr) * 4 + wc] = (f32x2){mw, q};
            }
        asm volatile("s_waitcnt lgkmcnt(0)" ::: "memory"); __builtin_amdgcn_s_barrier(); asm volatile("" ::: "memory");
        const int row = wid * 32 + (lane & 31);
        if (lane < 32) {
            const f32x2 a = Pt[row * 4 + 0], b = Pt[row * 4 + 1], c = Pt[row * 4 + 2], d = Pt[row * 4 + 3];
            const float mt = (a.x + b.x + c.x + d.x) * 0.25f;
            const float da = a.x - mt, db = b.x - mt, dc = c.x - mt, dd = d.x - mt;
            const float m2 = (a.y + b.y) + (c.y + d.y) + 64.0f * ((da * da + db * db) + (dc * dc + dd * dd));
            __hip_atomic_store(xbuf + ((size_t)(u.pm * 256 + row) * 4 + u.pn), ((u64)__float_as_uint(m2) << 32) | __float_as_uint(mt), __ATOMIC_RELAXED, __HIP_MEMORY_SCOPE_AGENT);
        }
        asm volatile("s_waitcnt vmcnt(0)" ::: "memory");
        if (lane == 0) __hip_atomic_fetch_add(cnt + 64 * u.pm, 1u, __ATOMIC_RELAXED, __HIP_MEMORY_SCOPE_AGENT);
        if (wid == 0) {
            unsigned spins = 0u;
            while ((unsigned)__builtin_amdgcn_readfirstlane(__hip_atomic_load(cnt + 64 * u.pm, __ATOMIC_RELAXED, __HIP_MEMORY_SCOPE_AGENT)) < 32u) { __builtin_amdgcn_s_sleep(2); if (++spins > (1u << 22)) break; }
            __builtin_amdgcn_fence(__ATOMIC_ACQUIRE, "agent");
        }
        asm volatile("s_waitcnt vmcnt(0) lgkmcnt(0)" ::: "memory"); __builtin_amdgcn_s_barrier(); asm volatile("" ::: "memory");
        if (lane < 32) {
            const u64* slot = xbuf + (size_t)(u.pm * 256 + row) * 4; float mt[4], m2[4]; float ms = 0.f;
#pragma unroll
            for (int t = 0; t < 4; ++t) { const u64 w = __hip_atomic_load(slot + t, __ATOMIC_RELAXED, __HIP_MEMORY_SCOPE_AGENT); mt[t] = __uint_as_float((unsigned)w); m2[t] = __uint_as_float((unsigned)(w >> 32)); ms += mt[t]; }
            const float mean = ms * 0.25f; float q = 0.f;
#pragma unroll
            for (int t = 0; t < 4; ++t) { const float dm = mt[t] - mean; q += m2[t] + 256.0f * dm * dm; }
            St[row] = (f32x2){mean, 1.0f / sqrtf(q * (1.0f / 1024.0f) + eps)};
        }
        asm volatile("s_waitcnt lgkmcnt(0)" ::: "memory"); __builtin_amdgcn_s_barrier(); asm volatile("" ::: "memory");
    }
};
struct EpiOutLn {
    static constexpr bool AFTER_DRAIN = true;
    float* X; bf16_t* XB; const float* g; const float* b; PanelStats st; unsigned char* XB8 = nullptr; float asc = 1.0f;
    __device__ __forceinline__ bool operator()(f32x4 (&)[2][2][4][2], const Unit&, int, int, int, int) const { return false; }
    __device__ __forceinline__ void fused(f32x4 (&acc)[2][2][4][2], const Unit& u, int wr, int wc, int fr, int fq, LAS unsigned char* lds, int wid, int lane) const {
        const int row0 = u.pm * 256 + wr * 64 + fr, col0 = u.pn * 256 + 32 * wc + 8 * fq;
#pragma unroll
        for (int ai = 0; ai < 2; ++ai)
#pragma unroll
            for (int m = 0; m < 4; ++m) { const size_t o = (size_t)EPI_ROWS(ai, m) * 1024 + col0;
#pragma unroll
                for (int bj = 0; bj < 2; ++bj) { const u32x4 xw = *(const u32x4*)(XB + o + 128 * bj);
                    const f32x4 xa = {bf_lo(xw.x), bf_hi(xw.x), bf_lo(xw.y), bf_hi(xw.y)}, xb2 = {bf_lo(xw.z), bf_hi(xw.z), bf_lo(xw.w), bf_hi(xw.w)};
                    acc[ai][bj][m][0] = xa * ALPHA + acc[ai][bj][m][0] * asc; acc[ai][bj][m][1] = xb2 * ALPHA + acc[ai][bj][m][1] * asc; }
                asm volatile("" : "+v"(acc[ai][0][m][0]), "+v"(acc[ai][0][m][1]), "+v"(acc[ai][1][m][0]), "+v"(acc[ai][1][m][1]));
                if (m & 1) asm volatile("" ::: "memory"); }
        st.run(acc, u, wr, wc, fr, fq, lds, wid, lane);
        const LAS f32x2* St = (const LAS f32x2*)(lds + 8192);
        f32x4 gg[2][2], bb[2][2];
#pragma unroll
        for (int bj = 0; bj < 2; ++bj)
#pragma unroll
            for (int n = 0; n < 2; ++n) { gg[bj][n] = *(const f32x4*)(g + col0 + 128 * bj + 4 * n); bb[bj][n] = *(const f32x4*)(b + col0 + 128 * bj + 4 * n); }
#pragma unroll
        for (int ai = 0; ai < 2; ++ai)
#pragma unroll
            for (int m = 0; m < 4; ++m) { const int rl = ai * 128 + wr * 64 + m * 16 + fr; const f32x2 sr = St[rl]; const size_t o = (size_t)(u.pm * 256 + rl) * 1024 + col0;
#pragma unroll
                for (int bj = 0; bj < 2; ++bj) { const f32x4 y0 = (acc[ai][bj][m][0] - sr.x) * sr.y * gg[bj][0] + bb[bj][0], y1 = (acc[ai][bj][m][1] - sr.x) * sr.y * gg[bj][1] + bb[bj][1];
                    *(f32x4*)(X + o + 128 * bj) = y0; *(f32x4*)(X + o + 128 * bj + 4) = y1; store8_bf16(XB + o + 128 * bj, y0, y1);
                    if (XB8) { u32x2 q8; q8.x = (unsigned)f8x4(y0[0], y0[1], y0[2], y0[3]); q8.y = (unsigned)f8x4(y1[0], y1[1], y1[2], y1[3]); *(u32x2*)(XB8 + o + 128 * bj) = q8; } }
                asm volatile("" ::: "memory"); }
    }
};
struct SchedMoE {
    int ts[16]; int ntiles, G, c; unsigned* hrdy;
    __device__ bool next(int i, Unit& u) const {
        const int L = i * G + c; if (L >= 4 * ntiles) return false;
        const int tile = L >> 2, j = L & 3; int e = 0;
#pragma unroll
        for (int k = 1; k < 16; ++k) e += (tile >= ts[k]) ? 1 : 0;
        u.pm = tile; u.pn = 4 * e + j; return true;
    }
    __device__ __forceinline__ void a_ready(const Unit&, int) const {}
    __device__ __forceinline__ void done(const Unit& u, int tid) const {
        asm volatile("s_waitcnt vmcnt(0)" ::: "memory"); __builtin_amdgcn_s_barrier(); asm volatile("" ::: "memory");
        if (tid == 0) __hip_atomic_fetch_add(hrdy + 64 * u.pm, 1u, __ATOMIC_RELAXED, __HIP_MEMORY_SCOPE_AGENT);
    }
};
struct SchedMoEDown {
    int ts[16]; int ntiles, G, c, nheavy; unsigned* hrdy;
    __device__ bool next(int i, Unit& u) const {
        const int cc = c - nheavy; if (cc < 0) return false;
        const int L = i * (G - nheavy) + cc; if (L >= 4 * ntiles) return false;
        const int tile = L >> 2, j = L & 3; int e = 0;
#pragma unroll
        for (int k = 1; k < 16; ++k) e += (tile >= ts[k]) ? 1 : 0;
        u.pm = tile; u.pn = 4 * e + j; return true;
    }
    __device__ __forceinline__ void a_ready(const Unit& u, int tid) const {
        if (tid < 64) {
            unsigned spins = 0u;
            while ((unsigned)__builtin_amdgcn_readfirstlane(__hip_atomic_load(hrdy + 64 * u.pm, __ATOMIC_RELAXED, __HIP_MEMORY_SCOPE_AGENT)) < 4u) { __builtin_amdgcn_s_sleep(2); if (++spins > (1u << 22)) break; }
            __builtin_amdgcn_fence(__ATOMIC_ACQUIRE, "agent");
            asm volatile("s_waitcnt vmcnt(0)" ::: "memory");
        }
        asm volatile("" ::: "memory"); __builtin_amdgcn_s_barrier(); asm volatile("" ::: "memory");
    }
    __device__ __forceinline__ void done(const Unit&, int) const {}
};
__device__ __forceinline__ void store16_wt(void* p, const u32x4& v) {
    asm volatile("global_store_dwordx4 %0, %1, off sc1\n\ts_nop 1" :: "v"(p), "v"(v) : "memory");
}
struct EpiGU {
    static constexpr bool AFTER_DRAIN = false;
    const float* ROWW; bf16_t* H; float isc = 1.0f; bool f8 = false;
    __device__ __forceinline__ bool operator()(f32x4 (&acc)[2][2][4][2], const Unit& u, int wr, int wc, int fr_in, int fq_in) const {
        (void)fr_in; (void)fq_in;
        int ln_; asm volatile("v_mbcnt_lo_u32_b32 %0, -1, 0\n\tv_mbcnt_hi_u32_b32 %0, -1, %0" : "=v"(ln_));
        const int fr = ln_ & 15, fq = ln_ >> 4;
        const int row0 = u.pm * 256 + wr * 64 + fr, col0 = (u.pn & 3) * 128 + 32 * wc + 8 * fq;
        float wv[2][4];
#pragma unroll
        for (int ai = 0; ai < 2; ++ai)
#pragma unroll
            for (int m = 0; m < 4; ++m) wv[ai][m] = ROWW[EPI_ROWS(ai, m)];
        __builtin_amdgcn_sched_barrier(0);
#pragma unroll
        for (int ai = 0; ai < 2; ++ai)
#pragma unroll
            for (int m = 0; m < 4; ++m) { const int r = EPI_ROWS(ai, m); const float w = wv[ai][m];
                f32x4 a = acc[ai][0][m][0], b = acc[ai][0][m][1]; const f32x4 ua = acc[ai][1][m][0], ub = acc[ai][1][m][1];
#pragma unroll
                for (int e = 0; e < 4; ++e) { const float ga_ = a[e] * isc, gb_ = b[e] * isc; a[e] = ga_ * fast_sigmoid(ga_) * (ua[e] * isc) * w; b[e] = gb_ * fast_sigmoid(gb_) * (ub[e] * isc) * w; }
                if (f8) { u32x2 q8; q8.x = (unsigned)f8x4(a[0] * 8.0f, a[1] * 8.0f, a[2] * 8.0f, a[3] * 8.0f); q8.y = (unsigned)f8x4(b[0] * 8.0f, b[1] * 8.0f, b[2] * 8.0f, b[3] * 8.0f); asm volatile("global_store_dwordx2 %0, %1, off sc1\n\ts_nop 1" :: "v"((unsigned char*)H + (size_t)r * 512 + col0), "v"(q8) : "memory"); }
                else { u32x4 pk_; pk_.x = pk2(a[0], a[1]); pk_.y = pk2(a[2], a[3]); pk_.z = pk2(b[0], b[1]); pk_.w = pk2(b[2], b[3]); store16_wt(H + (size_t)r * 512 + col0, pk_); } }
        return false;
    }
};
struct EpiDN {
    static constexpr bool AFTER_DRAIN = false;
    const int* ROWTOK; bf16_t* Y2; float osc = 1.0f;
    __device__ __forceinline__ bool operator()(f32x4 (&acc)[2][2][4][2], const Unit& u, int wr, int wc, int fr_in, int fq_in) const {
        (void)fr_in; (void)fq_in;
        int ln_; asm volatile("v_mbcnt_lo_u32_b32 %0, -1, 0\n\tv_mbcnt_hi_u32_b32 %0, -1, %0" : "=v"(ln_));
        const int fr = ln_ & 15, fq = ln_ >> 4;
        const int row0 = u.pm * 256 + wr * 64 + fr, col0 = (u.pn & 3) * 256 + 32 * wc + 8 * fq;
        int tkv[2][4];
#pragma unroll
        for (int ai = 0; ai < 2; ++ai)
#pragma unroll
            for (int m = 0; m < 4; ++m) tkv[ai][m] = ROWTOK[EPI_ROWS(ai, m)];
        __builtin_amdgcn_sched_barrier(0);
#pragma unroll
        for (int ai = 0; ai < 2; ++ai)
#pragma unroll
            for (int m = 0; m < 4; ++m) { const int tk = tkv[ai][m];
                if (tk >= 0) {
#pragma unroll
                    for (int bj = 0; bj < 2; ++bj) store8_bf16(Y2 + (size_t)tk * 1024 + col0 + 128 * bj, acc[ai][bj][m][0] * osc, acc[ai][bj][m][1] * osc); } }
        return false;
    }
};
#ifndef IDX_HEAD_FENCE
#define IDX_HEAD_FENCE 1
#endif
#define MFMA32(a, b, c) __builtin_amdgcn_mfma_f32_32x32x16_bf16((a), (b), (c), 0, 0, 0)
__device__ __forceinline__ constexpr int crow(int t, int h) { return (t & 3) + 8 * (t >> 2) + 4 * h; }
__device__ __forceinline__ bf16x8 pack8(const f32x16& x, int s) {
    u32x4 p; p.x = pk2(x[8 * s + 0], x[8 * s + 1]); p.y = pk2(x[8 * s + 2], x[8 * s + 3]); p.z = pk2(x[8 * s + 4], x[8 * s + 5]); p.w = pk2(x[8 * s + 6], x[8 * s + 7]);
    return __builtin_bit_cast(bf16x8, p);
}
template <int NKS, int MODE>
__device__ __forceinline__ void attn_item(const bf16_t* qrow, const bf16_t* k1, int ldk1, const bf16_t* k2, int ldk2, const bf16_t* vt,
                                          int kbeg, int kend, const unsigned* maskrow, float sink_l2, bf16_t* orow, int lane) {
    const int r = lane & 31, h = lane >> 5;
    bf16x8 qf[NKS];
#pragma unroll
    for (int ks = 0; ks < NKS; ++ks) qf[ks] = *(const bf16x8*)(qrow + 16 * ks + 8 * h);
    f32x16 o0, o1;
#pragma unroll
    for (int t = 0; t < 16; ++t) { o0[t] = 0.f; o1[t] = 0.f; }
    float m = -1e30f, l = 0.f;
    for (int kt = kbeg; kt < kend; kt += 64) {
        f32x16 s0, s1;
#pragma unroll
        for (int t = 0; t < 16; ++t) { s0[t] = 0.f; s1[t] = 0.f; }
#pragma unroll
        for (int ks = 0; ks < NKS; ++ks) {
            const bf16_t* kp = (ks < 4) ? (k1 + (size_t)(kt + r) * ldk1 + 16 * ks + 8 * h) : (k2 + (size_t)(kt + r) * ldk2 + 16 * (ks - 4) + 8 * h);
            const int ld = (ks < 4) ? ldk1 : ldk2;
            const bf16x8 a0 = *(const bf16x8*)kp, a1 = *(const bf16x8*)(kp + 32 * ld);
            s0 = MFMA32(a0, qf[ks], s0); s1 = MFMA32(a1, qf[ks], s1);
        }
        if (MODE == 1) {
            const unsigned w0 = maskrow[kt >> 5], w1 = maskrow[(kt >> 5) + 1];
#pragma unroll
            for (int t = 0; t < 16; ++t) { if (!((w0 >> crow(t, h)) & 1u)) s0[t] = -INFINITY; if (!((w1 >> crow(t, h)) & 1u)) s1[t] = -INFINITY; }
        }
        float mx = fmaxf(s0[0], s1[0]);
#pragma unroll
        for (int t = 1; t < 16; ++t) mx = fmaxf(mx, fmaxf(s0[t], s1[t]));
        mx = fmaxf(mx, shx(mx, 32, lane));
        const float mn = fmaxf(m, mx), alpha = __builtin_amdgcn_exp2f(m - mn); m = mn;
        float ps = 0.f;
#pragma unroll
        for (int t = 0; t < 16; ++t) { s0[t] = __builtin_amdgcn_exp2f(s0[t] - mn); s1[t] = __builtin_amdgcn_exp2f(s1[t] - mn); ps += s0[t] + s1[t]; }
        l = l * alpha + ps;
#pragma unroll
        for (int t = 0; t < 16; ++t) { o0[t] *= alpha; o1[t] *= alpha; }
        bf16x8 pb[4]; pb[0] = pack8(s0, 0); pb[1] = pack8(s0, 1); pb[2] = pack8(s1, 0); pb[3] = pack8(s1, 1);
#pragma unroll
        for (int s4 = 0; s4 < 4; ++s4) {
            const bf16_t* vp = vt + (size_t)r * SEQ + kt + 16 * s4 + 4 * h;
            const s16x4 lo0 = *(const s16x4*)vp, hi0 = *(const s16x4*)(vp + 8);
            const s16x4 lo1 = *(const s16x4*)(vp + 32 * SEQ), hi1 = *(const s16x4*)(vp + 32 * SEQ + 8);
            o0 = MFMA32(__builtin_shufflevector(lo0, hi0, 0, 1, 2, 3, 4, 5, 6, 7), pb[s4], o0);
            o1 = MFMA32(__builtin_shufflevector(lo1, hi1, 0, 1, 2, 3, 4, 5, 6, 7), pb[s4], o1);
        }
    }
    float lt = l + shx(l, 32, lane);
    if (MODE == 2) lt += __builtin_amdgcn_exp2f(sink_l2 - m);
    const float inv = 1.0f / lt;
#pragma unroll
    for (int g = 0; g < 4; ++g) {
        u32x2 w0, w1;
        w0.x = pk2(o0[4 * g] * inv, o0[4 * g + 1] * inv); w0.y = pk2(o0[4 * g + 2] * inv, o0[4 * g + 3] * inv);
        w1.x = pk2(o1[4 * g] * inv, o1[4 * g + 1] * inv); w1.y = pk2(o1[4 * g + 2] * inv, o1[4 * g + 3] * inv);
        *(u32x2*)(orow + 8 * g + 4 * h) = w0; *(u32x2*)(orow + 32 + 8 * g + 4 * h) = w1;
    }
}

__device__ __forceinline__ void attention_phase(unsigned char* ws, const float* sinks  , int G, int bid, int wave, int lane) {
    const int r = lane & 31;
    const bf16_t* AQ = (const bf16_t*)(ws + R_AQ); const bf16_t* AKN = (const bf16_t*)(ws + R_AKN); const bf16_t* KPE = (const bf16_t*)(ws + R_KPE); const bf16_t* AVT = (const bf16_t*)(ws + R_AVT);
    const bf16_t* BQ = (const bf16_t*)(ws + R_BQ); const bf16_t* BK = (const bf16_t*)(ws + R_BK); const bf16_t* BVT = (const bf16_t*)(ws + R_BVT); const unsigned* MASK = (const unsigned*)(ws + R_MASK);
    const bf16_t* CQ = (const bf16_t*)(ws + R_CQ); const bf16_t* CK = (const bf16_t*)(ws + R_CK); const bf16_t* CVT = (const bf16_t*)(ws + R_CVT);
    bf16_t* OA = (bf16_t*)(ws + WS_OABC); bf16_t* OB = OA + (size_t)NT * 512; bf16_t* OC = OB + (size_t)NT * 512;
    for (int j = bid; j < 256; j += G) {
        const int bh = j >> 2, b = bh >> 3, head = bh & 7, g = head >> 2, p = 8 * (j & 3) + wave;
        const size_t tb = (size_t)b * SEQ;
        for (int z = 0; z < 2; ++z) {
            const int qt = z ? 63 - p : p, c = qt >> 1, q0 = 32 * qt; const size_t qr = tb + q0 + r;
            attn_item<6, 0>(AQ + qr * 768 + head * 96, AKN + tb * 512 + head * 64, 512, KPE + tb * 32, 32, AVT + (size_t)(b * 8 + head) * 64 * SEQ,
                            0, 64 * (c + 1), nullptr, 0.f, OA + qr * 512 + head * 64, lane);
        }
        for (int z = 0; z < 2; ++z) {
            const int qt = z ? 63 - p : p, c = qt >> 1, q0 = 32 * qt; const size_t qr = tb + q0 + r;
            attn_item<4, 1>(BQ + qr * 512 + head * 64, BK + tb * 128 + g * 64, 128, nullptr, 0, BVT + (size_t)(b * 2 + g) * 64 * SEQ,
                            0, 64 * (c + 1), MASK + qr * 64, 0.f, OB + qr * 512 + head * 64, lane);
        }
        const float sink = sinks[head] * LOG2E;
        for (int z = 0; z < 2; ++z) {
            const int qt = z ? 63 - p : p, c = qt >> 1, q0 = 32 * qt; const size_t qr = tb + q0 + r;
            attn_item<4, 2>(CQ + qr * 512 + head * 64, CK + tb * 128 + g * 64, 128, nullptr, 0, CVT + (size_t)(b * 2 + g) * 64 * SEQ,
                            (c >= 2) ? 64 * (c - 2) : 0, 64 * (c + 1), nullptr, sink, OC + qr * 512 + head * 64, lane);
        }
    }
}

__device__ __forceinline__ void vt_item(const bf16_t* src  , int ld, bf16_t* dst  , LAS unsigned short* tile  , int lane) {
    const u32x4* sp = (const u32x4*)(src + (size_t)lane * ld);
#pragma unroll
    for (int c = 0; c < 8; ++c) { const u32x4 v = sp[c];
        tile[(8 * c + 0) * 72 + lane] = (unsigned short)v.x; tile[(8 * c + 1) * 72 + lane] = (unsigned short)(v.x >> 16);
        tile[(8 * c + 2) * 72 + lane] = (unsigned short)v.y; tile[(8 * c + 3) * 72 + lane] = (unsigned short)(v.y >> 16);
        tile[(8 * c + 4) * 72 + lane] = (unsigned short)v.z; tile[(8 * c + 5) * 72 + lane] = (unsigned short)(v.z >> 16);
        tile[(8 * c + 6) * 72 + lane] = (unsigned short)v.w; tile[(8 * c + 7) * 72 + lane] = (unsigned short)(v.w >> 16); }
    asm volatile("s_waitcnt lgkmcnt(0)" ::: "memory");
    u32x4* dp = (u32x4*)(dst + (size_t)lane * 64);
#pragma unroll
    for (int c = 0; c < 8; ++c) dp[c] = *(const LAS u32x4*)(tile + lane * 72 + 8 * c);
    asm volatile("s_waitcnt lgkmcnt(0)" ::: "memory");
}
__device__ __forceinline__ void vtranspose_phase(unsigned char* ws, LAS unsigned char* lds, int gw, int NGW, int wave, int lane) {
    LAS unsigned short* tile = (LAS unsigned short*)(lds + 4096 + wave * 9216);
    for (int it = gw; it < 3072; it += NGW) {
        if (it < 2048) { const int tt = it & 31, head = (it >> 5) & 7, b = it >> 8;
            vt_item((const bf16_t*)(ws + R_AV) + ((size_t)b * SEQ + 64 * tt) * 512 + 64 * head, 512, (bf16_t*)(ws + R_AVT) + (size_t)(b * 8 + head) * 64 * SEQ + 4096 * tt, tile, lane); }
        else { const int q = it - 2048, which = q >> 9, qq = q & 511, tt = qq & 31, g = (qq >> 5) & 1, b = qq >> 6;
            vt_item((const bf16_t*)(ws + (which ? R_CV : R_BV)) + ((size_t)b * SEQ + 64 * tt) * 128 + 64 * g, 128, (bf16_t*)(ws + (which ? R_CVT : R_BVT)) + (size_t)(b * 2 + g) * 64 * SEQ + 4096 * tt, tile, lane); }
    }
}

__device__ __forceinline__ unsigned sortable(float x) { const unsigned u = __float_as_uint(x + 0.0f); return (u & 0x80000000u) ? ~u : (u | 0x80000000u); }
__device__ __forceinline__ void indexer_phase(unsigned char* ws, LAS unsigned char* lds, int G, int bid, int w, int lane_in, int tid_in) {
    LAS unsigned* cntbuf = (LAS unsigned*)lds;
    LAS unsigned* runb = cntbuf + 512;
    const bf16_t* BQI = (const bf16_t*)(ws + R_BQI); const bf16_t* BKI = (const bf16_t*)(ws + R_BKI); const float* WIDX = (const float*)(ws + R_WIDX);
    unsigned* MASK = (unsigned*)(ws + R_MASK);
    for (int item = bid; item < 256; item += G) {
#pragma unroll 1
        for (int z = 0; z < 2; ++z) {
            int lane = lane_in; asm volatile("" : "+v"(lane));
            const int r = lane & 31, h = lane >> 5, tid = w * 64 + lane;
            const int b = item >> 5, qt = z ? 63 - (item & 31) : (item & 31), c = qt >> 1, q0 = 32 * qt, nsub = 2 * (c + 1);
            const size_t qr = (size_t)b * SEQ + q0 + r;
            unsigned* maskrow = MASK + qr * 64;
            if (c <= 3) {
                for (int st = w; st < nsub; st += 8) if (h == 0) maskrow[st] = 0xFFFFFFFFu;
                continue;
            }
            LAS unsigned char* QL = lds + 40960;
            const char* kbase = (const char*)(BKI + (size_t)b * SEQ * 64);
            const unsigned klane = ((unsigned)(32 * w + r) * 64u + 8u * h) * 2u;
            bf16x8 afn[4];
            f32x4 wq;
            { const int qq = tid >> 4, pc = tid & 15; const u32x4* src = (const u32x4*)(BQI + ((size_t)b * SEQ + q0 + qq) * 256 + 16 * pc);
              const u32x4 v0 = src[0], v1 = src[1];
              wq = *(const f32x4*)(WIDX + qr * 4);
              if (w < nsub) {
#pragma unroll
                  for (int ks = 0; ks < 4; ++ks) afn[ks] = *(const bf16x8*)(kbase + klane + 32 * ks);
              }
              *(LAS u32x4*)(QL + pc * 1024 + qq * 32) = v0; *(LAS u32x4*)(QL + pc * 1024 + qq * 32 + 16) = v1; }
            __syncthreads();
            unsigned key[8][16];
            const LAS unsigned char* qlr = QL + r * 32 + h * 16;
#pragma unroll
            for (int jj = 0; jj < 8; ++jj) {
                const int st = w + 8 * jj;
                if (st < nsub) {
                    bf16x8 af[4];
#pragma unroll
                    for (int ks = 0; ks < 4; ++ks) af[ks] = afn[ks];
                    if (jj < 7 && st + 8 < nsub) { const char* kp = kbase + (klane + (unsigned)(jj + 1) * 32768u);
#pragma unroll
                        for (int ks = 0; ks < 4; ++ks) afn[ks] = *(const bf16x8*)(kp + 32 * ks); }
                    f32x16 sc;
#pragma unroll
                    for (int t = 0; t < 16; ++t) sc[t] = 0.f;
#pragma unroll
                    for (int hh = 0; hh < 4; ++hh) {
                        f32x16 acc;
#pragma unroll
                        for (int t = 0; t < 16; ++t) acc[t] = 0.f;
#pragma unroll
                        for (int ks = 0; ks < 4; ++ks) acc = MFMA32(af[ks], *(const LAS bf16x8*)(qlr + (4 * hh + ks) * 1024), acc);
                        const float wh = wq[hh];
#pragma unroll
                        for (int t = 0; t < 16; ++t) sc[t] += wh * fmaxf(acc[t], 0.f);
                        if (IDX_HEAD_FENCE) asm volatile("" ::: "memory");
                    }
#pragma unroll
                    for (int t = 0; t < 16; ++t) key[jj][t] = sortable(sc[t]);
                } else {
#pragma unroll
                    for (int t = 0; t < 16; ++t) key[jj][t] = 0u;
                }
                asm volatile("" ::: "memory");
            }
            unsigned T = 0u, ge = 0u, gt = 0u;
            int par = 0;
            const int njj = (nsub - w + 7) >> 3;
#ifndef IDX_PACKED16
#define IDX_PACKED16 0
#endif
#ifndef IDX_EXTRA_SYNC
#define IDX_EXTRA_SYNC
#endif
#define IDX_COUNT_GE(CAND, TOT) do { unsigned cnt_ = 0u; \
                _Pragma("unroll") for (int jj = 0; jj < 8; ++jj) { if (jj < njj) { _Pragma("unroll") for (int t = 0; t < 16; ++t) cnt_ += (key[jj][t] >= (CAND)) ? 1u : 0u; } } \
                cnt_ += shxu(cnt_, 32, lane); LAS unsigned* buf_ = cntbuf + par * 256; par ^= 1; if (h == 0) buf_[w * 32 + r] = cnt_; __syncthreads(); \
                TOT = 0u; _Pragma("unroll") for (int ww = 0; ww < 8; ++ww) TOT += buf_[ww * 32 + r]; IDX_EXTRA_SYNC; } while (0)
            unsigned G = 0u;
#if IDX_PACKED16
            typedef short s16x2_t __attribute__((ext_vector_type(2))); typedef unsigned short u16x2_t __attribute__((ext_vector_type(2)));
            unsigned pk16[8][8];
#pragma unroll
            for (int jj = 0; jj < 8; ++jj)
#pragma unroll
                for (int p = 0; p < 8; ++p) pk16[jj][p] = (key[jj][2 * p] >> 17) | ((key[jj][2 * p + 1] >> 1) & 0x7FFF0000u);
#pragma unroll 1
            for (int bit = 31; bit >= 20; --bit) {
                const unsigned cand = T | (1u << bit); unsigned tot;
                const unsigned b1_ = cand >> 17, b2_ = b1_ | (b1_ << 16);
                u16x2_t lt_ = {0, 0};
#pragma unroll
                for (int jj = 0; jj < 8; ++jj) { if (jj < njj) {
#pragma unroll
                    for (int p = 0; p < 8; ++p) { const s16x2_t d_ = __builtin_bit_cast(s16x2_t, pk16[jj][p]) - __builtin_bit_cast(s16x2_t, b2_); lt_ += __builtin_bit_cast(u16x2_t, d_) >> (unsigned short)15; } } }
                const unsigned ltw_ = __builtin_bit_cast(unsigned, lt_);
                unsigned cnt_ = (unsigned)(16 * (njj > 0 ? njj : 0)) - ((ltw_ & 0xFFFFu) + (ltw_ >> 16));
                cnt_ += shxu(cnt_, 32, lane); LAS unsigned* buf_ = cntbuf + par * 256; par ^= 1; if (h == 0) buf_[w * 32 + r] = cnt_; __syncthreads();
                tot = 0u;
#pragma unroll
                for (int ww = 0; ww < 8; ++ww) tot += buf_[ww * 32 + r];
                if (tot >= 256u) { T = cand; ge = tot; } else G = tot;
            }
#else
#pragma unroll 1
            for (int bit = 31; bit >= 20; --bit) {
                const unsigned cand = T | (1u << bit); unsigned tot;
                IDX_COUNT_GE(cand, tot);
                if (tot >= 256u) { T = cand; ge = tot; } else G = tot;
            }
#endif
            const unsigned ncand = ge - G;
            const bool overflow = __builtin_amdgcn_ballot_w64(ncand > 256u) != 0ull;
            if (overflow) {
#pragma unroll 1
                for (int bit = 19; bit >= 0; --bit) {
                    const unsigned cand = T | (1u << bit); unsigned tot;
                    IDX_COUNT_GE(cand, tot);
                    if (tot >= 256u) { T = cand; ge = tot; }
                }
                unsigned tot; IDX_COUNT_GE(T + 1u, tot); gt = (T == 0xFFFFFFFFu) ? 0u : tot;
                __syncthreads();
            } else {
                LAS unsigned* clist = cntbuf + 1024;
                LAS unsigned* ccnt = clist + 8192;
                LAS unsigned* cres = ccnt + 32;
                __syncthreads();
                if (tid < 32) ccnt[tid] = 0u;
                if (w == 0 && h == 0) { cres[r * 4 + 0] = T; cres[r * 4 + 1] = G; }
                __syncthreads();
                {
#pragma unroll
                  for (int jj = 0; jj < 8; ++jj) { if (jj >= njj) continue;
                    unsigned pre = T >> 20; asm volatile("" : "+v"(pre));
#pragma unroll
                    for (int t = 0; t < 16; ++t) { const unsigned kv = key[jj][t];
                        if ((kv >> 20) == pre && kv != 0u) { const unsigned pos = __hip_atomic_fetch_add(ccnt + r, 1u, __ATOMIC_RELAXED, __HIP_MEMORY_SCOPE_WORKGROUP); clist[r * 256 + (pos & 255u)] = kv; } } } }
                __syncthreads();
                {
                    const int q = tid >> 4, s16 = tid & 15; const unsigned nq = ccnt[q]; unsigned Tq = cres[q * 4 + 0]; const unsigned Gq = cres[q * 4 + 1];
                    unsigned c[16];
#pragma unroll
                    for (int i = 0; i < 16; ++i) c[i] = ((unsigned)(16 * i + s16) < nq) ? clist[q * 256 + 16 * i + s16] : 0u;
#define IDX_ROW16_SUM(X) do { X += (unsigned)__builtin_amdgcn_update_dpp(0, (int)X, 0x128, 0xf, 0xf, false); X += (unsigned)__builtin_amdgcn_update_dpp(0, (int)X, 0x124, 0xf, 0xf, false); \
                        X += (unsigned)__builtin_amdgcn_update_dpp(0, (int)X, 0x122, 0xf, 0xf, false); X += (unsigned)__builtin_amdgcn_update_dpp(0, (int)X, 0x121, 0xf, 0xf, false); } while (0)
                    const unsigned nmax = max(max((unsigned)__builtin_amdgcn_readlane((int)nq, 0), (unsigned)__builtin_amdgcn_readlane((int)nq, 16)), max((unsigned)__builtin_amdgcn_readlane((int)nq, 32), (unsigned)__builtin_amdgcn_readlane((int)nq, 48)));
#define IDX_S2_ROUNDS(NI) do { _Pragma("unroll 1") for (int bit = 19; bit >= 0; --bit) { \
                        const unsigned cand = Tq | (1u << bit); unsigned cnt = 0u; \
                        _Pragma("unroll") for (int i = 0; i < (NI); ++i) cnt += (c[i] >= cand) ? 1u : 0u; \
                        IDX_ROW16_SUM(cnt); \
                        if (Gq + cnt >= 256u) Tq = cand; } } while (0)
                    if (nmax <= 64u) IDX_S2_ROUNDS(4); else if (nmax <= 128u) IDX_S2_ROUNDS(8); else IDX_S2_ROUNDS(16);
#undef IDX_S2_ROUNDS
                    unsigned cge = 0u, cgt = 0u;
#pragma unroll
                    for (int i = 0; i < 16; ++i) { cge += (c[i] >= Tq) ? 1u : 0u; cgt += (c[i] > Tq) ? 1u : 0u; }
                    IDX_ROW16_SUM(cge); IDX_ROW16_SUM(cgt);
                    if (s16 == 0) { cres[q * 4 + 0] = Tq; cres[q * 4 + 1] = Gq + cgt; cres[q * 4 + 2] = Gq + cge; }
                }
                __syncthreads();
                T = cres[r * 4 + 0]; gt = cres[r * 4 + 1]; ge = cres[r * 4 + 2];
                __syncthreads();
            }
            if (tid < 32) runb[tid] = 0u;
            __syncthreads();
#undef IDX_COUNT_GE
            const unsigned need = 256u - gt;
            asm volatile("" : "+v"(T));
            const bool anytie = __any(ge > 256u) != 0;
            unsigned idxT = 0xFFFFu; bool slow_ties = false;
            if (anytie) {
                LAS unsigned* clist = cntbuf + 1024; LAS unsigned* ccnt = clist + 8192; LAS unsigned* cres = ccnt + 32;
                __syncthreads();
                if (tid < 32) ccnt[tid] = 0u;
                if (w == 0 && h == 0) { cres[r * 4 + 1] = need; cres[r * 4 + 2] = ge; }
                __syncthreads();
#pragma unroll
                for (int jj = 0; jj < 8; ++jj) { if (jj >= njj) continue;
                    unsigned Tj = T; asm volatile("" : "+v"(Tj));
#pragma unroll
                    for (int t = 0; t < 16; ++t) { const unsigned kv = key[jj][t];
                        if (kv == Tj && kv != 0u) { const unsigned pos = __hip_atomic_fetch_add(ccnt + r, 1u, __ATOMIC_RELAXED, __HIP_MEMORY_SCOPE_WORKGROUP); if (pos < 256u) clist[r * 256 + pos] = (unsigned)(32 * (w + 8 * jj) + crow(t, h)); } } }
                __syncthreads();
                slow_ties = __builtin_amdgcn_ballot_w64(ge > 256u && ccnt[r] > 256u) != 0ull;
                if (!slow_ties) {
                    const int q = tid >> 4, s16 = tid & 15; const unsigned nq = ccnt[q], needq = cres[q * 4 + 1], geq = cres[q * 4 + 2];
                    unsigned c[16];
#pragma unroll
                    for (int i = 0; i < 16; ++i) c[i] = ((unsigned)(16 * i + s16) < nq) ? clist[q * 256 + 16 * i + s16] : 0xFFFFFFFFu;
                    unsigned cur = 0u;
#pragma unroll 1
                    for (int bit = 10; bit >= 0; --bit) {
                        const unsigned cand = cur | (1u << bit); unsigned cnt = 0u;
#pragma unroll
                        for (int i = 0; i < 16; ++i) cnt += (c[i] < cand) ? 1u : 0u;
                        IDX_ROW16_SUM(cnt);
                        if (cnt < needq) cur = cand;
                    }
                    if (s16 == 0) cres[q * 4 + 3] = (geq > 256u) ? cur : 0xFFFFu;
                    __syncthreads();
                    idxT = cres[r * 4 + 3];
                }
            }
#undef IDX_ROW16_SUM
            if (!slow_ties) {
#pragma unroll
                for (int jj = 0; jj < 8; ++jj) {
                    const int st = w + 8 * jj;
                    if (st < nsub) {
                        unsigned word = 0u;
#pragma unroll
                        for (int t = 0; t < 16; ++t) { const unsigned kv = key[jj][t]; const bool sel = (kv > T) || (kv == T && (unsigned)(32 * st + crow(t, h)) <= idxT);
                            word |= sel ? (1u << crow(t, h)) : 0u; }
                        word |= shxu(word, 32, lane);
                        if (h == 0) maskrow[st] = word;
                    }
                }
            } else {
#pragma unroll
                for (int jj = 0; jj < 8; ++jj) {
#pragma unroll 1
                    for (int ww = 0; ww < 8; ++ww) {
                        const int st = ww + 8 * jj;
                        if (st < nsub) {
                            if (w == ww) {
                                unsigned cg[4], pg[4];
#pragma unroll
                                for (int g4 = 0; g4 < 4; ++g4) { cg[g4] = 0u;
#pragma unroll
                                    for (int e = 0; e < 4; ++e) cg[g4] += (key[jj][4 * g4 + e] == T) ? 1u : 0u;
                                    pg[g4] = shxu(cg[g4], 32, lane); }
                                unsigned before = runb[r], word = 0u;
#pragma unroll
                                for (int g4 = 0; g4 < 4; ++g4) {
                                    unsigned rank = before + (h ? pg[g4] : 0u);
#pragma unroll
                                    for (int e = 0; e < 4; ++e) { const unsigned kv = key[jj][4 * g4 + e]; const bool eq = (kv == T);
                                        const bool sel = (kv > T) || (eq && rank < need); rank += eq ? 1u : 0u;
                                        word |= sel ? (1u << crow(4 * g4 + e, h)) : 0u; }
                                    before += cg[g4] + pg[g4];
                                }
                                word |= shxu(word, 32, lane);
                                if (h == 0) { maskrow[st] = word; runb[r] = before; }
                            }
                            __syncthreads();
                        }
                    }
                }
            }
            __syncthreads();
        }
    }
}
__device__ __forceinline__ float max3f(float a, float b, float c) { float r; asm("v_max3_f32 %0, %1, %2, %3" : "=v"(r) : "v"(a), "v"(b), "v"(c)); return r; }
__device__ __forceinline__ int pi32(int r) { return (r & ~12) | ((r & 4) << 1) | ((r & 8) >> 1); }
constexpr int AT_KPE = 8192, AT_VSLOT = 8192;
template <int MODE> struct AtMap { static constexpr int KSLOT = (MODE == 0) ? 12288 : 8192, VR = 4 * KSLOT, MASK = VR + 5 * AT_VSLOT; };
static_assert(AtMap<1>::MASK + 8 * 32 * 65 * 4 <= 147456 - 64 && AtMap<0>::MASK <= 147456 - 64, "attention LDS map");
template <int MODE>
__device__ __forceinline__ void attn_stage(LAS unsigned char* lds, int ks_, int vs_, const bf16_t* k1, int ldk1, const bf16_t* k2, const bf16_t* vt, int kt, unsigned voK, unsigned voV, unsigned voP, int wave) {
    const char* kb = (const char*)(k1 + (size_t)kt * ldk1); const char* vb = (const char*)(vt + (size_t)kt * 64);
    __builtin_amdgcn_global_load_lds((const unsigned*)(kb + voK), (LAS unsigned*)(lds + ks_ * AtMap<MODE>::KSLOT + wave * 1024), 16, 0, 0);
    __builtin_amdgcn_global_load_lds((const unsigned*)(vb + voV), (LAS unsigned*)(lds + AtMap<MODE>::VR + vs_ * AT_VSLOT + wave * 1024), 16, 0, 0);
    if (MODE == 0) { if (wave < 4) { const char* pb = (const char*)(k2 + (size_t)kt * 32);
        __builtin_amdgcn_global_load_lds((const unsigned*)(pb + voP), (LAS unsigned*)(lds + ks_ * AtMap<MODE>::KSLOT + AT_KPE + wave * 1024), 16, 0, 0); } }
}
template <int NKS, int MODE>
__device__ __forceinline__ void attn_wg_item(LAS unsigned char* lds, const bf16_t* qrow, const bf16_t* k1, int ldk1, const bf16_t* k2, const bf16_t* vt,
                                             int kt_begin, int kt_end, int my_end, const unsigned* maskrow, float sink_l2, bf16_t* orow, int tid, int wave, int lane) {
    const int r = lane & 31, h = lane >> 5, pr = pi32(r);
    bf16x8 qf[NKS];
#pragma unroll
    for (int ks = 0; ks < NKS; ++ks) qf[ks] = *(const bf16x8*)(qrow + 16 * ks + 8 * h);
#pragma unroll
    for (int ks = 0; ks < NKS; ++ks) asm volatile("" :: "v"(qf[ks]));
    f32x16 o0, o1, s0, s1;
#pragma unroll
    for (int t = 0; t < 16; ++t) { o0[t] = 0.f; o1[t] = 0.f; s0[t] = 0.f; s1[t] = 0.f; }
    float mref = 0.f, l = 0.f; bool init = false;
    const int kx0 = pr * 128, kx1 = (32 + pr) * 128, ksw = (pr >> 1) & 7;
    const int px0 = AT_KPE + pr * 64, px1 = AT_KPE + (32 + pr) * 64, psw = (pr >> 2) & 3;
    const int vx0 = AtMap<MODE>::VR + r * 128, vx1 = AtMap<MODE>::VR + (32 + r) * 128, vsw = (r >> 1) & 7;
    const bool skew = wave >= 4;
    __syncthreads();
    LAS unsigned* mrow = (LAS unsigned*)(lds + AtMap<MODE>::MASK) + (wave * 32 + r) * 65;
    if (MODE == 1) {
        LAS unsigned* mw = (LAS unsigned*)(lds + AtMap<MODE>::MASK) + (wave * 32) * 65;
        const unsigned* mg = maskrow;
        const int nw = my_end >> 5;
        const unsigned lo4 = (unsigned)lane * 4u;
        for (int q = 0; q < 32; ++q) { const char* mq = (const char*)(mg + (size_t)q * 64); if (lane < nw) mw[q * 65 + lane] = *(const unsigned*)(mq + lo4); }
        asm volatile("s_waitcnt vmcnt(0)" ::: "memory");
    }
    const int ntile = (kt_end - kt_begin) >> 6;
    unsigned voK, voV, voP;
    { const int row = tid >> 3, cp = tid & 7, c = cp ^ ((row >> 1) & 7); voK = (unsigned)(row * ldk1 + 8 * c) * 2u; voV = (unsigned)(row * 64 + 8 * c) * 2u;
      const int key = (tid & 255) >> 2, cq = tid & 3, cc = cq ^ ((key >> 2) & 3); voP = (unsigned)(key * 32 + 8 * cc) * 2u; }
    attn_stage<MODE>(lds, 0, 0, k1, ldk1, k2, vt, kt_begin, voK, voV, voP, wave);
    if (ntile > 1) attn_stage<MODE>(lds, 1, 1, k1, ldk1, k2, vt, kt_begin + 64, voK, voV, voP, wave);
    if (ntile > 2) attn_stage<MODE>(lds, 2, 2, k1, ldk1, k2, vt, kt_begin + 128, voK, voV, voP, wave);
#define AT_QK(KSL) do { const LAS unsigned char* B_ = lds + (KSL) * AtMap<MODE>::KSLOT; bf16x8 ka_[NKS], kb_[NKS]; \
        _Pragma("unroll") for (int ks = 0; ks < NKS; ++ks) { \
            if (ks < 4) { const int sw = ((2 * ks + h) ^ ksw) << 4; ka_[ks] = *(const LAS bf16x8*)(B_ + kx0 + sw); kb_[ks] = *(const LAS bf16x8*)(B_ + kx1 + sw); } \
            else { const int sw = ((2 * (ks - 4) + h) ^ psw) << 4; ka_[ks] = *(const LAS bf16x8*)(B_ + px0 + sw); kb_[ks] = *(const LAS bf16x8*)(B_ + px1 + sw); } } \
        __builtin_amdgcn_sched_barrier(0); \
        _Pragma("unroll") for (int t = 0; t < 16; ++t) { s0[t] = 0.f; s1[t] = 0.f; } \
        _Pragma("unroll") for (int ks = 0; ks < NKS; ++ks) { s0 = MFMA32(ka_[ks], qf[ks], s0); s1 = MFMA32(kb_[ks], qf[ks], s1); } \
        __builtin_amdgcn_sched_barrier(0); } while (0)
#define AT_SMPV(KT, VSL) do { const LAS unsigned char* V_ = lds + (VSL) * AT_VSLOT; \
        unsigned w0 = 0u, w1 = 0u; if (MODE == 1) { w0 = mrow[(KT) >> 5] >> (8 * h); w1 = mrow[((KT) >> 5) + 1] >> (8 * h); } \
        float mxl = fmaxf(s0[0], s1[0]); _Pragma("unroll") for (int t = 1; t < 16; ++t) mxl = max3f(mxl, s0[t], s1[t]); \
        if (__builtin_amdgcn_ballot_w64((mxl - mref > 8.0f) || !init) != 0ull) { \
            if (MODE == 1) { _Pragma("unroll") for (int t = 0; t < 16; ++t) { const int bit = (t & 3) + 4 * ((t >> 2) & 1) + 16 * (t >> 3); \
                if (!((w0 >> bit) & 1u)) s0[t] = -INFINITY; if (!((w1 >> bit) & 1u)) s1[t] = -INFINITY; } } \
            float mx = fmaxf(s0[0], s1[0]); _Pragma("unroll") for (int t = 1; t < 16; ++t) mx = max3f(mx, s0[t], s1[t]); \
            mx = fmaxf(mx, shx(mx, 32, lane)); const bool seen = mx > -INFINITY; \
            const float mnew = init ? fmaxf(mx, mref) : (seen ? mx : 0.f); const float alpha = init ? __builtin_amdgcn_exp2f(mref - mnew) : 1.0f; \
            init = init || seen; mref = mnew; l *= alpha; \
            _Pragma("unroll") for (int t = 0; t < 16; ++t) { o0[t] *= alpha; o1[t] *= alpha; } } \
        float ps0 = 0.f, ps1 = 0.f; \
        _Pragma("unroll") for (int t = 0; t < 16; ++t) { float p0 = __builtin_amdgcn_exp2f(s0[t] - mref), p1 = __builtin_amdgcn_exp2f(s1[t] - mref); \
            if (MODE == 1) { const int bit = (t & 3) + 4 * ((t >> 2) & 1) + 16 * (t >> 3); \
                p0 = __uint_as_float(__float_as_uint(p0) & (unsigned)__builtin_amdgcn_sbfe((int)w0, bit, 1)); p1 = __uint_as_float(__float_as_uint(p1) & (unsigned)__builtin_amdgcn_sbfe((int)w1, bit, 1)); } \
            s0[t] = p0; s1[t] = p1; ps0 += p0; ps1 += p1; } \
        l += ps0 + ps1; \
        bf16x8 va_[4], vb_[4]; \
        _Pragma("unroll") for (int s4 = 0; s4 < 4; ++s4) { const int sw = ((2 * s4 + h) ^ vsw) << 4; va_[s4] = *(const LAS bf16x8*)(V_ + vx0 + sw); vb_[s4] = *(const LAS bf16x8*)(V_ + vx1 + sw); } \
        bf16x8 pb[4]; pb[0] = pack8(s0, 0); pb[1] = pack8(s0, 1); pb[2] = pack8(s1, 0); pb[3] = pack8(s1, 1); \
        __builtin_amdgcn_sched_barrier(0); \
        _Pragma("unroll") for (int s4 = 0; s4 < 4; ++s4) { o0 = MFMA32(va_[s4], pb[s4], o0); o1 = MFMA32(vb_[s4], pb[s4], o1); } \
        __builtin_amdgcn_sched_barrier(0); } while (0)
    int ksl = 0, vsl = 0;
#pragma unroll 1
    for (int ti = 0; ti <= ntile; ++ti) {
        const int kt = kt_begin + 64 * ti;
        if (ti + 2 < ntile) { if (MODE == 0 && wave < 4) asm volatile("s_waitcnt vmcnt(6)" ::: "memory"); else asm volatile("s_waitcnt vmcnt(4)" ::: "memory"); }
        else if (ti + 1 < ntile) { if (MODE == 0 && wave < 4) asm volatile("s_waitcnt vmcnt(3)" ::: "memory"); else asm volatile("s_waitcnt vmcnt(2)" ::: "memory"); }
        else asm volatile("s_waitcnt vmcnt(0)" ::: "memory");
        __builtin_amdgcn_s_barrier();
        asm volatile("" ::: "memory");
        if (ti + 3 < ntile) attn_stage<MODE>(lds, (ksl + 3) & 3, (vsl + 3 >= 5) ? vsl - 2 : vsl + 3, k1, ldk1, k2, vt, kt + 192, voK, voV, voP, wave);
        const bool cur_ok = (ti < ntile) && (kt < my_end);
        if (!skew && cur_ok) AT_QK(ksl);
        { const int xt = skew ? kt - 64 : kt, xv = skew ? ((vsl == 0) ? 4 : vsl - 1) : vsl;
          if (xt >= kt_begin && xt < kt_end && xt < my_end) AT_SMPV(xt, xv); }
        if (skew && cur_ok) AT_QK(ksl);
        ksl = (ksl + 1) & 3; vsl = (vsl == 4) ? 0 : vsl + 1;
    }
#undef AT_QK
#undef AT_SMPV
    float lt = l + shx(l, 32, lane);
    if (MODE == 2) lt += __builtin_amdgcn_exp2f(sink_l2 - mref);
    const float inv = 1.0f / lt;
#pragma unroll
    for (int g = 0; g < 4; ++g) {
        u32x2 w0, w1;
        w0.x = pk2(o0[4 * g] * inv, o0[4 * g + 1] * inv); w0.y = pk2(o0[4 * g + 2] * inv, o0[4 * g + 3] * inv);
        w1.x = pk2(o1[4 * g] * inv, o1[4 * g + 1] * inv); w1.y = pk2(o1[4 * g + 2] * inv, o1[4 * g + 3] * inv);
        *(u32x2*)(orow + 8 * g + 4 * h) = w0; *(u32x2*)(orow + 32 + 8 * g + 4 * h) = w1;
    }
}

#define A5_SB() __builtin_amdgcn_sched_barrier(0)
#ifndef A5_NEGM
#define A5_NEGM 1
#endif
#ifndef A5_GV
#define A5_GV 2
#endif
#ifndef A5_GK
#define A5_GK 5
#endif
#ifndef A5_TRIG
#define A5_TRIG 256.0f
#endif
#ifndef A5_RISE
#define A5_RISE 8.0f
#endif
#ifndef A5_LSUM
#define A5_LSUM 0
#endif
#ifndef A5_WIDE_STORE
#define A5_WIDE_STORE 1
#endif
#ifndef A5_MASK_DMA
#define A5_MASK_DMA 1
#endif
#ifndef BR_F8
#define BR_F8 1
#endif
#if BR_F8
#define A5_OPTR(base, off) ((bf16_t*)((unsigned char*)(base) + (off)))
#else
#define A5_OPTR(base, off) ((base) + (off))
#endif
#ifndef A5_VLATE
#define A5_VLATE 1
#endif
template <int MODE> struct A5Map { static constexpr int KSLOT = (MODE == 0) ? 12288 : 8192, NKR = (MODE == 0) ? 5 : 4, VR = NKR * KSLOT, MASK = VR + 5 * AT_VSLOT; };
static_assert(A5Map<1>::MASK + 8 * 32 * 65 * 4 <= 147456 - 64 && A5Map<0>::MASK <= 147456 - 64, "attention v5 LDS map");
template <int MODE> __device__ __forceinline__ void a5_stage_k(LAS unsigned char* lds, int slot, const bf16_t* k1, int ldk1, const bf16_t* k2, int kt, unsigned voK, unsigned voP, int wave) {
    const char* kb = (const char*)(k1 + (size_t)kt * ldk1);
    __builtin_amdgcn_global_load_lds((const unsigned*)(kb + voK), (LAS unsigned*)(lds + slot * A5Map<MODE>::KSLOT + wave * 1024), 16, 0, 0);
    if (MODE == 0) { if (wave < 4) { const char* pb = (const char*)(k2 + (size_t)kt * 32);
        __builtin_amdgcn_global_load_lds((const unsigned*)(pb + voP), (LAS unsigned*)(lds + slot * A5Map<MODE>::KSLOT + AT_KPE + wave * 1024), 16, 0, 0); } }
}
template <int MODE> __device__ __forceinline__ void a5_stage_v(LAS unsigned char* lds, int slot, const bf16_t* vt, int kt, unsigned voV, int wave) {
    const char* vb = (const char*)(vt + (size_t)kt * 64);
    __builtin_amdgcn_global_load_lds((const unsigned*)(vb + voV), (LAS unsigned*)(lds + A5Map<MODE>::VR + slot * AT_VSLOT + wave * 1024), 16, 0, 0);
}
__device__ __forceinline__ void a5_wait_bar(int allowed) {
    if (allowed >= 6) asm volatile("s_waitcnt vmcnt(6) lgkmcnt(0)\n\ts_barrier" ::: "memory");
    else if (allowed >= 4) asm volatile("s_waitcnt vmcnt(4) lgkmcnt(0)\n\ts_barrier" ::: "memory");
    else if (allowed == 3) asm volatile("s_waitcnt vmcnt(3) lgkmcnt(0)\n\ts_barrier" ::: "memory");
    else if (allowed == 2) asm volatile("s_waitcnt vmcnt(2) lgkmcnt(0)\n\ts_barrier" ::: "memory");
    else if (allowed == 1) asm volatile("s_waitcnt vmcnt(1) lgkmcnt(0)\n\ts_barrier" ::: "memory");
    else asm volatile("s_waitcnt vmcnt(0) lgkmcnt(0)\n\ts_barrier" ::: "memory");
}
template <int NKS, int MODE, int PV = 0>
__device__ __forceinline__ void attn5_item(LAS unsigned char* lds, const bf16_t* qrow, const bf16_t* k1, int ldk1, const bf16_t* k2, const bf16_t* vt,
                                           int kt_begin, int nt, int ntm, const unsigned* maskrow, float sink_l2, bf16_t* orow, int tid, int wave, int lane) {
    constexpr int KSLOT = A5Map<MODE>::KSLOT, VR = A5Map<MODE>::VR, NKR = A5Map<MODE>::NKR;
    const int r = lane & 31, h = lane >> 5, pr = pi32(r);
    const unsigned ko0 = (unsigned)(pr * 128 + ((h ^ ((pr >> 1) & 7)) << 4)), kp0 = (unsigned)(AT_KPE + pr * 64 + ((h ^ ((pr >> 2) & 3)) << 4)), vo0 = (unsigned)(r * 128 + ((h ^ ((r >> 1) & 7)) << 4));
    unsigned voK, voV, voP;
    { const int row = tid >> 3, cp = tid & 7, c = cp ^ ((row >> 1) & 7); voK = (unsigned)(row * ldk1 + 8 * c) * 2u; voV = (unsigned)(row * 64 + 8 * c) * 2u;
      const int key = (tid & 255) >> 2, cq = tid & 3, cc = cq ^ ((key >> 2) & 3); voP = (unsigned)(key * 32 + 8 * cc) * 2u; }
    const int KP = (MODE == 0 && wave < 4) ? 2 : 1;
    asm volatile("s_waitcnt lgkmcnt(0)\n\ts_barrier" ::: "memory");
    LAS unsigned* mrow = (LAS unsigned*)(lds + A5Map<MODE>::MASK) + (wave * 32 + r) * 65;
    a5_stage_k<MODE>(lds, 0, k1, ldk1, k2, kt_begin, voK, voP, wave);
    a5_stage_v<MODE>(lds, 0, vt, kt_begin, voV, wave);
    if (nt > 1) { a5_stage_k<MODE>(lds, 1, k1, ldk1, k2, kt_begin + 64, voK, voP, wave); a5_stage_v<MODE>(lds, 1, vt, kt_begin + 64, voV, wave); }
    if (nt > 2) { a5_stage_k<MODE>(lds, 2, k1, ldk1, k2, kt_begin + 128, voK, voP, wave); a5_stage_v<MODE>(lds, 2, vt, kt_begin + 128, voV, wave); }
    if (nt > 3) a5_stage_k<MODE>(lds, 3, k1, ldk1, k2, kt_begin + 192, voK, voP, wave);
    bf16x8 qf[NKS];
#pragma unroll
    for (int ks = 0; ks < NKS; ++ks) qf[ks] = *(const bf16x8*)(qrow + 16 * ks + 8 * h);
    if (MODE == 1) {
        LAS unsigned* mw = (LAS unsigned*)(lds + A5Map<MODE>::MASK) + (wave * 32) * 65;
        const unsigned lo4 = (unsigned)lane * 4u;
#if A5_MASK_DMA
#pragma unroll 4
        for (int q = 0; q < 32; ++q) { const char* mq = (const char*)(maskrow + (size_t)q * 64);
            __builtin_amdgcn_global_load_lds((const unsigned*)(mq + lo4), (LAS unsigned*)(mw + q * 65), 4, 0, 0); }
#else
#pragma unroll 8
        for (int q = 0; q < 32; ++q) { const char* mq = (const char*)(maskrow + (size_t)q * 64); mw[q * 65 + lane] = *(const unsigned*)(mq + lo4); }
#endif
    }
#pragma unroll
    for (int ks = 0; ks < NKS; ++ks) asm volatile("" :: "v"(qf[ks]));
    asm volatile("s_waitcnt vmcnt(0) lgkmcnt(0)\n\ts_barrier" ::: "memory");
    f32x16 C[2], o0, o1; float P[32];
    bf16x8 kf[2 * NKS], vf[8]; u32x4 pw[4];
#pragma unroll
    for (int t = 0; t < 16; ++t) { o0[t] = 0.f; o1[t] = 0.f; }
    constexpr bool NEGM = A5_NEGM != 0;
    constexpr bool LSUM = (MODE == 1) && (A5_LSUM != 0);
    float mref = 0.f, l = 0.f, al_pend = 1.f, al_a = 1.f; bool pend = false, pend_a = false; f32x16 negm, lacc;
    bf16x8 ones_;
#pragma unroll
    for (int t = 0; t < 16; ++t) lacc[t] = 0.f;
#pragma unroll
    for (int t = 0; t < 8; ++t) ones_[t] = (short)0x3F80;
    if (PV != 0) { _Pragma("unroll") for (int i_ = 0; i_ < 4; ++i_) { pw[i_].x = 0x3c003c00u; pw[i_].y = 0x3c003c00u; pw[i_].z = 0x3c003c00u; pw[i_].w = 0x3c003c00u; }
                   _Pragma("unroll") for (int i_ = 0; i_ < 8; ++i_) vf[i_] = qf[i_ % NKS]; _Pragma("unroll") for (int i_ = 8; i_ < 2 * NKS; ++i_) kf[i_] = qf[i_ % NKS]; }
#define A5_DSRD(dst, addr, OFF) asm volatile("ds_read_b128 %0, %1 offset:%2" : "=&v"(dst) : "v"(addr), "i"(OFF))
#define A5_KRD(i, KA) do { if (((i) >> 1) < 4) A5_DSRD(kf[i], ((KA) + ko0) ^ (unsigned)(((i) >> 1) << 5), ((i) & 1) ? 4096 : 0); \
                           else A5_DSRD(kf[i], ((KA) + kp0) ^ (unsigned)((((i) >> 1) - 4) << 5), ((i) & 1) ? 2048 : 0); } while (0)
#define A5_VRD(i, VA) A5_DSRD(vf[i], ((VA) + vo0) ^ (unsigned)(((i) >> 1) << 5), ((i) & 1) ? 4096 : 0)
#define A5_LGKM(N, x) asm volatile("s_waitcnt lgkmcnt(%1)" : "+v"(x) : "n"(N))
#define A5_SUMPK(g) do { const int b_ = 4 * (g); \
        if (!LSUM) { sacc += P[b_]; sacc += P[b_ + 1]; sacc += P[b_ + 2]; sacc += P[b_ + 3]; asm volatile("" : "+v"(sacc)); } \
        pw[(g) >> 1][((g) & 1) * 2] = pk2(P[b_], P[b_ + 1]); pw[(g) >> 1][((g) & 1) * 2 + 1] = pk2(P[b_ + 2], P[b_ + 3]); \
        if ((g) & 1) asm volatile("" : "+v"(pw[(g) >> 1])); } while (0)
#define A5_EXP(j) do { _Pragma("unroll") for (int e_ = 4 * (j); e_ < 4 * (j) + 4; ++e_) { const int a_ = e_ >> 4, t_ = e_ & 15; \
        float p_ = __builtin_amdgcn_exp2f(NEGM ? C[a_][t_] : C[a_][t_] - mref); \
        if (MODE == 1) { const int bit_ = (t_ & 3) + 4 * ((t_ >> 2) & 1) + 16 * (t_ >> 3); p_ = __uint_as_float(__float_as_uint(p_) & (unsigned)__builtin_amdgcn_sbfe((int)(a_ ? w1 : w0), bit_, 1)); } \
        P[e_] = p_; } \
        asm volatile("" : "+v"(P[4 * (j)]), "+v"(P[4 * (j) + 1]), "+v"(P[4 * (j) + 2]), "+v"(P[4 * (j) + 3])); } while (0)
    {
        const unsigned KB0 = (unsigned)(size_t)lds;
#pragma unroll
        for (int i = 0; i < 8; ++i) A5_KRD(i, KB0);
        asm volatile("s_waitcnt lgkmcnt(0)\n\ts_barrier" ::: "memory");
#pragma unroll
        for (int i = 0; i < 8; ++i) asm volatile("" : "+v"(kf[i]));
    }
    int vprev = 4, kcur = 0;
#define A5_ISSUE_V(t) do { if (PV != 1 && (t) + 3 < nt) a5_stage_v<MODE>(lds, (vprev + 4 >= 5) ? vprev - 1 : vprev + 4, vt, kt_begin + 64 * (t) + 192, voV, wave); } while (0)
#define A5_ISSUE_K(t) do { if (PV != 1 && (t) + 4 < nt) a5_stage_k<MODE>(lds, (NKR == 4) ? kcur : ((kcur == 0) ? 4 : kcur - 1), k1, ldk1, k2, kt_begin + 64 * (t) + 256, voK, voP, wave); } while (0)
#define A5_SLOTS() \
        const int knext = (kcur == NKR - 1) ? 0 : kcur + 1; \
        const unsigned KBn = (unsigned)(size_t)lds + knext * KSLOT, KBc = (unsigned)(size_t)lds + kcur * KSLOT, VBp = (unsigned)(size_t)lds + VR + vprev * AT_VSLOT; (void)KBn; (void)KBc; (void)VBp;
#define A5_ISSUE(t) A5_ISSUE_V(t); A5_ISSUE_K(t); A5_SLOTS()
#define A5_CLOSE(t) do { int allowed_; \
        if ((t) + 2 < nt) allowed_ = 1 + (((t) + 3 < nt) ? KP + 1 : 0) + (((t) + 4 < nt) ? KP : 0); \
        else allowed_ = ((t) + 1 < nt) ? KP + 1 : 0; \
        a5_wait_bar(allowed_); vprev = (vprev == 4) ? 0 : vprev + 1; kcur = knext; \
        _Pragma("unroll") for (int i_ = 0; i_ < 8; ++i_) asm volatile("" : "+v"(kf[i_])); } while (0)
    {
        A5_ISSUE(0);
        unsigned w0 = 0u, w1 = 0u; if (MODE == 1) { w0 = mrow[0] >> (8 * h); w1 = mrow[1] >> (8 * h); }
#pragma unroll
        for (int i = 8; i < 2 * NKS; ++i) A5_KRD(i, KBc);
#pragma unroll
        for (int i = 8; i < 2 * NKS; ++i) A5_LGKM(0, kf[i]);
#pragma unroll
        for (int i = 0; i < 2 * NKS; ++i) {
            if (i < 2) { f32x16 z_; _Pragma("unroll") for (int t_ = 0; t_ < 16; ++t_) z_[t_] = 0.f; C[i & 1] = MFMA32(kf[i], qf[i >> 1], z_); }
            else C[i & 1] = MFMA32(kf[i], qf[i >> 1], C[i & 1]);
        }
        A5_SB();
        {
            asm volatile("s_nop 15\n\ts_nop 3" : "+v"(C[0]), "+v"(C[1]) :: "memory");
            float ma_ = max3f(C[0][0], C[0][1], C[0][2]), mb_ = max3f(C[1][0], C[1][1], C[1][2]);
            _Pragma("unroll") for (int t_ = 3; t_ < 15; t_ += 2) { ma_ = max3f(ma_, C[0][t_], C[0][t_ + 1]); mb_ = max3f(mb_, C[1][t_], C[1][t_ + 1]); }
            float mx_ = max3f(ma_, mb_, C[0][15]); mx_ = max3f(mx_, C[1][15], C[1][15]);
            mref = fmaxf(mx_, shx(mx_, 32, lane));
            if (NEGM) { _Pragma("unroll") for (int t_ = 0; t_ < 16; ++t_) { C[0][t_] -= mref; C[1][t_] -= mref; negm[t_] = -mref; } }
        }
#pragma unroll
        for (int i = 0; i < 8; ++i) A5_KRD(i, KBn);
#pragma unroll
        for (int j = 0; j < 8; ++j) A5_EXP(j);
        A5_SB();
        A5_CLOSE(0);
    }
#pragma unroll 1
    for (int t = 1; t < ntm; ++t) {
        if (A5_GV < 0) A5_ISSUE_V(t);
        if (A5_GK < 0) A5_ISSUE_K(t);
        A5_SLOTS();
        unsigned w0 = 0u, w1 = 0u;
        if (MODE == 1) { const unsigned ma_ = (unsigned)(size_t)mrow + 8u * (unsigned)t;
            asm volatile("ds_read_b32 %0, %1" : "=&v"(w0) : "v"(ma_)); asm volatile("ds_read_b32 %0, %1 offset:4" : "=&v"(w1) : "v"(ma_)); }
        float sacc = 0.f;
        A5_SB();
#pragma unroll
        for (int i = 0; i < 2 * NKS; ++i) {
            if (PV != 4) { if (A5_VLATE ? (i >= 2 * NKS - 3) : (i >= 2 * NKS - 8)) A5_VRD(i - (A5_VLATE ? 2 * NKS - 3 : 2 * NKS - 8), VBp); }
            if (PV != 4) { if (NKS > 4 && i < 2 * NKS - 8) A5_KRD(8 + i, KBc); }
            if (NKS > 4 && i >= 8) A5_LGKM(A5_VLATE ? 3 : 8, kf[i]);
            if (PV != 3) { if (i < 2 && !NEGM) { f32x16 z_; _Pragma("unroll") for (int t_ = 0; t_ < 16; ++t_) z_[t_] = 0.f; C[i & 1] = MFMA32(kf[i], qf[i >> 1], z_); }
                           else C[i & 1] = MFMA32(kf[i], qf[i >> 1], (i < 2) ? negm : C[i & 1]); }
            if (PV != 2) { if (i < 8) A5_SUMPK(i); }
            A5_SB();
            if (i == A5_GV) { A5_ISSUE_V(t); A5_SB(); }
            if (i == A5_GK) { A5_ISSUE_K(t); A5_SB(); }
        }
        l += sacc;
        if (LSUM) {
            if (t + 1 < ntm && __builtin_amdgcn_ballot_w64(lacc[0] > 4294967296.0f) != 0ull) {
                const float rise_ = __builtin_amdgcn_logf(fmaxf(lacc[0], 1.0f)), dl_ = (rise_ > 8.0f) ? rise_ : 0.f;
                al_a = __builtin_amdgcn_exp2f(-dl_); mref += dl_; pend_a = true;
                if (NEGM) { _Pragma("unroll") for (int t_ = 0; t_ < 16; ++t_) negm[t_] = -mref; }
            }
        } else
        if (PV != 2 && t + 1 < ntm && __builtin_amdgcn_ballot_w64(sacc > A5_TRIG) != 0ull) {
            float ma_ = max3f(P[0], P[1], P[2]), mb_ = max3f(P[3], P[4], P[5]);
#pragma unroll
            for (int e_ = 6; e_ < 30; e_ += 4) { ma_ = max3f(ma_, P[e_], P[e_ + 1]); mb_ = max3f(mb_, P[e_ + 2], P[e_ + 3]); }
            float mxp_ = max3f(ma_, mb_, P[30]); mxp_ = fmaxf(mxp_, P[31]); mxp_ = fmaxf(mxp_, shx(mxp_, 32, lane));
            const float rise_ = __builtin_amdgcn_logf(fmaxf(mxp_, 1.0f)), dl_ = (rise_ > A5_RISE) ? rise_ : 0.f;
            al_a = __builtin_amdgcn_exp2f(-dl_); mref += dl_; pend_a = true;
            if (NEGM) { _Pragma("unroll") for (int t_ = 0; t_ < 16; ++t_) negm[t_] = -mref; }
        }
#pragma unroll
        for (int j = 0; j < 8; ++j) {
            if (PV != 4) { if (j >= 2 && j < 6) { A5_KRD(2 * (j - 2), KBn); A5_KRD(2 * (j - 2) + 1, KBn); } }
            if (PV != 4 && A5_VLATE) { if (j < 5) A5_VRD(j + 3, VBp); }
            { constexpr int NW0[8] = {7, 6, 7, 8, 9, 10, 9, 8}, NW1[8] = {3, 3, 5, 7, 9, 8, 5, 2};
              if (MODE == 1 && j == 0) { asm volatile("s_waitcnt lgkmcnt(%3)" : "+v"(vf[0]), "+v"(w0), "+v"(w1) : "n"(A5_VLATE ? 3 : 7)); w0 >>= 8 * h; w1 >>= 8 * h; }
              else A5_LGKM(A5_VLATE ? NW1[j] : NW0[j], vf[j]); }
            if (PV != 3) { if (j & 1) o1 = MFMA32(vf[j], __builtin_bit_cast(bf16x8, pw[j >> 1]), o1); else o0 = MFMA32(vf[j], __builtin_bit_cast(bf16x8, pw[j >> 1]), o0); }
            if (LSUM && (j & 1)) lacc = MFMA32(ones_, __builtin_bit_cast(bf16x8, pw[j >> 1]), lacc);
            if (PV != 2) A5_EXP(j);
            A5_SB();
        }
        A5_CLOSE(t);
        if (pend) {
#pragma unroll
            for (int t_ = 0; t_ < 16; ++t_) { o0[t_] *= al_pend; o1[t_] *= al_pend; }
            l *= al_pend; pend = false;
            if (LSUM) { _Pragma("unroll") for (int t_ = 0; t_ < 16; ++t_) lacc[t_] *= al_pend; }
        }
        if (pend_a) { pend = true; al_pend = al_a; pend_a = false; }
    }
    {
        if (ntm < nt) { A5_ISSUE(ntm); (void)knext; }
        const unsigned VBl = (unsigned)(size_t)lds + VR + vprev * AT_VSLOT;
        float sacc = 0.f;
#pragma unroll
        for (int i = 0; i < 8; ++i) A5_VRD(i, VBl);
#pragma unroll
        for (int g = 0; g < 8; ++g) A5_SUMPK(g);
#pragma unroll
        for (int i = 0; i < 8; ++i) A5_LGKM(0, vf[i]);
        l += sacc;
        A5_SB();
#pragma unroll
        for (int j = 0; j < 8; ++j) { if (j & 1) o1 = MFMA32(vf[j], __builtin_bit_cast(bf16x8, pw[j >> 1]), o1); else o0 = MFMA32(vf[j], __builtin_bit_cast(bf16x8, pw[j >> 1]), o0);
            if (LSUM && (j & 1)) lacc = MFMA32(ones_, __builtin_bit_cast(bf16x8, pw[j >> 1]), lacc); }
        A5_SB();
    }
#pragma unroll 1
    for (int t = ntm; t < nt; ++t) {
        if (t > ntm) { A5_ISSUE(t); A5_CLOSE(t); }
        else { const int knext = (kcur == NKR - 1) ? 0 : kcur + 1; A5_CLOSE(t); }
    }
#undef A5_ISSUE
#undef A5_ISSUE_V
#undef A5_ISSUE_K
#undef A5_SLOTS
#undef A5_CLOSE
#undef A5_KRD
#undef A5_DSRD
#undef A5_LGKM
#undef A5_VRD
#undef A5_SUMPK
#undef A5_EXP
    float lt = LSUM ? lacc[0] : l + shx(l, 32, lane);
    if (MODE == 2) lt += __builtin_amdgcn_exp2f(sink_l2 - mref);
    const float inv = 1.0f / lt;
#if BR_F8
    { const float inv16 = inv * 16.0f;
#pragma unroll
      for (int p = 0; p < 2; ++p) { const int ge = 2 * p, go = 2 * p + 1; int xe0 = 0, xo0 = 0, xe1 = 0, xo1 = 0;
        xe0 = f8x4(o0[4 * ge] * inv16, o0[4 * ge + 1] * inv16, o0[4 * ge + 2] * inv16, o0[4 * ge + 3] * inv16); xo0 = f8x4(o0[4 * go] * inv16, o0[4 * go + 1] * inv16, o0[4 * go + 2] * inv16, o0[4 * go + 3] * inv16);
        xe1 = f8x4(o1[4 * ge] * inv16, o1[4 * ge + 1] * inv16, o1[4 * ge + 2] * inv16, o1[4 * ge + 3] * inv16); xo1 = f8x4(o1[4 * go] * inv16, o1[4 * go + 1] * inv16, o1[4 * go + 2] * inv16, o1[4 * go + 3] * inv16);
        const auto a = __builtin_amdgcn_permlane32_swap((unsigned)xe0, (unsigned)xo0, false, false), b = __builtin_amdgcn_permlane32_swap((unsigned)xe1, (unsigned)xo1, false, false);
        u32x2 c0, c1; c0.x = a[0]; c0.y = a[1]; c1.x = b[0]; c1.y = b[1];
        unsigned char* q = (unsigned char*)orow + 8 * (h ? go : ge);
        *(u32x2*)q = c0; *(u32x2*)(q + 32) = c1; } }
#elif A5_WIDE_STORE
#pragma unroll
    for (int p = 0; p < 2; ++p) {
        u32x2 we0, wo0, we1, wo1; const int ge = 2 * p, go = 2 * p + 1;
        we0.x = pk2(o0[4 * ge] * inv, o0[4 * ge + 1] * inv); we0.y = pk2(o0[4 * ge + 2] * inv, o0[4 * ge + 3] * inv);
        wo0.x = pk2(o0[4 * go] * inv, o0[4 * go + 1] * inv); wo0.y = pk2(o0[4 * go + 2] * inv, o0[4 * go + 3] * inv);
        we1.x = pk2(o1[4 * ge] * inv, o1[4 * ge + 1] * inv); we1.y = pk2(o1[4 * ge + 2] * inv, o1[4 * ge + 3] * inv);
        wo1.x = pk2(o1[4 * go] * inv, o1[4 * go + 1] * inv); wo1.y = pk2(o1[4 * go + 2] * inv, o1[4 * go + 3] * inv);
        const auto a0 = __builtin_amdgcn_permlane32_swap(we0.x, wo0.x, false, false), a1 = __builtin_amdgcn_permlane32_swap(we0.y, wo0.y, false, false);
        const auto b0 = __builtin_amdgcn_permlane32_swap(we1.x, wo1.x, false, false), b1 = __builtin_amdgcn_permlane32_swap(we1.y, wo1.y, false, false);
        u32x4 c0, c1; c0.x = a0[0]; c0.y = a1[0]; c0.z = a0[1]; c0.w = a1[1]; c1.x = b0[0]; c1.y = b1[0]; c1.z = b0[1]; c1.w = b1[1];
        bf16_t* q = orow + 8 * (h ? go : ge);
        *(u32x4*)q = c0; *(u32x4*)(q + 32) = c1;
    }
#else
#pragma unroll
    for (int g = 0; g < 4; ++g) {
        u32x2 w0, w1;
        w0.x = pk2(o0[4 * g] * inv, o0[4 * g + 1] * inv); w0.y = pk2(o0[4 * g + 2] * inv, o0[4 * g + 3] * inv);
        w1.x = pk2(o1[4 * g] * inv, o1[4 * g + 1] * inv); w1.y = pk2(o1[4 * g + 2] * inv, o1[4 * g + 3] * inv);
        *(u32x2*)(orow + 8 * g + 4 * h) = w0; *(u32x2*)(orow + 32 + 8 * g + 4 * h) = w1;
    }
#endif
}

#define AT_OPAQUE_WS() size_t zz_ = 0; asm volatile("" : "+s"(zz_)); unsigned char* ws = ws_in + zz_; int lane = lane_in; asm volatile("" : "+v"(lane)); const int r = lane & 31; const int tid = wave * 64 + lane;
__device__ __forceinline__ void attention_phase2(unsigned char* ws_in, LAS unsigned char* lds, const float* sinks, int G, int bid, int tid_in, int wave, int lane_in, int which = 7, bool dummy = false) {
    for (int j0 = bid; j0 < 256; j0 += G) {
        const int j = (G == 256) ? ((j0 & 7) * 32 + (j0 >> 3)) : j0;
        const int b = j >> 5; const size_t tb = (size_t)b * SEQ;
        if (which & 1) {
            AT_OPAQUE_WS();
            const bf16_t* AQ = (const bf16_t*)(ws + R_AQ); const bf16_t* AKN = (const bf16_t*)(ws + R_AKN); const bf16_t* KPE = (const bf16_t*)(ws + R_KPE); const bf16_t* AVT = (const bf16_t*)(ws + R_AVT);
            bf16_t* OA = (bf16_t*)(ws + (dummy ? R_AV : WS_OABC));
            const int head = (j >> 2) & 7, qp = j & 3;
#pragma unroll 1
            for (int z = 0; z < 2; ++z) {
                const int Q = z ? qp : 7 - qp, c = 4 * Q + (wave >> 1), q0 = 64 * c + 32 * (wave & 1); const size_t qr = tb + q0 + r;
#ifdef A5_PROBE_VARIANT
                if (dummy) attn5_item<6, 0, A5_PROBE_VARIANT>(lds, AQ + qr * 768 + head * 96, AKN + tb * 512 + head * 64, 512, KPE + tb * 32, AVT + (size_t)(b * 8 + head) * 64 * SEQ,
                                 0, 4 * Q + 4, c + 1, nullptr, 0.f, A5_OPTR(OA, qr * 512 + head * 64), tid, wave, lane); else
#endif
                attn5_item<6, 0>(lds, AQ + qr * 768 + head * 96, AKN + tb * 512 + head * 64, 512, KPE + tb * 32, AVT + (size_t)(b * 8 + head) * 64 * SEQ,
                                 0, 4 * Q + 4, c + 1, nullptr, 0.f, A5_OPTR(OA, qr * 512 + head * 64), tid, wave, lane);
            }
        }
        const int g = (j >> 4) & 1, cp = j & 15, head = 4 * g + (wave >> 1);
        if (which & 2) {
            AT_OPAQUE_WS();
            const bf16_t* BQ = (const bf16_t*)(ws + R_BQ); const bf16_t* BK = (const bf16_t*)(ws + R_BK); const bf16_t* BVT = (const bf16_t*)(ws + R_BVT); const unsigned* MASK = (const unsigned*)(ws + R_MASK);
            bf16_t* OB = A5_OPTR((bf16_t*)(ws + (dummy ? R_AV : WS_OABC)), (dummy ? (size_t)0 : (size_t)NT * 512));
#pragma unroll 1
            for (int z = 0; z < 2; ++z) {
                const int c = z ? cp : 31 - cp, q0 = 64 * c + 32 * (wave & 1); const size_t qr = tb + q0 + r;
                attn5_item<4, 1>(lds, BQ + qr * 512 + head * 64, BK + tb * 128 + g * 64, 128, nullptr, BVT + (size_t)(b * 2 + g) * 64 * SEQ,
                                 0, c + 1, c + 1, MASK + (tb + q0) * 64, 0.f, A5_OPTR(OB, qr * 512 + head * 64), tid, wave, lane);
            }
        }
        if (which & 4) {
            AT_OPAQUE_WS();
            const bf16_t* CQ = (const bf16_t*)(ws + R_CQ); const bf16_t* CK = (const bf16_t*)(ws + R_CK); const bf16_t* CVT = (const bf16_t*)(ws + R_CVT);
            bf16_t* OC = A5_OPTR((bf16_t*)(ws + (dummy ? R_AV : WS_OABC)), (dummy ? (size_t)0 : (size_t)2 * NT * 512));
            const float sink = sinks[head] * LOG2E;
#pragma unroll 1
            for (int z = 0; z < 2; ++z) {
                const int c = z ? cp : 31 - cp, q0 = 64 * c + 32 * (wave & 1); const size_t qr = tb + q0 + r;
                attn5_item<4, 2>(lds, CQ + qr * 512 + head * 64, CK + tb * 128 + g * 64, 128, nullptr, CVT + (size_t)(b * 2 + g) * 64 * SEQ,
                                 (c >= 2) ? 64 * (c - 2) : 0, (c >= 2) ? 3 : c + 1, (c >= 2) ? 3 : c + 1, nullptr, sink, A5_OPTR(OC, qr * 512 + head * 64), tid, wave, lane);
            }
        }
    }
}
#ifndef GATE_F8
#define GATE_F8 1
#endif
#ifndef MOE_F8
#define MOE_F8 1
#endif
#ifndef OUT_F8
#define OUT_F8 1
#endif
__device__ __forceinline__ void ln_rows(f32x4 (&v)[4], const float* g, const float* b, int lane) {
    float s = 0.f;
#pragma unroll
    for (int j = 0; j < 4; ++j) s += (v[j][0] + v[j][1]) + (v[j][2] + v[j][3]);
    const float mean = wave_sum(s, lane) * (1.0f / DM); float s2 = 0.f;
#pragma unroll
    for (int j = 0; j < 4; ++j) { v[j] = v[j] - mean; s2 += (v[j][0] * v[j][0] + v[j][1] * v[j][1]) + (v[j][2] * v[j][2] + v[j][3] * v[j][3]); }
    const float rstd = 1.0f / sqrtf(wave_sum(s2, lane) * (1.0f / DM) + LN_EPS);
#pragma unroll
    for (int j = 0; j < 4; ++j) { const f32x4 gg = *(const f32x4*)(g + 4 * lane + 256 * j), bb = *(const f32x4*)(b + 4 * lane + 256 * j); v[j] = v[j] * rstd * gg + bb; }
}
__device__ __forceinline__ void store_row(const f32x4 (&v)[4], float* orow, bf16_t* brow, int lane, unsigned char* qrow = nullptr) {
#pragma unroll
    for (int j = 0; j < 4; ++j) {
        if (orow) *(f32x4*)(orow + 4 * lane + 256 * j) = v[j];
        if (brow) { u32x2 w; w.x = pk2(v[j][0], v[j][1]); w.y = pk2(v[j][2], v[j][3]); *(u32x2*)(brow + 4 * lane + 256 * j) = w; }
        if (qrow) *(int*)(qrow + 4 * lane + 256 * j) = f8x4(v[j][0], v[j][1], v[j][2], v[j][3]);
    }
}

__device__ __forceinline__ void conv_item(const float* srccol  , int ldw, const float* gain, bf16_t* dst  , int K, int k0, LAS float* scr, int lane, float f8s = 0.f  ) {
    const int n4 = lane & 7, kr = lane >> 3;
    f32x4 v[8];
#pragma unroll
    for (int i = 0; i < 8; ++i) v[i] = srccol ? *(const f32x4*)(srccol + (size_t)(k0 + 8 * i + kr) * ldw) : (f32x4){0.f, 0.f, 0.f, 0.f};
    if (gain) {
#pragma unroll
        for (int i = 0; i < 8; ++i) v[i] = v[i] * gain[k0 + 8 * i + kr];
    }
#pragma unroll
    for (int i = 0; i < 8; ++i) *(LAS f32x4*)(scr + (8 * i + kr) * 36 + 4 * n4) = v[i];
    asm volatile("s_waitcnt lgkmcnt(0)" ::: "memory");
    const int c = lane & 7;
#pragma unroll
    for (int j = 0; j < 4; ++j) { const int n = (lane >> 3) + 8 * j; const LAS float* s = scr + (8 * c) * 36 + n;
        if (f8s != 0.f) { const int p0 = f8x4(s[0 * 36] * f8s, s[1 * 36] * f8s, s[2 * 36] * f8s, s[3 * 36] * f8s), p1 = f8x4(s[4 * 36] * f8s, s[5 * 36] * f8s, s[6 * 36] * f8s, s[7 * 36] * f8s);
            u32x2 o8; o8.x = (unsigned)p0; o8.y = (unsigned)p1; *(u32x2*)((unsigned char*)dst + (size_t)n * K + k0 + 8 * c) = o8; }
        else {
        u32x4 o; o.x = pk2(s[0 * 36], s[1 * 36]); o.y = pk2(s[2 * 36], s[3 * 36]); o.z = pk2(s[4 * 36], s[5 * 36]); o.w = pk2(s[6 * 36], s[7 * 36]);
        *(u32x4*)(dst + (size_t)n * K + k0 + 8 * c) = o; } }
    asm volatile("s_waitcnt lgkmcnt(0)" ::: "memory");
}
__device__ __forceinline__ int w1_src(int n) {
    const int T = n >> 8, tc = n & 255, p = tc & 127, sec = tc >> 7;
    switch (T) {
        case 0: return 672 + (p >> 5) * 64 + (p & 31) + 32 * sec;
        case 1: return 672 + (4 + (p >> 5)) * 64 + (p & 31) + 32 * sec;
        case 2: return 1764 + (p >> 5) * 64 + (p & 31) + 32 * sec;
        case 3: return 1764 + (4 + (p >> 5)) * 64 + (p & 31) + 32 * sec;
        case 4: return 1440 + (p >> 5) * 64 + (p & 31) + 32 * sec;
        case 5: return (p < 64) ? 1184 + (p >> 5) * 64 + (p & 31) + 32 * sec : 2276 + ((p - 64) >> 5) * 64 + (p & 31) + 32 * sec;
        case 6: return (p < 32) ? 1696 + p + 32 * sec : ((p < 48) ? 640 + (p - 32) + 16 * sec : -1);
        case 7: return tc;
        case 8: return (tc < 128) ? 256 + tc : 1312 + (tc - 128);
        case 9: return 384 + tc;
        default: return (tc < 128) ? 2404 + tc : ((tc < 132) ? 1760 + (tc - 128) : -1);
    }
}
__device__ __forceinline__ int wuq_src(int n) { const int T = n >> 8, tc = n & 255; if (T < 2) return (4 * T + (tc >> 6)) * 96 + (tc & 63); const int p = tc & 127, sec = tc >> 7; return (p >> 4) * 96 + 64 + (p & 15) + 16 * sec; }
__device__ __forceinline__ int wukv_src(int n) { const int T = n >> 8, tc = n & 255; return (T < 2) ? (4 * T + (tc >> 6)) * 128 + (tc & 63) : (4 * (T - 2) + (tc >> 6)) * 128 + 64 + (tc & 63); }

__device__ __forceinline__ void convert_phase(KernArgP P, unsigned char* ws, int layer, LAS unsigned char* lds, int gw, int NGW, int wave, int lane, int part = -1, unsigned* qcnt = nullptr) {
    LAS float* scr = (LAS float*)(lds + wave * 16384);
    constexpr int I_W1 = 88 * 16, I_WG = 96 * 16, I_UQ = 24 * 6, I_UKV = 32 * 4, I_BR = 3 * 32 * 8, I_OUT = 32 * 16, I_GU = 16 * 32 * 16, I_DN = 16 * 32 * 8;
    constexpr int NITEMS = I_W1 + I_WG + I_UQ + I_UKV + I_BR + I_OUT + I_GU + I_DN, I_MIX = I_W1 + I_WG + I_UQ + I_UKV + I_BR + I_OUT;
    const float* w_in = P->w_in + (size_t)layer * DM * INC;
    const int ln = 4 * (lane & 7);
    const int it_lo = (part == 1) ? I_MIX : 0, it_hi = (part == 0) ? I_MIX : NITEMS;
    int it = it_lo + gw, chunk_end = 0;
    if (qcnt) { it = 0; chunk_end = 0; }
    for (;;) {
        if (qcnt) {
            if (it >= chunk_end) { unsigned b_ = 0u; if (lane == 0) b_ = __hip_atomic_fetch_add(qcnt, 8u, __ATOMIC_RELAXED, __HIP_MEMORY_SCOPE_AGENT); it = it_lo + (int)__builtin_amdgcn_readfirstlane((int)b_); chunk_end = it + 8; }
            if (it >= it_hi) break;
        } else if (it >= it_hi) break;
        const int it_cur = it; it += qcnt ? 1 : NGW;
        int q = it_cur;
        if (q < I_W1) { const int kb = q / 88, nb = q % 88, s = w1_src(32 * nb + ln);
            conv_item(s >= 0 ? w_in + s : nullptr, INC, nullptr, (bf16_t*)(ws + WB_W1) + (size_t)(32 * nb) * 1024, 1024, 64 * kb, scr, lane); continue; } q -= I_W1;
        if (q < I_WG) { const int kb = q / 96, nb = q % 96;
            if (GATE_F8) conv_item(w_in + 2532 + 32 * nb + ln, INC, nullptr, (bf16_t*)((unsigned char*)(ws + WB_WG) + (size_t)(32 * nb) * 1024), 1024, 64 * kb, scr, lane, 32.0f);
            else conv_item(w_in + 2532 + 32 * nb + ln, INC, nullptr, (bf16_t*)(ws + WB_WG) + (size_t)(32 * nb) * 1024, 1024, 64 * kb, scr, lane);
            continue; } q -= I_WG;
        if (q < I_UQ) { const int kb = q / 24, nb = q % 24;
            conv_item(P->a_w_uq + (size_t)layer * 384 * 768 + wuq_src(32 * nb + ln), 768, P->a_q_ln_g + layer * 384, (bf16_t*)(ws + WB_WUQ) + (size_t)(32 * nb) * 384, 384, 64 * kb, scr, lane); continue; } q -= I_UQ;
        if (q < I_UKV) { const int kb = q / 32, nb = q % 32;
            conv_item(P->a_w_ukv + (size_t)layer * 256 * 1024 + wukv_src(32 * nb + ln), 1024, P->a_kv_ln_g + layer * 256, (bf16_t*)(ws + WB_WUKV) + (size_t)(32 * nb) * 256, 256, 64 * kb, scr, lane); continue; } q -= I_UKV;
        if (q < I_BR) { const int br = q / 256, qq = q % 256, kb = qq / 32, nb = qq % 32; const float* src = (br == 0 ? P->w_br_a : (br == 1 ? P->w_br_b : P->w_br_c)) + (size_t)layer * 512 * 1024;
            if (BR_F8) conv_item(src + 32 * nb + ln, 1024, nullptr, (bf16_t*)((unsigned char*)(ws + WB_WBR) + (size_t)(br * 1024 + 32 * nb) * 512), 512, 64 * kb, scr, lane, 32.0f);
            else conv_item(src + 32 * nb + ln, 1024, nullptr, (bf16_t*)(ws + WB_WBR) + (size_t)(br * 1024 + 32 * nb) * 512, 512, 64 * kb, scr, lane);
            continue; } q -= I_BR;
        if (q < I_OUT) { const int kb = q / 32, nb = q % 32;
            if (OUT_F8) conv_item(P->w_out + (size_t)layer * 1024 * 1024 + 32 * nb + ln, 1024, nullptr, (bf16_t*)((unsigned char*)(ws + WB_WOUT) + (size_t)(32 * nb) * 1024), 1024, 64 * kb, scr, lane, 32.0f);
            else conv_item(P->w_out + (size_t)layer * 1024 * 1024 + 32 * nb + ln, 1024, nullptr, (bf16_t*)(ws + WB_WOUT) + (size_t)(32 * nb) * 1024, 1024, 64 * kb, scr, lane);
            continue; } q -= I_OUT;
        if (q < I_GU) { const int e = q / 512, qq = q % 512, kb = qq / 32, nb = qq % 32, n = 32 * nb + ln, jt = n >> 8, tc = n & 255;
            const float* src = (tc < 128 ? P->w_exp_gate : P->w_exp_up) + ((size_t)layer * NEXP + e) * 1024 * 512 + 128 * jt + (tc & 127);
            if (MOE_F8) conv_item(src, 512, nullptr, (bf16_t*)((unsigned char*)(ws + WB_WGU) + (size_t)(e * 1024 + 32 * nb) * 1024), 1024, 64 * kb, scr, lane, 32.0f);
            else conv_item(src, 512, nullptr, (bf16_t*)(ws + WB_WGU) + (size_t)(e * 1024 + 32 * nb) * 1024, 1024, 64 * kb, scr, lane);
            continue; } q -= I_GU;
        { const int e = q / 256, qq = q % 256, kb = qq / 32, nb = qq % 32;
            if (MOE_F8) conv_item(P->w_exp_down + ((size_t)layer * NEXP + e) * 512 * 1024 + 32 * nb + ln, 1024, nullptr, (bf16_t*)((unsigned char*)(ws + WB_WDN) + (size_t)(e * 1024 + 32 * nb) * 512), 512, 64 * kb, scr, lane, 32.0f);
            else conv_item(P->w_exp_down + ((size_t)layer * NEXP + e) * 512 * 1024 + 32 * nb + ln, 1024, nullptr, (bf16_t*)(ws + WB_WDN) + (size_t)(e * 1024 + 32 * nb) * 512, 512, 64 * kb, scr, lane); }
    }
}

__device__ __forceinline__ void prep_phase(KernArgP P, unsigned char* ws, LAS unsigned char* lds, int gw, int NGW, int wave, int lane) {
    const int gt = gw * 64 + lane, NGT = NGW * 64;
    for (int i = gt; i < 1024; i += NGT) ((unsigned*)(ws + WS_CNT))[i] = 0u;
    for (int i = gt; i < DEPTH * 2 * NT; i += NGT) ((u64*)(ws + WS_SSQ))[i] = 0ull;
    for (int i = gt; i < SEQ * 48; i += NGT) {
        const int t = i / 48, k = i % 48; const int half = (k < 32) ? 32 : 16, idx = (k < 32) ? k : k - 32;
        const float inv = (float)pow(10000.0, -(double)idx / (double)half); const float ang = (float)t * inv;
        f32x2 cs; cs.x = (float)cos((double)ang); cs.y = (float)sin((double)ang);
        if (k < 32) ((f32x2*)(ws + WS_CS64))[t * 32 + idx] = cs; else ((f32x2*)(ws + WS_CS32))[t * 16 + idx] = cs;
    }
    f32x4 vn[4];
    if (gw < NT) {
#pragma unroll
        for (int j = 0; j < 4; ++j) vn[j] = *(const f32x4*)(P->x + (size_t)gw * DM + 4 * lane + 256 * j);
    }
    for (int row = gw; row < NT; row += NGW) {
        f32x4 v[4];
#pragma unroll
        for (int j = 0; j < 4; ++j) v[j] = vn[j];
        if (row + NGW < NT) {
#pragma unroll
            for (int j = 0; j < 4; ++j) vn[j] = *(const f32x4*)(P->x + (size_t)(row + NGW) * DM + 4 * lane + 256 * j);
        }
        ln_rows(v, P->ln_in_g, P->ln_in_b, lane);
        store_row(v, nullptr, (bf16_t*)(ws + WS_XB) + (size_t)row * DM, lane, GATE_F8 ? (unsigned char*)(ws + R_XB8) + (size_t)row * DM : nullptr);
    }
}

__device__ __forceinline__ void ln1_router_phase(KernArgP P, unsigned char* ws, int layer, LAS unsigned char* lds, int gw, int NGW, int lane, int tid, int bid) {
    LAS float* WRT = (LAS float*)lds;
    LAS unsigned* LCNT = (LAS unsigned*)(lds + 65536);
    if (tid < 16) LCNT[tid] = 0u;
    for (int i = tid; i < 16 * 1024; i += 512) { const int d = i >> 4, e = i & 15; WRT[e * 1024 + d] = P->w_router[i]; }
    __syncthreads();
    f32x4 vn[4];
    if (gw < NT) {
#pragma unroll
        for (int j = 0; j < 4; ++j) vn[j] = *(const f32x4*)(P->out + (size_t)gw * DM + 4 * lane + 256 * j);
    }
    for (int row = gw; row < NT; row += NGW) {
        f32x4 v[4];
#pragma unroll
        for (int j = 0; j < 4; ++j) v[j] = vn[j];
        if (row + NGW < NT) {
#pragma unroll
            for (int j = 0; j < 4; ++j) vn[j] = *(const f32x4*)(P->out + (size_t)(row + NGW) * DM + 4 * lane + 256 * j);
        }
        float pe[16];
#pragma unroll
        for (int e = 0; e < 16; ++e) { float a = 0.f;
#pragma unroll
            for (int j = 0; j < 4; ++j) { const f32x4 wv = *(const LAS f32x4*)(WRT + e * 1024 + 4 * lane + 256 * j); a += (v[j][0] * wv[0] + v[j][1] * wv[1]) + (v[j][2] * wv[2] + v[j][3] * wv[3]); }
            pe[e] = a; if ((e & 3) == 3) asm volatile("" ::: "memory"); }
        float r8[8], r4[4], r2[2], r1;
        { const bool hi = (lane & 32) != 0;
#pragma unroll
          for (int k = 0; k < 8; ++k) { const float keep = hi ? pe[k + 8] : pe[k], send = hi ? pe[k] : pe[k + 8]; r8[k] = keep + shx(send, 32, lane); } }
        { const bool hi = (lane & 16) != 0;
#pragma unroll
          for (int k = 0; k < 4; ++k) { const float keep = hi ? r8[k + 4] : r8[k], send = hi ? r8[k] : r8[k + 4]; r4[k] = keep + shx(send, 16, lane); } }
        { const bool hi = (lane & 8) != 0;
#pragma unroll
          for (int k = 0; k < 2; ++k) { const float keep = hi ? r4[k + 2] : r4[k], send = hi ? r4[k] : r4[k + 2]; r2[k] = keep + shx(send, 8, lane); } }
        { const bool hi = (lane & 4) != 0; const float keep = hi ? r2[1] : r2[0], send = hi ? r2[0] : r2[1]; r1 = keep + shx(send, 4, lane); }
        r1 += shx(r1, 2, lane); r1 += shx(r1, 1, lane);
        float lg[16];
#pragma unroll
        for (int e = 0; e < 16; ++e) lg[e] = __int_as_float(__builtin_amdgcn_readlane(__float_as_int(r1), 4 * e));
        float sco[16], bsd[16];
#pragma unroll
        for (int e = 0; e < 16; ++e) { sco[e] = __builtin_amdgcn_rcpf(1.0f + __builtin_amdgcn_exp2f(-lg[e] * 1.4426950408889634f)); bsd[e] = sco[e] + P->router_bias[e]; }
        float best_gs = -3.0e38f; int gsel = 0; int i1s = 0, i2s = 1; float w1s = 0.f, w2s = 0.f;
#pragma unroll
        for (int g = 0; g < 4; ++g) {
            int i1 = 0; float b1 = bsd[4 * g], s1 = sco[4 * g];
#pragma unroll
            for (int k = 1; k < 4; ++k) if (bsd[4 * g + k] > b1) { b1 = bsd[4 * g + k]; s1 = sco[4 * g + k]; i1 = k; }
            int i2 = -1; float b2 = -3.0e38f, s2 = 0.f;
#pragma unroll
            for (int k = 0; k < 4; ++k) if (k != i1 && bsd[4 * g + k] > b2) { b2 = bsd[4 * g + k]; s2 = sco[4 * g + k]; i2 = k; }
            const float gs = b1 + b2;
            if (gs > best_gs) { best_gs = gs; gsel = g; i1s = 4 * g + i1; i2s = 4 * g + i2; w1s = s1; w2s = s2; }
        }
        (void)gsel;
        if (lane == 0) {
            const float ws_ = w1s + w2s; const float wa = w1s / ws_, wb = w2s / ws_;
            const unsigned sl1 = __hip_atomic_fetch_add(LCNT + i1s, 1u, __ATOMIC_RELAXED, __HIP_MEMORY_SCOPE_WORKGROUP), sl2 = __hip_atomic_fetch_add(LCNT + i2s, 1u, __ATOMIC_RELAXED, __HIP_MEMORY_SCOPE_WORKGROUP);
            int* rt = (int*)(ws + WS_ROUTE) + (size_t)row * 6;
            rt[0] = i1s; rt[1] = i2s; rt[2] = (int)sl1; rt[3] = (int)sl2; ((float*)rt)[4] = wa; ((float*)rt)[5] = wb;
        }
    }
    __syncthreads();
    if (tid < 16) ((unsigned*)(ws + WS_WGCNT))[bid * 16 + tid] = LCNT[tid];
}
__device__ __forceinline__ void moe_tiles(const unsigned* CNT, int (&ts)[16], int (&cn)[16], int& ntiles) {
    int acc = 0;
#pragma unroll
    for (int e = 0; e < 16; ++e) { cn[e] = (int)__builtin_amdgcn_readfirstlane(CNT[e]); ts[e] = acc; acc += (cn[e] + 255) >> 8; }
    ntiles = acc;
}
__device__ __forceinline__ void gather_phase(unsigned char* ws, int layer, LAS unsigned char* lds, int gw, int NGW, int lane, int tid, int bid, int G) {
    LAS unsigned* RAW = (LAS unsigned*)lds;
    LAS unsigned* PART = RAW + 4096;
    LAS int* TS = (LAS int*)(PART + 1024);
    LAS int* CN = TS + 16;
    const unsigned* WGC = (const unsigned*)(ws + WS_WGCNT);
    for (int i = tid; i < 4096; i += 512) RAW[i] = (i < G * 16) ? WGC[i] : 0u;
    __syncthreads();
    { const int e = tid & 15, part = tid >> 4; unsigned tot = 0u, pre = 0u;
#pragma unroll
      for (int k = 0; k < 8; ++k) { const int b2 = part * 8 + k; const unsigned v = RAW[b2 * 16 + e]; tot += v; pre += (b2 < bid) ? v : 0u; }
      PART[part * 32 + e] = tot; PART[part * 32 + 16 + e] = pre; }
    __syncthreads();
    if (tid < 16) { unsigned tot = 0u, pre = 0u;
        for (int p2 = 0; p2 < 32; ++p2) { tot += PART[p2 * 32 + tid]; pre += PART[p2 * 32 + 16 + tid]; }
        CN[tid] = (int)tot; TS[tid] = (int)pre;
        if (bid == 0) ((unsigned*)(ws + WS_CNT))[layer * 16 + tid] = tot; }
    __syncthreads();
    int ts[16], cn[16];
    { int acc = 0;
#pragma unroll
      for (int e = 0; e < 16; ++e) { cn[e] = __builtin_amdgcn_readfirstlane(CN[e]); ts[e] = acc; acc += (cn[e] + 255) >> 8; } }
    __syncthreads();
    if (tid < 16) { int base = 0;
#pragma unroll
        for (int e = 0; e < 16; ++e) if (e == tid) base = 256 * ts[e];
        TS[tid] += base; }
    __syncthreads();
    int* ROWTOK = (int*)(ws + WS_ROWTOK); float* ROWW = (float*)(ws + WS_ROWW);
    if (NGW * 8 == NT) {
        int ev[8], sv[8]; float wv[8];
        if (lane < 2) {
#pragma unroll
            for (int k = 0; k < 8; ++k) { const int* rt = (const int*)(ws + WS_ROUTE) + (size_t)(gw + k * NGW) * 6; ev[k] = rt[lane]; sv[k] = rt[2 + lane]; wv[k] = ((const float*)rt)[4 + lane]; }
            __builtin_amdgcn_sched_barrier(0);
#pragma unroll
            for (int k = 0; k < 8; ++k) { const int row = TS[ev[k]] + sv[k]; ROWTOK[row] = 2 * (gw + k * NGW) + lane; ROWW[row] = wv[k]; }
        }
    } else
    for (int t = gw; t < NT; t += NGW) {
        if (lane < 2) { const int* rt = (const int*)(ws + WS_ROUTE) + (size_t)t * 6; const int e = rt[lane], slot = rt[2 + lane]; const int row = TS[e] + slot;
            ROWTOK[row] = 2 * t + lane; ROWW[row] = ((const float*)rt)[4 + lane]; }
    }
#pragma unroll
    for (int e = 0; e < 16; ++e) {
        const int tiles = (cn[e] + 255) >> 8;
        for (int pr = cn[e] + gw * 64 + lane; pr < 256 * tiles; pr += NGW * 64) { const int row = 256 * ts[e] + pr; ROWTOK[row] = -1; ROWW[row] = 0.f; }
    }
}
__device__ __forceinline__ void ln2_phase(KernArgP P, unsigned char* ws, int layer, int gw, int NGW, int lane, float* outp, bf16_t* xbp) { const bf16_t* Y2 = (const bf16_t*)(ws + R_Y2);
    u32x2 xn[4], y0n[4], y1n[4];
#define LN2_LOAD(ROW) do { _Pragma("unroll") for (int j = 0; j < 4; ++j) { xn[j] = *(const u32x2*)((const bf16_t*)(ws + WS_XB) + (size_t)(ROW) * DM + 4 * lane + 256 * j); \
        y0n[j] = *(const u32x2*)(Y2 + (size_t)(2 * (ROW)) * DM + 4 * lane + 256 * j); y1n[j] = *(const u32x2*)(Y2 + (size_t)(2 * (ROW) + 1) * DM + 4 * lane + 256 * j); } } while (0)
    if (gw < NT) LN2_LOAD(gw);
    for (int row = gw; row < NT; row += NGW) {
        f32x4 v[4];
#pragma unroll
        for (int j = 0; j < 4; ++j) {
            const u32x2 xw = xn[j]; const f32x4 x = {bf_lo(xw.x), bf_hi(xw.x), bf_lo(xw.y), bf_hi(xw.y)};
            const u32x2 y0 = y0n[j], y1 = y1n[j];
            v[j][0] = x[0] * ALPHA + (bf_lo(y0.x) + bf_lo(y1.x)); v[j][1] = x[1] * ALPHA + (bf_hi(y0.x) + bf_hi(y1.x));
            v[j][2] = x[2] * ALPHA + (bf_lo(y0.y) + bf_lo(y1.y)); v[j][3] = x[3] * ALPHA + (bf_hi(y0.y) + bf_hi(y1.y));
        }
        if (row + NGW < NT) LN2_LOAD(row + NGW);
        ln_rows(v, P->ln2_g + layer * DM, P->ln2_b + layer * DM, lane);
        store_row(v, outp ? outp + (size_t)row * DM : nullptr, xbp ? xbp + (size_t)row * DM : nullptr, lane, (GATE_F8 && xbp) ? (unsigned char*)(ws + R_XB8) + (size_t)row * DM : nullptr);
    }
#undef LN2_LOAD
}
#ifndef XB_FLAT
#define XB_FLAT 1
#endif
#define XB_TMO      128
#define XB_XCNT(j)  (256  + 64 * (j))
#define XB_XSUB(j)  (1280 + 64 * (j))
#define XB_XGEN(j)  (2304 + 64 * (j))
#define XB_TOP      3328
#define XB_TOPGEN   3392
#define XCD_BAR_WORDS 3456
#define XB_SPIN_CAP (1u << 18)
__device__ __forceinline__ unsigned xb_ld(unsigned* p)              { return __hip_atomic_load(p, __ATOMIC_RELAXED, __HIP_MEMORY_SCOPE_AGENT); }
__device__ __forceinline__ unsigned xb_add(unsigned* p, unsigned v) { return __hip_atomic_fetch_add(p, v, __ATOMIC_RELAXED, __HIP_MEMORY_SCOPE_AGENT); }
__device__ __forceinline__ unsigned xb_xcc_id() { return (unsigned)__builtin_amdgcn_s_getreg((3 << 11) | 20) & 0xFu; }
#define XB_SPIN(cond, bar) do { unsigned _sp = 0; while (cond) { __builtin_amdgcn_s_sleep(1); \
    if ((++_sp & 255u) == 0u) { if (xb_ld(&(bar)[XB_TMO])) break; if (_sp > XB_SPIN_CAP) { atomicAdd(&(bar)[XB_TMO], 1u); break; } } } } while (0)
struct XcdBarrier { unsigned* bar; unsigned x; volatile LAS unsigned* st; };
__device__ __forceinline__ XcdBarrier xcd_barrier_post(unsigned* bar, volatile LAS unsigned* st, int tid) {
    XcdBarrier b; b.bar = bar; b.x = xb_xcc_id(); b.st = st;
    if (tid == 0) (void)xb_add(&bar[XB_XCNT(b.x)], 1u);
    return b;
}
__device__ __forceinline__ void xcd_barrier_complete(unsigned* bar, unsigned x, unsigned G, unsigned& nloc, unsigned& nx) {
    unsigned sum, cnt, mine, sp = 0u;
    for (;;) {
        sum = 0u; cnt = 0u; mine = 0u;
#pragma unroll
        for (unsigned j = 0; j < 16; ++j) { const unsigned c = xb_ld(&bar[XB_XCNT(j)]); sum += c; cnt += (c > 0u) ? 1u : 0u; mine = (j == x) ? c : mine; }
        if (sum == G) break;
        __builtin_amdgcn_s_sleep(1);
        if ((++sp & 255u) == 0u) { if (xb_ld(&bar[XB_TMO])) break; if (sp > XB_SPIN_CAP) { atomicAdd(&bar[XB_TMO], 1u); break; } }
    }
    nloc = mine > 0u ? mine : 1u; nx = cnt > 0u ? cnt : 1u;
}
__device__ __forceinline__ void xcd_barrier(const XcdBarrier& b, int tid, unsigned G) {
    asm volatile("s_waitcnt vmcnt(0)" ::: "memory");
    __syncthreads();
    if (tid == 0) {
        unsigned* bar = b.bar;
        __builtin_amdgcn_s_waitcnt(0);
        unsigned nloc = b.st[0], nx = b.st[1];
        if (nloc == 0u) { xcd_barrier_complete(bar, b.x, G, nloc, nx); b.st[0] = nloc; b.st[1] = nx; }
        const unsigned old = xb_add(&bar[XB_XSUB(b.x)], 1u);
        const unsigned gen = old / nloc;
        if (old + 1u == (gen + 1u) * nloc) {
            __builtin_amdgcn_fence(__ATOMIC_RELEASE, "agent");
            asm volatile("s_waitcnt vmcnt(0)" ::: "memory");
            const unsigned og = xb_add(&bar[XB_TOP], 1u);
            const unsigned tg = og / nx;
            if (og + 1u == (tg + 1u) * nx) xb_add(&bar[XB_TOPGEN], 1u);
            else XB_SPIN(xb_ld(&bar[XB_TOPGEN]) == tg, bar);
            __builtin_amdgcn_fence(__ATOMIC_ACQUIRE, "agent");
            if (!XB_FLAT) xb_add(&bar[XB_XGEN(b.x)], 1u);
            asm volatile("s_waitcnt vmcnt(0)" ::: "memory");
        } else {
            if (XB_FLAT) XB_SPIN(xb_ld(&bar[XB_TOPGEN]) == gen, bar);
            else XB_SPIN(xb_ld(&bar[XB_XGEN(b.x)]) == gen, bar);
            __builtin_amdgcn_fence(__ATOMIC_ACQUIRE, "agent");
            asm volatile("s_waitcnt vmcnt(0)" ::: "memory");
        }
    }
    __syncthreads();
}
#define PHASE_BEGIN() int lane; asm volatile("v_mbcnt_lo_u32_b32 %0, -1, 0\n\tv_mbcnt_hi_u32_b32 %0, -1, %0" : "=v"(lane)); int wave = wave0; asm volatile("" : "+s"(wave)); \
    const int tid = wave * 64 + lane; KernArgP kp_ = (KernArgP)__builtin_amdgcn_kernarg_segment_ptr(); asm volatile("" : "+s"(kp_)); KernArgP P = kp_;     \
    size_t z_ = 0; asm volatile("" : "+s"(z_)); unsigned char* ws = P->ws + z_; const int gw = bid * 8 + wave; int G = G0; asm volatile("" : "+s"(G)); const int NGW = G * 8; (void)tid; (void)gw; (void)NGW;
__global__ void __launch_bounds__(512, 2) mk_forward(Params Pkernarg) {
    extern __shared__ __attribute__((aligned(128))) unsigned char smem[];
    LAS unsigned char* lds = (LAS unsigned char*)smem;
    const int G0 = gridDim.x, bid = blockIdx.x, wave0 = __builtin_amdgcn_readfirstlane(threadIdx.x >> 6);
    XcdBarrier xbar;
    { PHASE_BEGIN(); volatile LAS unsigned* st = (volatile LAS unsigned*)(lds + LDS_MISC); if (tid < 2) st[tid] = 0u; __syncthreads();
      xbar = xcd_barrier_post((unsigned*)(ws + WS_BAR), st, tid); (void)xbar; }
#ifndef P2_SPLIT
#define P2_SPLIT 0
#endif
#ifndef GATE_F8MMA
#define GATE_F8MMA true
#endif
#ifndef CV_SPLIT
#define CV_SPLIT 0
#endif
#define GRID_BAR() do { PHASE_BEGIN(); XcdBarrier xb_; xb_.bar = (unsigned*)(ws + WS_BAR); xb_.x = xb_xcc_id(); xb_.st = (volatile LAS unsigned*)(lds + LDS_MISC); xcd_barrier(xb_, tid, (unsigned)G); } while (0)
    { PHASE_BEGIN(); prep_phase(P, ws, lds, gw, NGW, wave, lane); }
    { PHASE_BEGIN(); convert_phase(P, ws, 0, lds, gw, NGW, wave, lane); }
    for (int layer = 0; layer < DEPTH; ++layer) {
        if (G0 > 65535) cg::this_grid().sync();
        GRID_BAR();
        {
            PHASE_BEGIN();
            pg8::Gemm g{(const bf16_t*)(ws + WS_XB), (const bf16_t*)(ws + WB_W1), 1024, nullptr}; pg8::StaticOrder S; S.init(NT, 2816, G, bid);
            Epi1 E{ws, layer};
            pg8::gemm_phase<Epi1, pg8::StaticOrder, true, true>(lds, g, S, E, tid);
        }
#ifdef P1_PROBE_REPS
        if (layer == 1) {
#pragma unroll 1
            for (int rep_ = 0; rep_ < P1_PROBE_REPS; ++rep_) {
                PHASE_BEGIN();
                pg8::Gemm g{(const bf16_t*)(ws + WS_XB), (const bf16_t*)(ws + WB_W1), 1024, nullptr}; pg8::StaticOrder S; S.init(NT, 2816, G, bid);
                Epi1 E{ws, 0};
                pg8::gemm_phase<Epi1, pg8::StaticOrder, true, true>(lds, g, S, E, tid);
            }
        }
#endif
        GRID_BAR();
        {
#if P2_SPLIT
            { PHASE_BEGIN(); pg8::Gemm g{(const bf16_t*)(ws + R_KVLAT), (const bf16_t*)(ws + WB_WUKV), 256, nullptr}; SchedSub S; S.on = (G == 256) && bid < 128; S.S.init(NT, 1024, 128, bid & 127); EpiUKV E{ws, layer};
              if (G != 256) { S.on = true; S.S.init(NT, 1024, G, bid); }
              pg8::gemm_phase<EpiUKV, SchedSub, true, true>(lds, g, S, E, tid); }
            { PHASE_BEGIN(); pg8::Gemm g{(const bf16_t*)(ws + R_QLAT), (const bf16_t*)(ws + WB_WUQ), 384, nullptr}; SchedSub S; S.on = (G == 256) && bid >= 128 && bid < 224; S.S.init(NT, 768, 96, (bid - 128) & 127); EpiUQ E{ws, layer};
              if (G != 256) { S.on = true; S.S.init(NT, 768, G, bid); }
              pg8::gemm_phase<EpiUQ, SchedSub, true, true>(lds, g, S, E, tid); }
#else
            { PHASE_BEGIN(); pg8::Gemm g{(const bf16_t*)(ws + R_KVLAT), (const bf16_t*)(ws + WB_WUKV), 256, nullptr}; pg8::StaticOrder S; S.init(NT, 1024, G, bid); EpiUKV E{ws, layer};
              pg8::gemm_phase<EpiUKV, pg8::StaticOrder, true, true>(lds, g, S, E, tid); }
            { PHASE_BEGIN(); pg8::Gemm g{(const bf16_t*)(ws + R_QLAT), (const bf16_t*)(ws + WB_WUQ), 384, nullptr}; pg8::StaticOrder S; S.init(NT, 768, G, (bid + 64) % G); EpiUQ E{ws, layer};
              pg8::gemm_phase<EpiUQ, pg8::StaticOrder, true, true>(lds, g, S, E, tid); }
#endif
        }
        { PHASE_BEGIN(); __syncthreads(); indexer_phase(ws, lds, G, bid, wave, lane, tid); }
#ifdef IDX_PROBE_REPS
#pragma unroll 1
        for (int rep_ = 0; rep_ < IDX_PROBE_REPS; ++rep_) { PHASE_BEGIN(); __syncthreads(); indexer_phase(ws, lds, G, bid, wave, lane, tid); }
#endif
        GRID_BAR();
        { PHASE_BEGIN(); attention_phase2(ws, lds, P->c_sinks + layer * 8, G, bid, tid, wave, lane); }
#ifdef A5_PROBE_WHICH
#ifndef A5_PROBE_REPS
#define A5_PROBE_REPS 1
#endif
#pragma unroll 1
        for (int rep_ = 0; rep_ < A5_PROBE_REPS; ++rep_) { PHASE_BEGIN(); attention_phase2(ws, lds, P->c_sinks + layer * 8, G, bid, tid, wave, lane, A5_PROBE_WHICH, true); }
#endif
        GRID_BAR();
        {
            PHASE_BEGIN();
#if GATE_F8
            pg8::Gemm g{(const bf16_t*)(ws + R_XB8), (const bf16_t*)(ws + WB_WG), 512, nullptr}; SchedGate S; S.S.init(NT, 1024, G, bid);
            EpiGate E{(bf16_t*)(ws + R_GATES), 1.0f / 32.0f};
            pg8::gemm_phase<EpiGate, SchedGate, true, true, false, GATE_F8MMA>(lds, g, S, E, tid);
#else
            pg8::Gemm g{(const bf16_t*)(ws + WS_XB), (const bf16_t*)(ws + WB_WG), 1024, nullptr}; SchedGate S; S.S.init(NT, 1024, G, bid);
            EpiGate E{(bf16_t*)(ws + R_GATES)};
            pg8::gemm_phase<EpiGate, SchedGate, true, true>(lds, g, S, E, tid);
#endif
        }
#ifdef P5_PROBE_REPS
#pragma unroll 1
        for (int rep_ = 0; rep_ < P5_PROBE_REPS; ++rep_) {
            PHASE_BEGIN();
            pg8::Gemm g{(const bf16_t*)(ws + WS_XB), (const bf16_t*)(ws + WB_WG), 1024, nullptr}; SchedGate S; S.S.init(NT, 1024, G, bid);
            EpiGate E{(bf16_t*)(ws + R_GATES)};
            pg8::gemm_phase<EpiGate, SchedGate, true, true>(lds, g, S, E, tid);
        }
#endif
        {
            PHASE_BEGIN();
#if BR_F8
            pg8::Gemm g{(const bf16_t*)(ws + WS_OABC), (const bf16_t*)(ws + WB_WBR), 256, nullptr}; SchedBr S; S.S.init(NT, 1024, G, bid);
            EpiBr E{(const bf16_t*)(ws + R_GATES), (bf16_t*)(ws + R_MERGED), 1.0f / 512.0f, OUT_F8 != 0};
            pg8::gemm_phase<EpiBr, SchedBr, true, true, false, true>(lds, g, S, E, tid);
#else
            pg8::Gemm g{(const bf16_t*)(ws + WS_OABC), (const bf16_t*)(ws + WB_WBR), 512, nullptr}; SchedBr S; S.S.init(NT, 1024, G, bid);
            EpiBr E{(const bf16_t*)(ws + R_GATES), (bf16_t*)(ws + R_MERGED)};
            pg8::gemm_phase<EpiBr, SchedBr, true, true>(lds, g, S, E, tid);
#endif
        }
#ifdef P6_PROBE_REPS
#pragma unroll 1
        for (int rep_ = 0; rep_ < P6_PROBE_REPS; ++rep_)
        {
            PHASE_BEGIN();
            pg8::Gemm g{(const bf16_t*)(ws + WS_OABC), (const bf16_t*)(ws + WB_WBR), 512, nullptr}; SchedBr S; S.S.init(NT, 1024, G, bid);
            EpiBr E{(const bf16_t*)(ws + R_GATES), (bf16_t*)(ws + R_MERGED)};
            pg8::gemm_phase<EpiBr, SchedBr, true, true>(lds, g, S, E, tid);
        }
#endif
        GRID_BAR();
        {
            PHASE_BEGIN();
            pg8::Gemm g{(const bf16_t*)(ws + R_MERGED), (const bf16_t*)(ws + WB_WOUT), OUT_F8 ? 512 : 1024, nullptr}; pg8::StaticOrder S; S.init(NT, 1024, G, bid);
            PanelStats st{(u64*)(ws + WS_XBUF), (unsigned*)(ws + WS_PCNT) + layer * 4096, LN_EPS};
            EpiOutLn E{P->out, (bf16_t*)(ws + WS_XB), P->ln1_g + layer * DM, P->ln1_b + layer * DM, st, MOE_F8 ? (unsigned char*)(ws + R_XB8) : nullptr, OUT_F8 ? 1.0f / 512.0f : 1.0f};
            pg8::gemm_phase<EpiOutLn, pg8::StaticOrder, false, true, false, OUT_F8 != 0>(lds, g, S, E, tid);
        }
        GRID_BAR();
        { PHASE_BEGIN(); ln1_router_phase(P, ws, layer, lds, gw, NGW, lane, tid, bid); }
        GRID_BAR();
        { PHASE_BEGIN(); gather_phase(ws, layer, lds, gw, NGW, lane, tid, bid, G); }
        GRID_BAR();
        {
            PHASE_BEGIN();
            SchedMoE S; int cn[16]; moe_tiles((const unsigned*)(ws + WS_CNT) + layer * 16, S.ts, cn, S.ntiles); S.G = G; S.c = (G == 256) ? ((bid & 7) * 32 + (bid >> 3)) : bid; S.hrdy = (unsigned*)(ws + WS_HRDY) + layer * 144 * 64;
#if MOE_F8
            pg8::Gemm g{(const bf16_t*)(ws + R_XB8), (const bf16_t*)(ws + WB_WGU), 512, (const int*)(ws + WS_ROWTOK)}; EpiGU E{(const float*)(ws + WS_ROWW), (bf16_t*)(ws + WS_H), 1.0f / 32.0f, true};
            pg8::gemm_phase<EpiGU, SchedMoE, true, true, true, true>(lds, g, S, E, tid);
#else
            pg8::Gemm g{(const bf16_t*)(ws + WS_XB), (const bf16_t*)(ws + WB_WGU), 1024, (const int*)(ws + WS_ROWTOK)}; EpiGU E{(const float*)(ws + WS_ROWW), (bf16_t*)(ws + WS_H)};
            pg8::gemm_phase<EpiGU, SchedMoE, true, true, true>(lds, g, S, E, tid);
#endif
        }
        {
            PHASE_BEGIN();
            SchedMoEDown S; int cn[16]; moe_tiles((const unsigned*)(ws + WS_CNT) + layer * 16, S.ts, cn, S.ntiles); S.G = G; S.c = (G == 256) ? ((bid & 7) * 32 + (bid >> 3)) : bid; S.hrdy = (unsigned*)(ws + WS_HRDY) + layer * 144 * 64;
            { const int rem = (4 * S.ntiles) % G; S.nheavy = (rem > 0 && 4 * rem <= G) ? rem : 0; }
#if MOE_F8
            pg8::Gemm g{(const bf16_t*)(ws + WS_H), (const bf16_t*)(ws + WB_WDN), 256, nullptr}; EpiDN E{(const int*)(ws + WS_ROWTOK), (bf16_t*)(ws + R_Y2), 1.0f / 256.0f};
            pg8::gemm_phase<EpiDN, SchedMoEDown, true, true, false, true>(lds, g, S, E, tid);
#else
            pg8::Gemm g{(const bf16_t*)(ws + WS_H), (const bf16_t*)(ws + WB_WDN), 512, nullptr}; EpiDN E{(const int*)(ws + WS_ROWTOK), (bf16_t*)(ws + R_Y2)};
            pg8::gemm_phase<EpiDN, SchedMoEDown, true, true>(lds, g, S, E, tid);
#endif
        }
#ifdef MOE_PROBE_REPS
#pragma unroll 1
        for (int rep_ = 0; rep_ < MOE_PROBE_REPS; ++rep_) {
        {
            PHASE_BEGIN();
            SchedMoE S; int cn[16]; moe_tiles((const unsigned*)(ws + WS_CNT) + layer * 16, S.ts, cn, S.ntiles); S.G = G; S.c = (G == 256) ? ((bid & 7) * 32 + (bid >> 3)) : bid; S.hrdy = (unsigned*)(ws + WS_HRDY) + layer * 144 * 64;
            pg8::Gemm g{(const bf16_t*)(ws + WS_XB), (const bf16_t*)(ws + WB_WGU), 1024, (const int*)(ws + WS_ROWTOK)}; EpiGU E{(const float*)(ws + WS_ROWW), (bf16_t*)(ws + WS_H)};
            pg8::gemm_phase<EpiGU, SchedMoE, true, true, true>(lds, g, S, E, tid);
        }
        {
            PHASE_BEGIN();
            SchedMoEDown S; int cn[16]; moe_tiles((const unsigned*)(ws + WS_CNT) + layer * 16, S.ts, cn, S.ntiles); S.G = G; S.c = (G == 256) ? ((bid & 7) * 32 + (bid >> 3)) : bid; S.hrdy = (unsigned*)(ws + WS_HRDY) + layer * 144 * 64;
            { const int rem = (4 * S.ntiles) % G; S.nheavy = (rem > 0 && 4 * rem <= G) ? rem : 0; }
            pg8::Gemm g{(const bf16_t*)(ws + WS_H), (const bf16_t*)(ws + WB_WDN), 512, nullptr}; EpiDN E{(const int*)(ws + WS_ROWTOK), (bf16_t*)(ws + R_Y2)};
            pg8::gemm_phase<EpiDN, SchedMoEDown, true, true>(lds, g, S, E, tid);
        }
        }
#endif
        GRID_BAR();
        { PHASE_BEGIN(); ln2_phase(P, ws, layer, gw, NGW, lane, (layer + 1 == DEPTH) ? P->out : nullptr, (layer + 1 == DEPTH) ? nullptr : (bf16_t*)(ws + WS_XB)); }
        if (layer + 1 < DEPTH) { PHASE_BEGIN(); __syncthreads(); convert_phase(P, ws, layer + 1, lds, gw, NGW, wave, lane); }
    }
}

extern "C" void kernel_launch(void* const* d_in, const int* in_sizes, int n_in, void* d_out, int out_size, void* d_ws, size_t ws_size, hipStream_t stream) {
    static int grid_blocks = 0;
    if (grid_blocks == 0) {
        if (n_in != 22 || out_size != NT * DM || ws_size < WS_END) { fprintf(stderr, "kernel_launch: unexpected problem (n_in %d, out %d, ws %zu < %zu)\n", n_in, out_size, ws_size, (size_t)WS_END); grid_blocks = -1; return; }
        int dev = 0, cus = 0, per_cu = 0;
        (void)hipGetDevice(&dev);
        (void)hipDeviceGetAttribute(&cus, hipDeviceAttributeMultiprocessorCount, dev);
        (void)hipFuncSetAttribute((const void*)mk_forward, hipFuncAttributeMaxDynamicSharedMemorySize, LDS_BYTES);
        if (hipOccupancyMaxActiveBlocksPerMultiprocessor(&per_cu, (const void*)mk_forward, 512, LDS_BYTES) != hipSuccess || per_cu < 1) { fprintf(stderr, "kernel_launch: occupancy query says %d blocks per CU\n", per_cu); grid_blocks = -1; return; }
        grid_blocks = 256; if (cus < 256) { fprintf(stderr, "kernel_launch: needs 256 CUs (fused LayerNorm epilogue: one 256x256 unit per workgroup)\n"); grid_blocks = -1; return; }
    }
    if (grid_blocks < 0) return;
    if (hipMemsetAsync((char*)d_ws + WS_BAR, 0, WS_SSQ - WS_BAR, stream) != hipSuccess) { fprintf(stderr, "kernel_launch: memset of the barrier words failed\n"); return; }
    Params p{};
    p.x = (const float*)d_in[0]; p.ln_in_g = (const float*)d_in[1]; p.ln_in_b = (const float*)d_in[2]; p.w_in = (const float*)d_in[3];
    p.a_q_ln_g = (const float*)d_in[4]; p.a_kv_ln_g = (const float*)d_in[5]; p.a_w_uq = (const float*)d_in[6]; p.a_w_ukv = (const float*)d_in[7];
    p.c_sinks = (const float*)d_in[8]; p.w_br_a = (const float*)d_in[9]; p.w_br_b = (const float*)d_in[10]; p.w_br_c = (const float*)d_in[11];
    p.w_out = (const float*)d_in[12]; p.ln1_g = (const float*)d_in[13]; p.ln1_b = (const float*)d_in[14]; p.w_router = (const float*)d_in[15];
    p.router_bias = (const float*)d_in[16]; p.w_exp_gate = (const float*)d_in[17]; p.w_exp_up = (const float*)d_in[18]; p.w_exp_down = (const float*)d_in[19];
    p.ln2_g = (const float*)d_in[20]; p.ln2_b = (const float*)d_in[21];
    p.out = (float*)d_out; p.ws = (unsigned char*)d_ws;
    void* args[] = {&p};
    hipError_t e = hipLaunchCooperativeKernel((void*)mk_forward, dim3(grid_blocks), dim3(512), args, LDS_BYTES, stream);
    if (e != hipSuccess) fprintf(stderr, "kernel_launch: cooperative launch failed: %s (grid %d)\n", hipGetErrorString(e), grid_blocks);
}
```

```cpp
#include <hip/hip_runtime.h>
#include <hip/hip_cooperative_groups.h>
#include <cstdio>
#include <cstdint>
namespace cg = cooperative_groups;

#define LAS __attribute__((address_space(3)))
typedef unsigned short bf16_t;
typedef short bf16x8 __attribute__((ext_vector_type(8)));
typedef short s16x4 __attribute__((ext_vector_type(4)));
typedef float f32x2 __attribute__((ext_vector_type(2)));
typedef float f32x4 __attribute__((ext_vector_type(4)));
typedef float f32x16 __attribute__((ext_vector_type(16)));
typedef unsigned u32x2 __attribute__((ext_vector_type(2)));
typedef unsigned u32x4 __attribute__((ext_vector_type(4)));
typedef __bf16 bf2_t __attribute__((ext_vector_type(2)));
typedef unsigned long long u64;

constexpr int NT = 16384, SEQ = 2048, NB = 8, DM = 1024, INC = 5604, DEPTH = 2;
constexpr int NEXP = 16, DEXP = 512;
constexpr float ALPHA = 1.4142135623730951f;
constexpr float LN_EPS = 1e-5f, RMS_EPS = 1e-6f;
constexpr float LOG2E = 1.4426950408889634f;
constexpr float QS64 = 0.125f * LOG2E;
constexpr float QS96 = 0.10206207261596575f * LOG2E;
constexpr float SSQ_SCALE = 16777216.0f;
constexpr int XS_ROWS = 36864;

constexpr size_t al256(size_t x) { return (x + 255) & ~(size_t)255; }
constexpr size_t WS_CNT   = 0;
constexpr size_t WS_WGCNT = 1024;
constexpr size_t WS_BAR   = 17408;
constexpr size_t WS_PCNT  = 32768;
constexpr size_t WS_HRDY  = 65536;
constexpr size_t WS_CVQ   = 139264;
constexpr size_t WS_SSQ   = 147456;
constexpr size_t WS_CS64  = WS_SSQ + (size_t)DEPTH * 2 * NT * 8;
constexpr size_t WS_CS32  = WS_CS64 + (size_t)SEQ * 32 * 8;
constexpr size_t WS_ROUTE = WS_CS32 + (size_t)SEQ * 16 * 8;
constexpr size_t WS_ROWTOK = WS_ROUTE + (size_t)NT * 24;
constexpr size_t WS_ROWW  = WS_ROWTOK + (size_t)XS_ROWS * 4;
constexpr size_t WS_XBUF  = al256(WS_ROWW + (size_t)XS_ROWS * 4);
constexpr size_t WS_WB    = al256(WS_XBUF + (size_t)NT * 4 * 8);
constexpr size_t WB_W1   = WS_WB;
constexpr size_t WB_WG   = WB_W1 + (size_t)2816 * 1024 * 2;
constexpr size_t WB_WUQ  = WB_WG + (size_t)3072 * 1024 * 2;
constexpr size_t WB_WUKV = WB_WUQ + (size_t)768 * 384 * 2;
constexpr size_t WB_WBR  = WB_WUKV + (size_t)1024 * 256 * 2;
constexpr size_t WB_WOUT = WB_WBR + (size_t)3 * 1024 * 512 * 2;
constexpr size_t WB_WGU  = WB_WOUT + (size_t)1024 * 1024 * 2;
constexpr size_t WB_WDN  = WB_WGU + (size_t)16 * 1024 * 1024 * 2;
constexpr size_t WS_XB   = WB_WDN + (size_t)16 * 1024 * 512 * 2;
constexpr size_t WS_OABC = WS_XB + (size_t)NT * 1024 * 2;
constexpr size_t WS_R    = WS_OABC + (size_t)3 * NT * 512 * 2;
constexpr size_t R_QLAT  = WS_R;
constexpr size_t R_KVLAT = R_QLAT + (size_t)NT * 384 * 2;
constexpr size_t R_KPE   = R_KVLAT + (size_t)NT * 256 * 2;
constexpr size_t R_BQ    = R_KPE + (size_t)NT * 32 * 2;
constexpr size_t R_BK    = R_BQ + (size_t)NT * 512 * 2;
constexpr size_t R_BVT   = R_BK + (size_t)NT * 128 * 2;
constexpr size_t R_BQI   = R_BVT + (size_t)NT * 128 * 2;
constexpr size_t R_BKI   = R_BQI + (size_t)NT * 256 * 2;
constexpr size_t R_WIDX  = R_BKI + (size_t)NT * 64 * 2;
constexpr size_t R_CQ    = R_WIDX + (size_t)NT * 4 * 4;
constexpr size_t R_CK    = R_CQ + (size_t)NT * 512 * 2;
constexpr size_t R_CVT   = R_CK + (size_t)NT * 128 * 2;
constexpr size_t R_AQ    = R_CVT + (size_t)NT * 128 * 2;
constexpr size_t R_AKN   = R_AQ + (size_t)NT * 768 * 2;
constexpr size_t R_AVT   = R_AKN + (size_t)NT * 512 * 2;
constexpr size_t R_MASK  = R_AVT + (size_t)NT * 512 * 2;
constexpr size_t R_BV    = R_MASK + (size_t)NT * 64 * 4;
constexpr size_t R_CV    = R_BV + (size_t)NT * 128 * 2;
constexpr size_t R_AV    = R_CV + (size_t)NT * 128 * 2;
constexpr size_t R_XB8   = R_BV;
constexpr size_t R_END1  = R_AV + (size_t)NT * 512 * 2;
constexpr size_t R_GATES = WS_R;
constexpr size_t R_MERGED = R_GATES + (size_t)NT * 3072 * 2;
constexpr size_t R_END2  = R_MERGED + (size_t)NT * 1024 * 2;
constexpr size_t R_Y2    = WS_R;
constexpr size_t R_END3  = R_Y2 + (size_t)NT * 2 * 1024 * 2;
constexpr size_t WS_H    = WS_OABC;
constexpr size_t cmax(size_t a, size_t b) { return a > b ? a : b; }
constexpr size_t WS_END  = cmax(R_END1, cmax(R_END2, R_END3));
static_assert((size_t)XS_ROWS * 512 * 2 <= (size_t)3 * NT * 512 * 2, "H fits in OABC");
static_assert(WS_END <= (size_t)332 * 1024 * 1024, "workspace budget");
static_assert(R_XB8 >= R_END2 && R_XB8 >= R_END3 && R_XB8 + (size_t)NT * 1024 <= R_END1, "fp8 x copy placement");

constexpr int LDS_BYTES = 147456;
constexpr int LDS_MISC = 147456 - 64;

struct Params {
    const float* x; const float* ln_in_g; const float* ln_in_b; const float* w_in; const float* a_q_ln_g; const float* a_kv_ln_g;
    const float* a_w_uq; const float* a_w_ukv; const float* c_sinks; const float* w_br_a; const float* w_br_b; const float* w_br_c; const float* w_out;
    const float* ln1_g; const float* ln1_b; const float* w_router; const float* router_bias; const float* w_exp_gate; const float* w_exp_up; const float* w_exp_down;
    const float* ln2_g; const float* ln2_b;
    float* out; unsigned char* ws;
};

typedef const __attribute__((address_space(4))) Params* KernArgP;
__device__ __forceinline__ unsigned pk2(float lo, float hi) { f32x2 v = {lo, hi}; return __builtin_bit_cast(unsigned, __builtin_convertvector(v, bf2_t)); }
__device__ __forceinline__ float bf_lo(unsigned w) { return __uint_as_float(w << 16); }
__device__ __forceinline__ float bf_hi(unsigned w) { return __uint_as_float(w & 0xffff0000u); }
__device__ __forceinline__ float shx(float v, int mask, int lane) { return __int_as_float(__builtin_amdgcn_ds_bpermute((lane ^ mask) << 2, __float_as_int(v))); }
__device__ __forceinline__ unsigned shxu(unsigned v, int mask, int lane) { return (unsigned)__builtin_amdgcn_ds_bpermute((lane ^ mask) << 2, (int)v); }
__device__ __forceinline__ float wave_sum(float v, int lane) {
#pragma unroll
    for (int o = 1; o < 64; o <<= 1) v += shx(v, o, lane);
    return v;
}
template <class T> __device__ __forceinline__ T* uniform_ptr(T* p) {
    const unsigned long long v = (unsigned long long)p; const unsigned lo = __builtin_amdgcn_readfirstlane((unsigned)v), hi = __builtin_amdgcn_readfirstlane((unsigned)(v >> 32));
    return (T*)(((unsigned long long)hi << 32) | lo); }
__device__ __forceinline__ int f8x4(float a, float b, float c, float d) {
    a = __builtin_amdgcn_fmed3f(a, -440.0f, 440.0f); b = __builtin_amdgcn_fmed3f(b, -440.0f, 440.0f); c = __builtin_amdgcn_fmed3f(c, -440.0f, 440.0f); d = __builtin_amdgcn_fmed3f(d, -440.0f, 440.0f);
    int p = 0; p = __builtin_amdgcn_cvt_pk_fp8_f32(a, b, p, false); p = __builtin_amdgcn_cvt_pk_fp8_f32(c, d, p, true); return p; }
__device__ __forceinline__ float fast_sigmoid(float v) { return __builtin_amdgcn_rcpf(1.0f + __builtin_amdgcn_exp2f(-v * LOG2E)); }
namespace pg8 {
#ifndef PG8_PIN
#define PG8_PIN 1
#endif
#define PG8_LAS __attribute__((address_space(3)))
constexpr int BM = 256, BK = 64, HALF = 128, HTB = HALF * BK * 2, STAGE_BYTES = 8 * HTB, NXCD = 8, WGM = 8;
__host__ __device__ __forceinline__ int lds_byte(int r, int c) { const int st = (r >> 4) * 2 + (c >> 5), rr = r & 15, cc = c & 31, ob = rr * 64 + cc * 2; return st * 1024 + (ob ^ (((ob >> 9) & 1) << 5)); }
__host__ __device__ __forceinline__ void stage_rc(int b, int& R, int& C) { const int st = b / 1024, sb = b % 1024, swz = sb ^ (((sb >> 9) & 1) << 5); R = (st >> 1) * 16 + swz / 64; C = (st & 1) * 32 + (swz % 64) / 2; }
__host__ __device__ __forceinline__ int perm32(int rho) { const int n = rho >> 4, i = rho & 15; return 8 * (i >> 2) + 4 * n + (i & 3); }
struct Unit { int pm, pn; };
struct Gemm { const bf16_t* A; const bf16_t* Bt; int K; const int* rowmap; };
struct StaticOrder {
    int nM, nN, nwg, G, c;
    __device__ void init(int M, int N, int G_, int c_) { nM = M / BM; nN = N / BM; nwg = nM * nN; G = G_; c = c_; }
    __device__ bool next(int i, Unit& u) const {
        const long L = (long)i * G + c; if (L >= nwg) return false;
        int wgid = (int)L; { const int q = nwg / NXCD, r = nwg % NXCD, xcd = wgid % NXCD, off = wgid / NXCD; wgid = (xcd < r ? xcd * (q + 1) : r * (q + 1) + (xcd - r) * q) + off; }
        const int nig = WGM * nN, gid = wgid / nig, fm = gid * WGM, gsz = (nM - fm) < WGM ? (nM - fm) : WGM;
        u.pm = fm + ((wgid % nig) % gsz); u.pn = (wgid % nig) / gsz; return true;
    }
    __device__ __forceinline__ void a_ready(const Unit&, int) const {}
    __device__ __forceinline__ void done(const Unit&, int) const {}
};
template <class Epi, class Sched, bool ALIGN_EPI, bool SP2, bool GATHER = false, bool F8 = false>
__device__ __forceinline__ void gemm_phase(PG8_LAS unsigned char* lds, const Gemm g, const Sched& S, const Epi& E, const int tid) {
    const int wid = __builtin_amdgcn_readfirstlane(tid >> 6), lane = tid & 63, wr = wid >> 2, wc = wid & 3, fr = lane & 15, fq = lane >> 4;
    const int K = g.K, nt = K / BK;
    unsigned voffA[2], voffB[2];
#pragma unroll
    for (int i = 0; i < 2; ++i) { int R, C; stage_rc(tid * 16 + i * 8192, R, C); const int Rb = (R & ~31) + perm32(R & 31);
        voffA[i] = (unsigned)(R * K + C) * 2u; voffB[i] = (unsigned)(Rb * K + C) * 2u; }
    unsigned cOff[2][2];
    PG8_LAS u32x4* nslot = (PG8_LAS u32x4*)(lds + STAGE_BYTES) + tid;
#define PG8_GOFF(U, OFF) do { const int* rm_ = g.rowmap + (U).pm * 256; _Pragma("unroll") for (int _h = 0; _h < 2; ++_h) _Pragma("unroll") for (int _i = 0; _i < 2; ++_i) { int R_, C_; stage_rc(tid * 16 + _i * 8192, R_, C_); \
        const int tk_ = rm_[128 * _h + R_]; const int tok_ = tk_ < 0 ? 0 : (tk_ >> 1); OFF[_h][_i] = (unsigned)(tok_ * K + C_) * 2u; } } while (0)
    const size_t kstep = (size_t)(BK * 2);
    const size_t hstep = (size_t)HALF * K * 2;
    const size_t tstep = 2 * hstep;
    const unsigned ldsw = (unsigned)wid * 1024u;
    const int aoff = lds_byte(wr * 64 + fr, fq * 8), boff = lds_byte(wc * 32 + fr, fq * 8);
#define PG8_SA(b, h) (((b) * 2 + (h)) * HTB)
#define PG8_SB(b, h) ((4 + (b) * 2 + (h)) * HTB)
#define PG8_STAGE(bufoff, gbase, voff) do { _Pragma("unroll") for (int _i = 0; _i < 2; ++_i) { unsigned vo_ = (voff)[_i]; if (F8 || PG8_PIN) asm volatile("" : "+v"(vo_));     \
        __builtin_amdgcn_global_load_lds((const unsigned*)(((F8 || PG8_PIN) ? uniform_ptr((const char*)(gbase)) : (const char*)(gbase)) + vo_), (PG8_LAS unsigned*)(lds + (bufoff) + ldsw + _i * 8192), 16, 0, 0); } } while (0)
#define PG8_LD8(p) __builtin_shufflevector(*(const PG8_LAS v4i32*)(p), *(const PG8_LAS v4i32*)((p) + 1024), 0, 1, 2, 3, 4, 5, 6, 7)
#define PG8_LDA(dst, b, h) do { if constexpr (F8) { _Pragma("unroll") for (int m = 0; m < 4; ++m) dst##8[m] = PG8_LD8(lds + PG8_SA(b, h) + aoff + m * 2048); } \
        else { _Pragma("unroll") for (int m = 0; m < 4; ++m) _Pragma("unroll") for (int k = 0; k < 2; ++k) dst[m][k] = *(const PG8_LAS bf16x8*)(lds + PG8_SA(b, h) + aoff + m * 2048 + k * 1024); } } while (0)
#define PG8_LDB(dst, b, h) do { if constexpr (F8) { _Pragma("unroll") for (int n = 0; n < 2; ++n) dst##8[n] = PG8_LD8(lds + PG8_SB(b, h) + boff + n * 2048); } \
        else { _Pragma("unroll") for (int n = 0; n < 2; ++n) _Pragma("unroll") for (int k = 0; k < 2; ++k) dst[n][k] = *(const PG8_LAS bf16x8*)(lds + PG8_SB(b, h) + boff + n * 2048 + k * 1024); } } while (0)
#define PG8_MMA(ai, bj, At, Bt) do { __builtin_amdgcn_s_setprio(1); _Pragma("unroll") for (int m = 0; m < 4; ++m) _Pragma("unroll") for (int n = 0; n < 2; ++n) { \
        if constexpr (F8) acc[ai][bj][m][n] = __builtin_amdgcn_mfma_scale_f32_16x16x128_f8f6f4(Bt##8[n], At##8[m], acc[ai][bj][m][n], 0, 0, 0, 0x7F7F7F7F, 0, 0x7F7F7F7F); \
        else { _Pragma("unroll") for (int k = 0; k < 2; ++k) acc[ai][bj][m][n] = __builtin_amdgcn_mfma_f32_16x16x32_bf16(Bt[n][k], At[m][k], acc[ai][bj][m][n], 0, 0, 0); } } \
        __builtin_amdgcn_s_setprio(0); } while (0)
#define PG8_WAIT_V(n) asm volatile("s_waitcnt vmcnt(" #n ")" ::: "memory")
#define PG8_WAIT_L(n) asm volatile("s_waitcnt lgkmcnt(" #n ")" ::: "memory")
#define PG8_BAR __builtin_amdgcn_s_barrier()
#define PG8_SCHED __builtin_amdgcn_sched_barrier(0)
    Unit cur, nxt; int ui = 0;
    if (!S.next(0, cur)) return;
    if constexpr (F8 || PG8_PIN) { cur.pm = __builtin_amdgcn_readfirstlane(cur.pm); cur.pn = __builtin_amdgcn_readfirstlane(cur.pn); }
    S.a_ready(cur, tid);
    f32x4 acc[2][2][4][2];
#pragma unroll
    for (int a = 0; a < 2; ++a)
#pragma unroll
        for (int b = 0; b < 2; ++b)
#pragma unroll
            for (int m = 0; m < 4; ++m)
#pragma unroll
                for (int n = 0; n < 2; ++n) acc[a][b][m][n] = (f32x4){0.f, 0.f, 0.f, 0.f};
    typedef int v8i32 __attribute__((ext_vector_type(8))); typedef int v4i32 __attribute__((ext_vector_type(4)));
    bf16x8 At[4][2], B0[2][2], B1[2][2]; v8i32 At8[4], B08[2], B18[2];
    const char* cA = GATHER ? (const char*)g.A : (const char*)g.A + (size_t)cur.pm * tstep; const char* cB = (const char*)g.Bt + (size_t)cur.pn * tstep;
    if constexpr (GATHER) { PG8_GOFF(cur, cOff); asm volatile("s_waitcnt vmcnt(0)" ::: "memory"); }
    if constexpr (SP2) {
        PG8_STAGE(PG8_SB(0, 0), cB, voffB); PG8_STAGE(PG8_SB(0, 1), cB + hstep, voffB);
        if constexpr (GATHER) { PG8_STAGE(PG8_SA(0, 0), cA, cOff[0]); PG8_STAGE(PG8_SA(0, 1), cA, cOff[1]); } else { PG8_STAGE(PG8_SA(0, 0), cA, voffA); PG8_STAGE(PG8_SA(0, 1), cA + hstep, voffA); }
        if (wr == 1) PG8_BAR;
        PG8_WAIT_V(2); PG8_BAR;
        PG8_STAGE(PG8_SB(1, 0), cB + kstep, voffB); if constexpr (GATHER) PG8_STAGE(PG8_SA(1, 0), cA + kstep, cOff[0]); else PG8_STAGE(PG8_SA(1, 0), cA + kstep, voffA); PG8_STAGE(PG8_SB(1, 1), cB + hstep + kstep, voffB);
        PG8_WAIT_V(6); PG8_BAR;
    } else {
        PG8_STAGE(PG8_SB(0, 0), cB, voffB); PG8_STAGE(PG8_SA(0, 0), cA, voffA); PG8_STAGE(PG8_SB(0, 1), cB + hstep, voffB); PG8_STAGE(PG8_SA(0, 1), cA + hstep, voffA);
        if (wr == 1) PG8_BAR;
        PG8_WAIT_V(4); PG8_BAR;
        PG8_STAGE(PG8_SB(1, 0), cB + kstep, voffB); PG8_STAGE(PG8_SA(1, 0), cA + kstep, voffA); PG8_STAGE(PG8_SB(1, 1), cB + hstep + kstep, voffB);
        PG8_WAIT_V(6); PG8_BAR;
    }
    for (;;) {
        const bool has_next = S.next(ui + 1, nxt);
        if constexpr (F8 || PG8_PIN) { nxt.pm = __builtin_amdgcn_readfirstlane(nxt.pm); nxt.pn = __builtin_amdgcn_readfirstlane(nxt.pn); }
        const char* nA = GATHER ? cA : (has_next ? (const char*)g.A + (size_t)nxt.pm * tstep : cA); const char* nB = has_next ? (const char*)g.Bt + (size_t)nxt.pn * tstep : cB;
        if constexpr (GATHER) { unsigned t_[2][2]; if (has_next) PG8_GOFF(nxt, t_); else { _Pragma("unroll") for (int _h = 0; _h < 2; ++_h) _Pragma("unroll") for (int _i = 0; _i < 2; ++_i) t_[_h][_i] = cOff[_h][_i]; }
            u32x4 pk_; pk_.x = t_[0][0]; pk_.y = t_[0][1]; pk_.z = t_[1][0]; pk_.w = t_[1][1]; *nslot = pk_; }
#pragma unroll 1
        for (int t = 0; t < nt; t += 2) {
            const bool last = (t == nt - 2);
            const char* a1 = cA + (size_t)(t + 1) * kstep;
            const char* a2 = last ? nA : cA + (size_t)(t + 2) * kstep; const char* b2 = last ? nB : cB + (size_t)(t + 2) * kstep;
            const char* a3 = a2 + kstep; const char* b3 = b2 + kstep;
            if (last && has_next) S.a_ready(nxt, tid);
            if constexpr (SP2 && GATHER) {
#define PG8_STAGE_SEL(bufoff, gbase, H) PG8_STAGE(bufoff, gbase, cOff[H])
            const char* g2 = last ? cA : cA + (size_t)(t + 2) * kstep; const char* g3 = g2 + kstep;
            PG8_LDB(B0, 0, 0); PG8_LDB(B1, 0, 1); PG8_SCHED; PG8_LDA(At, 0, 0); PG8_STAGE(PG8_SA(1, 1), a1, cOff[1]);
            if (last) { const u32x4 nf_ = *nslot; cOff[0][0] = nf_.x; cOff[0][1] = nf_.y; cOff[1][0] = nf_.z; cOff[1][1] = nf_.w; }
            PG8_WAIT_V(8); PG8_WAIT_L(0); PG8_BAR; PG8_MMA(0, 0, At, B0); PG8_MMA(0, 1, At, B1); PG8_BAR; PG8_SCHED;
            PG8_LDA(At, 0, 1); PG8_STAGE(PG8_SB(0, 0), b2, voffB); PG8_STAGE(PG8_SB(0, 1), b2 + hstep, voffB); PG8_STAGE_SEL(PG8_SA(0, 0), g2, 0);
            PG8_WAIT_V(8); PG8_WAIT_L(0); PG8_BAR; PG8_MMA(1, 0, At, B0); PG8_MMA(1, 1, At, B1); PG8_BAR; PG8_SCHED;
            PG8_LDB(B0, 1, 0); PG8_LDB(B1, 1, 1); PG8_SCHED; PG8_LDA(At, 1, 0); PG8_STAGE_SEL(PG8_SA(0, 1), g2, 1);
            PG8_WAIT_V(8); PG8_WAIT_L(0); PG8_BAR; PG8_MMA(0, 0, At, B0); PG8_MMA(0, 1, At, B1); PG8_BAR; PG8_SCHED;
            PG8_LDA(At, 1, 1); PG8_STAGE(PG8_SB(1, 0), b3, voffB); PG8_STAGE(PG8_SB(1, 1), b3 + hstep, voffB); PG8_STAGE_SEL(PG8_SA(1, 0), g3, 0);
            PG8_WAIT_V(8); PG8_WAIT_L(0); PG8_BAR; PG8_MMA(1, 0, At, B0); PG8_MMA(1, 1, At, B1); PG8_BAR; PG8_SCHED;
            } else             if constexpr (SP2) {
            PG8_LDB(B0, 0, 0); PG8_LDB(B1, 0, 1); PG8_SCHED; PG8_LDA(At, 0, 0); PG8_STAGE(PG8_SA(1, 1), a1 + hstep, voffA);
            PG8_WAIT_V(8); PG8_WAIT_L(0); PG8_BAR; PG8_MMA(0, 0, At, B0); PG8_MMA(0, 1, At, B1); PG8_BAR; PG8_SCHED;
            PG8_LDA(At, 0, 1); PG8_STAGE(PG8_SB(0, 0), b2, voffB); PG8_STAGE(PG8_SB(0, 1), b2 + hstep, voffB); PG8_STAGE(PG8_SA(0, 0), a2, voffA);
            PG8_WAIT_V(8); PG8_WAIT_L(0); PG8_BAR; PG8_MMA(1, 0, At, B0); PG8_MMA(1, 1, At, B1); PG8_BAR; PG8_SCHED;
            PG8_LDB(B0, 1, 0); PG8_LDB(B1, 1, 1); PG8_SCHED; PG8_LDA(At, 1, 0); PG8_STAGE(PG8_SA(0, 1), a2 + hstep, voffA);
            PG8_WAIT_V(8); PG8_WAIT_L(0); PG8_BAR; PG8_MMA(0, 0, At, B0); PG8_MMA(0, 1, At, B1); PG8_BAR; PG8_SCHED;
            PG8_LDA(At, 1, 1); PG8_STAGE(PG8_SB(1, 0), b3, voffB); PG8_STAGE(PG8_SB(1, 1), b3 + hstep, voffB); PG8_STAGE(PG8_SA(1, 0), a3, voffA);
            PG8_WAIT_V(8); PG8_WAIT_L(0); PG8_BAR; PG8_MMA(1, 0, At, B0); PG8_MMA(1, 1, At, B1); PG8_BAR; PG8_SCHED;
            } else {
            PG8_LDB(B0, 0, 0); PG8_SCHED; PG8_LDA(At, 0, 0); PG8_STAGE(PG8_SA(1, 1), a1 + hstep, voffA);
            PG8_WAIT_L(8); PG8_BAR; PG8_WAIT_L(0); PG8_MMA(0, 0, At, B0); PG8_BAR; PG8_SCHED;
            PG8_LDB(B1, 0, 1); PG8_STAGE(PG8_SB(0, 0), b2, voffB);
            PG8_BAR; PG8_WAIT_L(0); PG8_MMA(0, 1, At, B1); PG8_BAR;
            PG8_LDA(At, 0, 1); PG8_STAGE(PG8_SA(0, 0), a2, voffA);
            PG8_BAR; PG8_WAIT_L(0); PG8_MMA(1, 0, At, B0); PG8_BAR; PG8_SCHED;
            PG8_STAGE(PG8_SB(0, 1), b2 + hstep, voffB);
            PG8_WAIT_V(6); PG8_BAR; PG8_MMA(1, 1, At, B1); PG8_BAR;
            PG8_LDB(B0, 1, 0); PG8_SCHED; PG8_LDA(At, 1, 0); PG8_STAGE(PG8_SA(0, 1), a2 + hstep, voffA);
            PG8_WAIT_L(8); PG8_BAR; PG8_WAIT_L(0); PG8_MMA(0, 0, At, B0); PG8_BAR; PG8_SCHED;
            PG8_LDB(B1, 1, 1); PG8_STAGE(PG8_SB(1, 0), b3, voffB);
            PG8_BAR; PG8_WAIT_L(0); PG8_MMA(0, 1, At, B1); PG8_BAR;
            PG8_LDA(At, 1, 1); PG8_STAGE(PG8_SA(1, 0), a3, voffA);
            PG8_BAR; PG8_WAIT_L(0); PG8_MMA(1, 0, At, B0); PG8_BAR; PG8_SCHED;
            PG8_STAGE(PG8_SB(1, 1), b3 + hstep, voffB);
            PG8_WAIT_V(6); PG8_BAR; PG8_MMA(1, 1, At, B1); PG8_BAR;
            }
        }
        if constexpr (ALIGN_EPI) { if (wr == 0) PG8_BAR; }
        bool keep = false;
        if constexpr (!Epi::AFTER_DRAIN) { keep = E(acc, cur, wr, wc, fr, fq); S.done(cur, tid); }
        if (!has_next) break;
        if (!keep) {
#pragma unroll
        for (int a = 0; a < 2; ++a)
#pragma unroll
            for (int b = 0; b < 2; ++b)
#pragma unroll
                for (int m = 0; m < 4; ++m)
#pragma unroll
                    for (int n = 0; n < 2; ++n) acc[a][b][m][n] = (f32x4){0.f, 0.f, 0.f, 0.f};
        }
        cur = nxt; cA = nA; cB = nB; ++ui;
        if constexpr (ALIGN_EPI) { if (wr == 1) PG8_BAR; }
    }
    PG8_WAIT_V(0);
    if constexpr (!ALIGN_EPI) { if (wr == 0) PG8_BAR; }
    PG8_BAR;
    if constexpr (Epi::AFTER_DRAIN) E.fused(acc, cur, wr, wc, fr, fq, lds, wid, lane);
#undef PG8_GOFF
#undef PG8_STAGE_SEL
#undef PG8_SA
#undef PG8_SB
#undef PG8_STAGE
#undef PG8_LDA
#undef PG8_LD8
#undef PG8_LDB
#undef PG8_MMA
#undef PG8_WAIT_V
#undef PG8_WAIT_L
#undef PG8_BAR
#undef PG8_SCHED
}
}
using pg8::Unit;
#define EPI_ROWS(ai, m) (row0 + 128 * (ai) + 16 * (m))
#ifndef EPI_WT
#define EPI_WT 0
#endif
__device__ __forceinline__ void store8_bf16(bf16_t* p, const f32x4& a, const f32x4& b) {
    u32x4 w; w.x = pk2(a[0], a[1]); w.y = pk2(a[2], a[3]); w.z = pk2(b[0], b[1]); w.w = pk2(b[2], b[3]);
    if (EPI_WT) asm volatile("global_store_dwordx4 %0, %1, off sc1\n\ts_nop 1" :: "v"(p), "v"(w) : "memory"); else *(u32x4*)p = w;
}
__device__ __forceinline__ void rope8_store(const f32x4& a0, const f32x4& a1, const f32x4& b0, const f32x4& b1, const f32x4* cs, float sc, bf16_t* p1, bf16_t* p2) {
    const f32x4 c0 = cs[0], c1 = cs[1], c2 = cs[2], c3 = cs[3];
    f32x4 o1a, o1b, o2a, o2b;
    o1a[0] = (a0[0] * c0[0] - b0[0] * c0[1]) * sc; o2a[0] = (b0[0] * c0[0] + a0[0] * c0[1]) * sc;
    o1a[1] = (a0[1] * c0[2] - b0[1] * c0[3]) * sc; o2a[1] = (b0[1] * c0[2] + a0[1] * c0[3]) * sc;
    o1a[2] = (a0[2] * c1[0] - b0[2] * c1[1]) * sc; o2a[2] = (b0[2] * c1[0] + a0[2] * c1[1]) * sc;
    o1a[3] = (a0[3] * c1[2] - b0[3] * c1[3]) * sc; o2a[3] = (b0[3] * c1[2] + a0[3] * c1[3]) * sc;
    o1b[0] = (a1[0] * c2[0] - b1[0] * c2[1]) * sc; o2b[0] = (b1[0] * c2[0] + a1[0] * c2[1]) * sc;
    o1b[1] = (a1[1] * c2[2] - b1[1] * c2[3]) * sc; o2b[1] = (b1[1] * c2[2] + a1[1] * c2[3]) * sc;
    o1b[2] = (a1[2] * c3[0] - b1[2] * c3[1]) * sc; o2b[2] = (b1[2] * c3[0] + a1[2] * c3[1]) * sc;
    o1b[3] = (a1[3] * c3[2] - b1[3] * c3[3]) * sc; o2b[3] = (b1[3] * c3[2] + a1[3] * c3[3]) * sc;
    store8_bf16(p1, o1a, o1b); store8_bf16(p2, o2a, o2b);
}
__device__ __forceinline__ float sumsq8(const f32x4& a, const f32x4& b) { return (a[0] * a[0] + a[1] * a[1]) + (a[2] * a[2] + a[3] * a[3]) + (b[0] * b[0] + b[1] * b[1]) + (b[2] * b[2] + b[3] * b[3]); }
__device__ __forceinline__ void vt_store8(bf16_t* p  , const f32x4& a, const f32x4& b) {
    const unsigned w0 = pk2(a[0], a[1]), w1 = pk2(a[2], a[3]), w2 = pk2(b[0], b[1]), w3 = pk2(b[2], b[3]);
    p[0 * 64] = (bf16_t)w0; p[1 * 64] = (bf16_t)(w0 >> 16); p[2 * 64] = (bf16_t)w1; p[3 * 64] = (bf16_t)(w1 >> 16);
    p[4 * 64] = (bf16_t)w2; p[5 * 64] = (bf16_t)(w2 >> 16); p[6 * 64] = (bf16_t)w3; p[7 * 64] = (bf16_t)(w3 >> 16);
}

struct Epi1 {
    static constexpr bool AFTER_DRAIN = false;
    unsigned char* ws; int layer;
    __device__ __forceinline__ bool operator()(f32x4 (&acc)[2][2][4][2], const Unit& u, int wr, int wc, int fr, int fq) const {
        const int pn = u.pn, row0 = u.pm * 256 + wr * 64 + fr;
        if (pn <= 6) {
            bf16_t* dst; int ld, hc, half = 32; float sc = 1.f; bool valid = true;
            if (pn == 0)      { dst = (bf16_t*)(ws + R_BQ);  ld = 512; hc = 64 * wc;       sc = QS64; }
            else if (pn == 1) { dst = (bf16_t*)(ws + R_BQ);  ld = 512; hc = 64 * (4 + wc); sc = QS64; }
            else if (pn == 2) { dst = (bf16_t*)(ws + R_CQ);  ld = 512; hc = 64 * wc;       sc = QS64; }
            else if (pn == 3) { dst = (bf16_t*)(ws + R_CQ);  ld = 512; hc = 64 * (4 + wc); sc = QS64; }
            else if (pn == 4) { dst = (bf16_t*)(ws + R_BQI); ld = 256; hc = 64 * wc; }
            else if (pn == 5) { if (wc < 2) { dst = (bf16_t*)(ws + R_BK); ld = 128; hc = 64 * wc; } else { dst = (bf16_t*)(ws + R_CK); ld = 128; hc = 64 * (wc - 2); } }
            else { if (wc == 0) { dst = (bf16_t*)(ws + R_BKI); ld = 64; hc = 0; } else { dst = (bf16_t*)(ws + R_KPE); ld = 32; hc = 0; half = 16; valid = (wc == 1) && (fq < 2); } }
            const f32x2* tab = (const f32x2*)(ws + (half == 32 ? WS_CS64 : WS_CS32));
            const int ci = (half == 32) ? 8 * fq : 8 * (fq & 1);
            if (valid) {
#pragma unroll
                for (int ai = 0; ai < 2; ++ai) {
                    f32x4 csv[4][4];
#pragma unroll
                    for (int m = 0; m < 4; ++m) { const int t = EPI_ROWS(ai, m) & (SEQ - 1); const f32x4* cs = (const f32x4*)(tab + (size_t)t * half + ci);
#pragma unroll
                        for (int q = 0; q < 4; ++q) csv[m][q] = cs[q]; }
                    __builtin_amdgcn_sched_barrier(0);
#pragma unroll
                    for (int m = 0; m < 4; ++m) {
                        const int r = EPI_ROWS(ai, m);
                        bf16_t* p = dst + (size_t)r * ld + hc + ci;
                        rope8_store(acc[ai][0][m][0], acc[ai][0][m][1], acc[ai][1][m][0], acc[ai][1][m][1], csv[m], sc, p, p + half);
                        asm volatile("" ::: "memory");
                    }
                }
            }
            return false;
        }
        u64* ssq = (u64*)(ws + WS_SSQ) + (size_t)layer * 2 * NT;
        bf16_t* QLAT = (bf16_t*)(ws + R_QLAT); bf16_t* KVLAT = (bf16_t*)(ws + R_KVLAT);
        const int c8 = 32 * wc + 8 * fq;
#pragma unroll
        for (int ai = 0; ai < 2; ++ai)
#pragma unroll
            for (int m = 0; m < 4; ++m) {
                const int r = EPI_ROWS(ai, m);
                const f32x4 &v00 = acc[ai][0][m][0], &v01 = acc[ai][0][m][1], &v10 = acc[ai][1][m][0], &v11 = acc[ai][1][m][1];
                if (pn == 7) {
                    store8_bf16(QLAT + (size_t)r * 384 + c8, v00, v01); store8_bf16(QLAT + (size_t)r * 384 + 128 + c8, v10, v11);
                    float ss = sumsq8(v00, v01) + sumsq8(v10, v11); ss += shx(ss, 16, fr + 16 * fq); ss += shx(ss, 32, fr + 16 * fq);
                    if (fq == 0) atomicAdd(ssq + r, (u64)(ss * SSQ_SCALE));
                } else if (pn == 8) {
                    store8_bf16(QLAT + (size_t)r * 384 + 256 + c8, v00, v01);
                    float ss = sumsq8(v00, v01); ss += shx(ss, 16, fr + 16 * fq); ss += shx(ss, 32, fr + 16 * fq);
                    if (fq == 0) atomicAdd(ssq + r, (u64)(ss * SSQ_SCALE));
                    vt_store8((bf16_t*)(ws + R_BVT) + ((size_t)(((r >> 11) * 2 + (c8 >> 6)) * 32 + ((r & 2047) >> 6)) * 64 + (c8 & 63)) * 64 + (r & 63), v10, v11);
                } else if (pn == 9) {
                    store8_bf16(KVLAT + (size_t)r * 256 + c8, v00, v01); store8_bf16(KVLAT + (size_t)r * 256 + 128 + c8, v10, v11);
                    float ss = sumsq8(v00, v01) + sumsq8(v10, v11); ss += shx(ss, 16, fr + 16 * fq); ss += shx(ss, 32, fr + 16 * fq);
                    if (fq == 0) atomicAdd(ssq + NT + r, (u64)(ss * SSQ_SCALE));
                } else {
                    vt_store8((bf16_t*)(ws + R_CVT) + ((size_t)(((r >> 11) * 2 + (c8 >> 6)) * 32 + ((r & 2047) >> 6)) * 64 + (c8 & 63)) * 64 + (r & 63), v00, v01);
                    if (wc == 0 && fq == 0) *(f32x4*)((float*)(ws + R_WIDX) + (size_t)r * 4) = v10 * 0.0625f;
                }
            }
        return false;
    }
};
struct EpiGate {
    static constexpr bool AFTER_DRAIN = false;
    bf16_t* G; float osc = 1.0f;
    __device__ __forceinline__ bool operator()(f32x4 (&acc)[2][2][4][2], const Unit& u, int wr, int wc, int fr_in, int fq_in) const {
        (void)fr_in; (void)fq_in;
        int ln_; asm volatile("v_mbcnt_lo_u32_b32 %0, -1, 0\n\tv_mbcnt_hi_u32_b32 %0, -1, %0" : "=v"(ln_));
        const int fr = ln_ & 15, fq = ln_ >> 4;
        const int row0 = u.pm * 256 + wr * 64 + fr, col0 = u.pn * 256 + 32 * wc + 8 * fq;
#pragma unroll
        for (int ai = 0; ai < 2; ++ai)
#pragma unroll
            for (int m = 0; m < 4; ++m) { bf16_t* rp = G + (size_t)EPI_ROWS(ai, m) * 3072 + col0;
#pragma unroll
                for (int bj = 0; bj < 2; ++bj) { f32x4 a = acc[ai][bj][m][0], b = acc[ai][bj][m][1];
#pragma unroll
                    for (int e = 0; e < 4; ++e) { a[e] = fast_sigmoid(a[e] * osc); b[e] = fast_sigmoid(b[e] * osc); }
                    store8_bf16(rp + 128 * bj, a, b); } }
        return false;
    }
};
struct SchedSub {
    pg8::StaticOrder S; bool on;
    __device__ bool next(int i, Unit& u) const { return on && S.next(i, u); }
    __device__ __forceinline__ void a_ready(const Unit&, int) const {}
    __device__ __forceinline__ void done(const Unit&, int) const {}
};
struct EpiUQ {
    static constexpr bool AFTER_DRAIN = false;
    unsigned char* ws; int layer;
    __device__ __forceinline__ bool operator()(f32x4 (&acc)[2][2][4][2], const Unit& u, int wr, int wc, int fr, int fq) const {
        const int pn = u.pn, row0 = u.pm * 256 + wr * 64 + fr;
        const u64* ssq = (const u64*)(ws + WS_SSQ) + (size_t)layer * 2 * NT;
        bf16_t* AQ = (bf16_t*)(ws + R_AQ);
        u64 sv[2][4];
#pragma unroll
        for (int ai = 0; ai < 2; ++ai)
#pragma unroll
            for (int m = 0; m < 4; ++m) sv[ai][m] = ssq[EPI_ROWS(ai, m)];
        __builtin_amdgcn_sched_barrier(0);
        if (pn < 2) {
            const int d0 = 32 * (wc & 1) + 8 * fq, h0 = 4 * pn + (wc >> 1);
#pragma unroll
            for (int ai = 0; ai < 2; ++ai)
#pragma unroll
                for (int m = 0; m < 4; ++m) {
                    const int r = EPI_ROWS(ai, m);
                    const float rs = __builtin_amdgcn_rsqf((float)(unsigned)(sv[ai][m] >> 12) * (4096.0f / (SSQ_SCALE * 384.0f)) + RMS_EPS) * QS96;
                    bf16_t* p = AQ + (size_t)r * 768 + h0 * 96 + d0;
                    store8_bf16(p, acc[ai][0][m][0] * rs, acc[ai][0][m][1] * rs);
                    store8_bf16(p + 2 * 96, acc[ai][1][m][0] * rs, acc[ai][1][m][1] * rs);
                    asm volatile("" ::: "memory");
                }
        } else {
            const int head = 2 * wc + (fq >> 1), i0 = 8 * (fq & 1);
#pragma unroll
            for (int ai = 0; ai < 2; ++ai)
#pragma unroll
                for (int m = 0; m < 4; ++m) {
                    const int r = EPI_ROWS(ai, m), t = r & (SEQ - 1);
                    const float rs = __builtin_amdgcn_rsqf((float)(unsigned)(sv[ai][m] >> 12) * (4096.0f / (SSQ_SCALE * 384.0f)) + RMS_EPS) * QS96;
                    const f32x4* cs = (const f32x4*)((const f32x2*)(ws + WS_CS32) + (size_t)t * 16 + i0);
                    bf16_t* p = AQ + (size_t)r * 768 + head * 96 + 64 + i0;
                    rope8_store(acc[ai][0][m][0], acc[ai][0][m][1], acc[ai][1][m][0], acc[ai][1][m][1], cs, rs, p, p + 16);
                    asm volatile("" ::: "memory");
                }
        }
        return false;
    }
};
struct EpiUKV {
    static constexpr bool AFTER_DRAIN = false;
    unsigned char* ws; int layer; bool nov = false;
    __device__ __forceinline__ bool operator()(f32x4 (&acc)[2][2][4][2], const Unit& u, int wr, int wc, int fr, int fq) const {
        const int pn = u.pn, row0 = u.pm * 256 + wr * 64 + fr, c8 = 32 * wc + 8 * fq;
        const u64* ssq = (const u64*)(ws + WS_SSQ) + (size_t)layer * 2 * NT + NT;
        u64 sv[2][4];
#pragma unroll
        for (int ai = 0; ai < 2; ++ai)
#pragma unroll
            for (int m = 0; m < 4; ++m) sv[ai][m] = ssq[EPI_ROWS(ai, m)];
        __builtin_amdgcn_sched_barrier(0);
#pragma unroll
        for (int ai = 0; ai < 2; ++ai)
#pragma unroll
            for (int m = 0; m < 4; ++m) {
                const int r = EPI_ROWS(ai, m);
                const float rs = __builtin_amdgcn_rsqf((float)(unsigned)(sv[ai][m] >> 12) * (4096.0f / (SSQ_SCALE * 256.0f)) + RMS_EPS);
#pragma unroll
                for (int bj = 0; bj < 2; ++bj) { const int tc = 128 * bj + c8;
                    if (pn < 2) store8_bf16((bf16_t*)(ws + R_AKN) + (size_t)r * 512 + 256 * pn + tc, acc[ai][bj][m][0] * rs, acc[ai][bj][m][1] * rs);
                    else if (!nov) vt_store8((bf16_t*)(ws + R_AVT) + ((size_t)(((r >> 11) * 8 + 4 * (pn - 2) + (tc >> 6)) * 32 + ((r & 2047) >> 6)) * 64 + (tc & 63)) * 64 + (r & 63), acc[ai][bj][m][0] * rs, acc[ai][bj][m][1] * rs); }
            }
        return false;
    }
};
struct EpiBr {
    static constexpr bool AFTER_DRAIN = false;
    const bf16_t* G; bf16_t* MERGED; float osc = 1.0f; bool m8 = false;
    __device__ __forceinline__ bool operator()(f32x4 (&acc)[2][2][4][2], const Unit& u, int wr, int wc, int fr_in, int fq_in) const {
        (void)fr_in; (void)fq_in;
        int ln_; asm volatile("v_mbcnt_lo_u32_b32 %0, -1, 0\n\tv_mbcnt_hi_u32_b32 %0, -1, %0" : "=v"(ln_));
        const int fr = ln_ & 15, fq = ln_ >> 4;
        int upm_ = u.pm, upn_ = u.pn; asm volatile("" : "+s"(upm_), "+s"(upn_));
        const int sub = upm_ >> 6, pm = upm_ & 63, pn = upn_ & 3;
        const int row0 = pm * 256 + wr * 64 + fr, col0 = pn * 256 + 32 * wc + 8 * fq;
#pragma unroll
        for (int ai = 0; ai < 2; ++ai) {
            u32x4 gv[4][2], hv[4][2];
#pragma unroll
            for (int m = 0; m < 4; ++m) { const int r = EPI_ROWS(ai, m);
#pragma unroll
                for (int bj = 0; bj < 2; ++bj) { gv[m][bj] = *(const u32x4*)(G + (size_t)r * 3072 + 1024 * sub + col0 + 128 * bj);
                    if (sub < 2) hv[m][bj] = *(const u32x4*)(G + (size_t)r * 3072 + 1024 * (sub + 1) + col0 + 128 * bj); else hv[m][bj] = gv[m][bj]; } }
            __builtin_amdgcn_sched_barrier(0);
#pragma unroll
            for (int m = 0; m < 4; ++m) { const int r = EPI_ROWS(ai, m);
#pragma unroll
                for (int bj = 0; bj < 2; ++bj) {
                    const u32x4 g = gv[m][bj];
                    f32x4 ga = {bf_lo(g.x), bf_hi(g.x), bf_lo(g.y), bf_hi(g.y)}, gb = {bf_lo(g.z), bf_hi(g.z), bf_lo(g.w), bf_hi(g.w)};
                    if (sub < 2) {
                        const u32x4 h = hv[m][bj];
                        const f32x4 ha = {bf_lo(h.x), bf_hi(h.x), bf_lo(h.y), bf_hi(h.y)}, hb = {bf_lo(h.z), bf_hi(h.z), bf_lo(h.w), bf_hi(h.w)};
#pragma unroll
                        for (int e = 0; e < 4; ++e) { ga[e] = ga[e] * __builtin_amdgcn_rcpf(ha[e]); gb[e] = gb[e] * __builtin_amdgcn_rcpf(hb[e]); }
                        acc[ai][bj][m][0] = acc[ai][bj][m][0] * ga; acc[ai][bj][m][1] = acc[ai][bj][m][1] * gb;
                    } else {
                        if (m8) { const f32x4 ya = acc[ai][bj][m][0] * (ga * (osc * 16.0f)), yb = acc[ai][bj][m][1] * (gb * (osc * 16.0f)); u32x2 q8; q8.x = (unsigned)f8x4(ya[0], ya[1], ya[2], ya[3]); q8.y = (unsigned)f8x4(yb[0], yb[1], yb[2], yb[3]);
                            *(u32x2*)((unsigned char*)MERGED + (size_t)r * 1024 + col0 + 128 * bj) = q8; }
                        else store8_bf16(MERGED + (size_t)r * 1024 + col0 + 128 * bj, acc[ai][bj][m][0] * (ga * osc), acc[ai][bj][m][1] * (gb * osc));
                    }
                } }
            __builtin_amdgcn_sched_barrier(0);
        }
        return sub < 2;
    }
};
struct SchedGate {
    pg8::StaticOrder S;
    __device__ bool next(int i, Unit& u) const { const int q = (i * 43) >> 7, sub = i - 3 * q; if (!S.next(q, u)) return false; u.pn += 4 * sub; return true; }
    __device__ __forceinline__ void a_ready(const Unit&, int) const {}
    __device__ __forceinline__ void done(const Unit&, int) const {}
};
struct SchedBr {
    pg8::StaticOrder S;
    __device__ bool next(int i, Unit& u) const { const int q = i / 3, sub = i - 3 * q; if (!S.next(q, u)) return false; u.pm += 64 * sub; u.pn += 4 * sub; return true; }
    __device__ __forceinline__ void a_ready(const Unit&, int) const {}
    __device__ __forceinline__ void done(const Unit&, int) const {}
};
struct EpiOut {
    static constexpr bool AFTER_DRAIN = false;
    const float* X; float* Z;
    __device__ __forceinline__ bool operator()(f32x4 (&acc)[2][2][4][2], const Unit& u, int wr, int wc, int fr, int fq) const {
        const int row0 = u.pm * 256 + wr * 64 + fr, col0 = u.pn * 256 + 32 * wc + 8 * fq;
#pragma unroll
        for (int ai = 0; ai < 2; ++ai)
#pragma unroll
            for (int m = 0; m < 4; ++m) { const size_t o = (size_t)EPI_ROWS(ai, m) * 1024 + col0;
#pragma unroll
                for (int bj = 0; bj < 2; ++bj) {
                    const f32x4 x0 = *(const f32x4*)(X + o + 128 * bj), x1 = *(const f32x4*)(X + o + 128 * bj + 4);
                    *(f32x4*)(Z + o + 128 * bj) = x0 * ALPHA + acc[ai][bj][m][0]; *(f32x4*)(Z + o + 128 * bj + 4) = x1 * ALPHA + acc[ai][bj][m][1]; }
                asm volatile("" ::: "memory"); }
        return false;
    }
};
struct PanelStats {
    u64* xbuf; unsigned* cnt; float eps;
    __device__ __forceinline__ void run(const f32x4 (&v)[2][2][4][2], const Unit& u, int wr, int wc, int fr, int fq, LAS unsigned char* lds, int wid, int lane) const {
        LAS f32x2* Pt = (LAS f32x2*)lds;
        LAS f32x2* St = (LAS f32x2*)(lds + 8192);
#pragma unroll
        for (int ai = 0; ai < 2; ++ai)
#pragma unroll
            for (int m = 0; m < 4; ++m) {
                float s = 0.f;
#pragma unroll
                for (int bj = 0; bj < 2; ++bj)
#pragma unroll
                    for (int n = 0; n < 2; ++n) { const f32x4 x = v[ai][bj][m][n]; s += (x[0] + x[1]) + (x[2] + x[3]); }
                s += shx(s, 16, lane); s += shx(s, 32, lane);
                const float mw = s * (1.0f / 64.0f); float q = 0.f;
#pragma unroll
                for (int bj = 0; bj < 2; ++bj)
#pragma unroll
                    for (int n = 0; n < 2; ++n) { const f32x4 d = v[ai][bj][m][n] - mw; q += (d[0] * d[0] + d[1] * d[1]) + (d[2] * d[2] + d[3] * d[3]); }
                q += shx(q, 16, lane); q += shx(q, 32, lane);
                if (fq == 0) Pt[(ai * 128 + wr * 64 + m * 16 + fr) * 4 + wc] = (f32x2){mw, q};
            }
        asm volatile("s_waitcnt lgkmcnt(0)" ::: "memory"); __builtin_amdgcn_s_barrier(); asm volatile("" ::: "memory");
        const int row = wid * 32 + (lane & 31);
        if (lane < 32) {
            const f32x2 a = Pt[row * 4 + 0], b = Pt[row * 4 + 1], c = Pt[row * 4 + 2], d = Pt[row * 4 + 3];
            const float mt = (a.x + b.x + c.x + d.x) * 0.25f;
            const float da = a.x - mt, db = b.x - mt, dc = c.x - mt, dd = d.x - mt;
            const float m2 = (a.y + b.y) + (c.y + d.y) + 64.0f * ((da * da + db * db) + (dc * dc + dd * dd));
            __hip_atomic_store(xbuf + ((size_t)(u.pm * 256 + row) * 4 + u.pn), ((u64)__float_as_uint(m2) << 32) | __float_as_uint(mt), __ATOMIC_RELAXED, __HIP_MEMORY_SCOPE_AGENT);
        }
        asm volatile("s_waitcnt vmcnt(0)" ::: "memory");
        if (lane == 0) __hip_atomic_fetch_add(cnt + 64 * u.pm, 1u, __ATOMIC_RELAXED, __HIP_MEMORY_SCOPE_AGENT);
        if (wid == 0) {
            unsigned spins = 0u;
            while ((unsigned)__builtin_amdgcn_readfirstlane(__hip_atomic_load(cnt + 64 * u.pm, __ATOMIC_RELAXED, __HIP_MEMORY_SCOPE_AGENT)) < 32u) { __builtin_amdgcn_s_sleep(2); if (++spins > (1u << 22)) break; }
            __builtin_amdgcn_fence(__ATOMIC_ACQUIRE, "agent");
        }
        asm volatile("s_waitcnt vmcnt(0) lgkmcnt(0)" ::: "memory"); __builtin_amdgcn_s_barrier(); asm volatile("" ::: "memory");
        if (lane < 32) {
            const u64* slot = xbuf + (size_t)(u.pm * 256 + row) * 4; float mt[4], m2[4]; float ms = 0.f;
#pragma unroll
            for (int t = 0; t < 4; ++t) { const u64 w = __hip_atomic_load(slot + t, __ATOMIC_RELAXED, __HIP_MEMORY_SCOPE_AGENT); mt[t] = __uint_as_float((unsigned)w); m2[t] = __uint_as_float((unsigned)(w >> 32)); ms += mt[t]; }
            const float mean = ms * 0.25f; float q = 0.f;
#pragma unroll
            for (int t = 0; t < 4; ++t) { const float dm = mt[t] - mean; q += m2[t] + 256.0f * dm * dm; }
            St[row] = (f32x2){mean, 1.0f / sqrtf(q * (1.0f / 1024.0f) + eps)};
        }
        asm volatile("s_waitcnt lgkmcnt(0)" ::: "memory"); __builtin_amdgcn_s_barrier(); asm volatile("" ::: "memory");
    }
};
struct EpiOutLn {
    static constexpr bool AFTER_DRAIN = true;
    float* X; bf16_t* XB; const float* g; const float* b; PanelStats st; unsigned char* XB8 = nullptr; float asc = 1.0f;
    __device__ __forceinline__ bool operator()(f32x4 (&)[2][2][4][2], const Unit&, int, int, int, int) const { return false; }
    __device__ __forceinline__ void fused(f32x4 (&acc)[2][2][4][2], const Unit& u, int wr, int wc, int fr, int fq, LAS unsigned char* lds, int wid, int lane) const {
        const int row0 = u.pm * 256 + wr * 64 + fr, col0 = u.pn * 256 + 32 * wc + 8 * fq;
#pragma unroll
        for (int ai = 0; ai < 2; ++ai)
#pragma unroll
            for (int m = 0; m < 4; ++m) { const size_t o = (size_t)EPI_ROWS(ai, m) * 1024 + col0;
#pragma unroll
                for (int bj = 0; bj < 2; ++bj) { const u32x4 xw = *(const u32x4*)(XB + o + 128 * bj);
                    const f32x4 xa = {bf_lo(xw.x), bf_hi(xw.x), bf_lo(xw.y), bf_hi(xw.y)}, xb2 = {bf_lo(xw.z), bf_hi(xw.z), bf_lo(xw.w), bf_hi(xw.w)};
                    acc[ai][bj][m][0] = xa * ALPHA + acc[ai][bj][m][0] * asc; acc[ai][bj][m][1] = xb2 * ALPHA + acc[ai][bj][m][1] * asc; }
                asm volatile("" : "+v"(acc[ai][0][m][0]), "+v"(acc[ai][0][m][1]), "+v"(acc[ai][1][m][0]), "+v"(acc[ai][1][m][1]));
                if (m & 1) asm volatile("" ::: "memory"); }
        st.run(acc, u, wr, wc, fr, fq, lds, wid, lane);
        const LAS f32x2* St = (const LAS f32x2*)(lds + 8192);
        f32x4 gg[2][2], bb[2][2];
#pragma unroll
        for (int bj = 0; bj < 2; ++bj)
#pragma unroll
            for (int n = 0; n < 2; ++n) { gg[bj][n] = *(const f32x4*)(g + col0 + 128 * bj + 4 * n); bb[bj][n] = *(const f32x4*)(b + col0 + 128 * bj + 4 * n); }
#pragma unroll
        for (int ai = 0; ai < 2; ++ai)
#pragma unroll
            for (int m = 0; m < 4; ++m) { const int rl = ai * 128 + wr * 64 + m * 16 + fr; const f32x2 sr = St[rl]; const size_t o = (size_t)(u.pm * 256 + rl) * 1024 + col0;
#pragma unroll
                for (int bj = 0; bj < 2; ++bj) { const f32x4 y0 = (acc[ai][bj][m][0] - sr.x) * sr.y * gg[bj][0] + bb[bj][0], y1 = (acc[ai][bj][m][1] - sr.x) * sr.y * gg[bj][1] + bb[bj][1];
                    *(f32x4*)(X + o + 128 * bj) = y0; *(f32x4*)(X + o + 128 * bj + 4) = y1; store8_bf16(XB + o + 128 * bj, y0, y1);
                    if (XB8) { u32x2 q8; q8.x = (unsigned)f8x4(y0[0], y0[1], y0[2], y0[3]); q8.y = (unsigned)f8x4(y1[0], y1[1], y1[2], y1[3]); *(u32x2*)(XB8 + o + 128 * bj) = q8; } }
                asm volatile("" ::: "memory"); }
    }
};
struct SchedMoE {
    int ts[16]; int ntiles, G, c; unsigned* hrdy;
    __device__ bool next(int i, Unit& u) const {
        const int L = i * G + c; if (L >= 4 * ntiles) return false;
        const int tile = L >> 2, j = L & 3; int e = 0;
#pragma unroll
        for (int k = 1; k < 16; ++k) e += (tile >= ts[k]) ? 1 : 0;
        u.pm = tile; u.pn = 4 * e + j; return true;
    }
    __device__ __forceinline__ void a_ready(const Unit&, int) const {}
    __device__ __forceinline__ void done(const Unit& u, int tid) const {
        asm volatile("s_waitcnt vmcnt(0)" ::: "memory"); __builtin_amdgcn_s_barrier(); asm volatile("" ::: "memory");
        if (tid == 0) __hip_atomic_fetch_add(hrdy + 64 * u.pm, 1u, __ATOMIC_RELAXED, __HIP_MEMORY_SCOPE_AGENT);
    }
};
struct SchedMoEDown {
    int ts[16]; int ntiles, G, c, nheavy; unsigned* hrdy;
    __device__ bool next(int i, Unit& u) const {
        const int cc = c - nheavy; if (cc < 0) return false;
        const int L = i * (G - nheavy) + cc; if (L >= 4 * ntiles) return false;
        const int tile = L >> 2, j = L & 3; int e = 0;
#pragma unroll
        for (int k = 1; k < 16; ++k) e += (tile >= ts[k]) ? 1 : 0;
        u.pm = tile; u.pn = 4 * e + j; return true;
    }
    __device__ __forceinline__ void a_ready(const Unit& u, int tid) const {
        if (tid < 64) {
            unsigned spins = 0u;
            while ((unsigned)__builtin_amdgcn_readfirstlane(__hip_atomic_load(hrdy + 64 * u.pm, __ATOMIC_RELAXED, __HIP_MEMORY_SCOPE_AGENT)) < 4u) { __builtin_amdgcn_s_sleep(2); if (++spins > (1u << 22)) break; }
            __builtin_amdgcn_fence(__ATOMIC_ACQUIRE, "agent");
            asm volatile("s_waitcnt vmcnt(0)" ::: "memory");
        }
        asm volatile("" ::: "memory"); __builtin_amdgcn_s_barrier(); asm volatile("" ::: "memory");
    }
    __device__ __forceinline__ void done(const Unit&, int) const {}
};
__device__ __forceinline__ void store16_wt(void* p, const u32x4& v) {
    asm volatile("global_store_dwordx4 %0, %1, off sc1\n\ts_nop 1" :: "v"(p), "v"(v) : "memory");
}
struct EpiGU {
    static constexpr bool AFTER_DRAIN = false;
    const float* ROWW; bf16_t* H; float isc = 1.0f; bool f8 = false;
    __device__ __forceinline__ bool operator()(f32x4 (&acc)[2][2][4][2], const Unit& u, int wr, int wc, int fr_in, int fq_in) const {
        (void)fr_in; (void)fq_in;
        int ln_; asm volatile("v_mbcnt_lo_u32_b32 %0, -1, 0\n\tv_mbcnt_hi_u32_b32 %0, -1, %0" : "=v"(ln_));
        const int fr = ln_ & 15, fq = ln_ >> 4;
        const int row0 = u.pm * 256 + wr * 64 + fr, col0 = (u.pn & 3) * 128 + 32 * wc + 8 * fq;
        float wv[2][4];
#pragma unroll
        for (int ai = 0; ai < 2; ++ai)
#pragma unroll
            for (int m = 0; m < 4; ++m) wv[ai][m] = ROWW[EPI_ROWS(ai, m)];
        __builtin_amdgcn_sched_barrier(0);
#pragma unroll
        for (int ai = 0; ai < 2; ++ai)
#pragma unroll
            for (int m = 0; m < 4; ++m) { const int r = EPI_ROWS(ai, m); const float w = wv[ai][m];
                f32x4 a = acc[ai][0][m][0], b = acc[ai][0][m][1]; const f32x4 ua = acc[ai][1][m][0], ub = acc[ai][1][m][1];
#pragma unroll
                for (int e = 0; e < 4; ++e) { const float ga_ = a[e] * isc, gb_ = b[e] * isc; a[e] = ga_ * fast_sigmoid(ga_) * (ua[e] * isc) * w; b[e] = gb_ * fast_sigmoid(gb_) * (ub[e] * isc) * w; }
                if (f8) { u32x2 q8; q8.x = (unsigned)f8x4(a[0] * 8.0f, a[1] * 8.0f, a[2] * 8.0f, a[3] * 8.0f); q8.y = (unsigned)f8x4(b[0] * 8.0f, b[1] * 8.0f, b[2] * 8.0f, b[3] * 8.0f); asm volatile("global_store_dwordx2 %0, %1, off sc1\n\ts_nop 1" :: "v"((unsigned char*)H + (size_t)r * 512 + col0), "v"(q8) : "memory"); }
                else { u32x4 pk_; pk_.x = pk2(a[0], a[1]); pk_.y = pk2(a[2], a[3]); pk_.z = pk2(b[0], b[1]); pk_.w = pk2(b[2], b[3]); store16_wt(H + (size_t)r * 512 + col0, pk_); } }
        return false;
    }
};
struct EpiDN {
    static constexpr bool AFTER_DRAIN = false;
    const int* ROWTOK; bf16_t* Y2; float osc = 1.0f;
    __device__ __forceinline__ bool operator()(f32x4 (&acc)[2][2][4][2], const Unit& u, int wr, int wc, int fr_in, int fq_in) const {
        (void)fr_in; (void)fq_in;
        int ln_; asm volatile("v_mbcnt_lo_u32_b32 %0, -1, 0\n\tv_mbcnt_hi_u32_b32 %0, -1, %0" : "=v"(ln_));
        const int fr = ln_ & 15, fq = ln_ >> 4;
        const int row0 = u.pm * 256 + wr * 64 + fr, col0 = (u.pn & 3) * 256 + 32 * wc + 8 * fq;
        int tkv[2][4];
#pragma unroll
        for (int ai = 0; ai < 2; ++ai)
#pragma unroll
            for (int m = 0; m < 4; ++m) tkv[ai][m] = ROWTOK[EPI_ROWS(ai, m)];
        __builtin_amdgcn_sched_barrier(0);
#pragma unroll
        for (int ai = 0; ai < 2; ++ai)
#pragma unroll
            for (int m = 0; m < 4; ++m) { const int tk = tkv[ai][m];
                if (tk >= 0) {
#pragma unroll
                    for (int bj = 0; bj < 2; ++bj) store8_bf16(Y2 + (size_t)tk * 1024 + col0 + 128 * bj, acc[ai][bj][m][0] * osc, acc[ai][bj][m][1] * osc); } }
        return false;
    }
};
#ifndef IDX_HEAD_FENCE
#define IDX_HEAD_FENCE 1
#endif
#define MFMA32(a, b, c) __builtin_amdgcn_mfma_f32_32x32x16_bf16((a), (b), (c), 0, 0, 0)
__device__ __forceinline__ constexpr int crow(int t, int h) { return (t & 3) + 8 * (t >> 2) + 4 * h; }
__device__ __forceinline__ bf16x8 pack8(const f32x16& x, int s) {
    u32x4 p; p.x = pk2(x[8 * s + 0], x[8 * s + 1]); p.y = pk2(x[8 * s + 2], x[8 * s + 3]); p.z = pk2(x[8 * s + 4], x[8 * s + 5]); p.w = pk2(x[8 * s + 6], x[8 * s + 7]);
    return __builtin_bit_cast(bf16x8, p);
}
template <int NKS, int MODE>
__device__ __forceinline__ void attn_item(const bf16_t* qrow, const bf16_t* k1, int ldk1, const bf16_t* k2, int ldk2, const bf16_t* vt,
                                          int kbeg, int kend, const unsigned* maskrow, float sink_l2, bf16_t* orow, int lane) {
    const int r = lane & 31, h = lane >> 5;
    bf16x8 qf[NKS];
#pragma unroll
    for (int ks = 0; ks < NKS; ++ks) qf[ks] = *(const bf16x8*)(qrow + 16 * ks + 8 * h);
    f32x16 o0, o1;
#pragma unroll
    for (int t = 0; t < 16; ++t) { o0[t] = 0.f; o1[t] = 0.f; }
    float m = -1e30f, l = 0.f;
    for (int kt = kbeg; kt < kend; kt += 64) {
        f32x16 s0, s1;
#pragma unroll
        for (int t = 0; t < 16; ++t) { s0[t] = 0.f; s1[t] = 0.f; }
#pragma unroll
        for (int ks = 0; ks < NKS; ++ks) {
            const bf16_t* kp = (ks < 4) ? (k1 + (size_t)(kt + r) * ldk1 + 16 * ks + 8 * h) : (k2 + (size_t)(kt + r) * ldk2 + 16 * (ks - 4) + 8 * h);
            const int ld = (ks < 4) ? ldk1 : ldk2;
            const bf16x8 a0 = *(const bf16x8*)kp, a1 = *(const bf16x8*)(kp + 32 * ld);
            s0 = MFMA32(a0, qf[ks], s0); s1 = MFMA32(a1, qf[ks], s1);
        }
        if (MODE == 1) {
            const unsigned w0 = maskrow[kt >> 5], w1 = maskrow[(kt >> 5) + 1];
#pragma unroll
            for (int t = 0; t < 16; ++t) { if (!((w0 >> crow(t, h)) & 1u)) s0[t] = -INFINITY; if (!((w1 >> crow(t, h)) & 1u)) s1[t] = -INFINITY; }
        }
        float mx = fmaxf(s0[0], s1[0]);
#pragma unroll
        for (int t = 1; t < 16; ++t) mx = fmaxf(mx, fmaxf(s0[t], s1[t]));
        mx = fmaxf(mx, shx(mx, 32, lane));
        const float mn = fmaxf(m, mx), alpha = __builtin_amdgcn_exp2f(m - mn); m = mn;
        float ps = 0.f;
#pragma unroll
        for (int t = 0; t < 16; ++t) { s0[t] = __builtin_amdgcn_exp2f(s0[t] - mn); s1[t] = __builtin_amdgcn_exp2f(s1[t] - mn); ps += s0[t] + s1[t]; }
        l = l * alpha + ps;
#pragma unroll
        for (int t = 0; t < 16; ++t) { o0[t] *= alpha; o1[t] *= alpha; }
        bf16x8 pb[4]; pb[0] = pack8(s0, 0); pb[1] = pack8(s0, 1); pb[2] = pack8(s1, 0); pb[3] = pack8(s1, 1);
#pragma unroll
        for (int s4 = 0; s4 < 4; ++s4) {
            const bf16_t* vp = vt + (size_t)r * SEQ + kt + 16 * s4 + 4 * h;
            const s16x4 lo0 = *(const s16x4*)vp, hi0 = *(const s16x4*)(vp + 8);
            const s16x4 lo1 = *(const s16x4*)(vp + 32 * SEQ), hi1 = *(const s16x4*)(vp + 32 * SEQ + 8);
            o0 = MFMA32(__builtin_shufflevector(lo0, hi0, 0, 1, 2, 3, 4, 5, 6, 7), pb[s4], o0);
            o1 = MFMA32(__builtin_shufflevector(lo1, hi1, 0, 1, 2, 3, 4, 5, 6, 7), pb[s4], o1);
        }
    }
    float lt = l + shx(l, 32, lane);
    if (MODE == 2) lt += __builtin_amdgcn_exp2f(sink_l2 - m);
    const float inv = 1.0f / lt;
#pragma unroll
    for (int g = 0; g < 4; ++g) {
        u32x2 w0, w1;
        w0.x = pk2(o0[4 * g] * inv, o0[4 * g + 1] * inv); w0.y = pk2(o0[4 * g + 2] * inv, o0[4 * g + 3] * inv);
        w1.x = pk2(o1[4 * g] * inv, o1[4 * g + 1] * inv); w1.y = pk2(o1[4 * g + 2] * inv, o1[4 * g + 3] * inv);
        *(u32x2*)(orow + 8 * g + 4 * h) = w0; *(u32x2*)(orow + 32 + 8 * g + 4 * h) = w1;
    }
}

__device__ __forceinline__ void attention_phase(unsigned char* ws, const float* sinks  , int G, int bid, int wave, int lane) {
    const int r = lane & 31;
    const bf16_t* AQ = (const bf16_t*)(ws + R_AQ); const bf16_t* AKN = (const bf16_t*)(ws + R_AKN); const bf16_t* KPE = (const bf16_t*)(ws + R_KPE); const bf16_t* AVT = (const bf16_t*)(ws + R_AVT);
    const bf16_t* BQ = (const bf16_t*)(ws + R_BQ); const bf16_t* BK = (const bf16_t*)(ws + R_BK); const bf16_t* BVT = (const bf16_t*)(ws + R_BVT); const unsigned* MASK = (const unsigned*)(ws + R_MASK);
    const bf16_t* CQ = (const bf16_t*)(ws + R_CQ); const bf16_t* CK = (const bf16_t*)(ws + R_CK); const bf16_t* CVT = (const bf16_t*)(ws + R_CVT);
    bf16_t* OA = (bf16_t*)(ws + WS_OABC); bf16_t* OB = OA + (size_t)NT * 512; bf16_t* OC = OB + (size_t)NT * 512;
    for (int j = bid; j < 256; j += G) {
        const int bh = j >> 2, b = bh >> 3, head = bh & 7, g = head >> 2, p = 8 * (j & 3) + wave;
        const size_t tb = (size_t)b * SEQ;
        for (int z = 0; z < 2; ++z) {
            const int qt = z ? 63 - p : p, c = qt >> 1, q0 = 32 * qt; const size_t qr = tb + q0 + r;
            attn_item<6, 0>(AQ + qr * 768 + head * 96, AKN + tb * 512 + head * 64, 512, KPE + tb * 32, 32, AVT + (size_t)(b * 8 + head) * 64 * SEQ,
                            0, 64 * (c + 1), nullptr, 0.f, OA + qr * 512 + head * 64, lane);
        }
        for (int z = 0; z < 2; ++z) {
            const int qt = z ? 63 - p : p, c = qt >> 1, q0 = 32 * qt; const size_t qr = tb + q0 + r;
            attn_item<4, 1>(BQ + qr * 512 + head * 64, BK + tb * 128 + g * 64, 128, nullptr, 0, BVT + (size_t)(b * 2 + g) * 64 * SEQ,
                            0, 64 * (c + 1), MASK + qr * 64, 0.f, OB + qr * 512 + head * 64, lane);
        }
        const float sink = sinks[head] * LOG2E;
        for (int z = 0; z < 2; ++z) {
            const int qt = z ? 63 - p : p, c = qt >> 1, q0 = 32 * qt; const size_t qr = tb + q0 + r;
            attn_item<4, 2>(CQ + qr * 512 + head * 64, CK + tb * 128 + g * 64, 128, nullptr, 0, CVT + (size_t)(b * 2 + g) * 64 * SEQ,
                            (c >= 2) ? 64 * (c - 2) : 0, 64 * (c + 1), nullptr, sink, OC + qr * 512 + head * 64, lane);
        }
    }
}

__device__ __forceinline__ void vt_item(const bf16_t* src  , int ld, bf16_t* dst  , LAS unsigned short* tile  , int lane) {
    const u32x4* sp = (const u32x4*)(src + (size_t)lane * ld);
#pragma unroll
    for (int c = 0; c < 8; ++c) { const u32x4 v = sp[c];
        tile[(8 * c + 0) * 72 + lane] = (unsigned short)v.x; tile[(8 * c + 1) * 72 + lane] = (unsigned short)(v.x >> 16);
        tile[(8 * c + 2) * 72 + lane] = (unsigned short)v.y; tile[(8 * c + 3) * 72 + lane] = (unsigned short)(v.y >> 16);
        tile[(8 * c + 4) * 72 + lane] = (unsigned short)v.z; tile[(8 * c + 5) * 72 + lane] = (unsigned short)(v.z >> 16);
        tile[(8 * c + 6) * 72 + lane] = (unsigned short)v.w; tile[(8 * c + 7) * 72 + lane] = (unsigned short)(v.w >> 16); }
    asm volatile("s_waitcnt lgkmcnt(0)" ::: "memory");
    u32x4* dp = (u32x4*)(dst + (size_t)lane * 64);
#pragma unroll
    for (int c = 0; c < 8; ++c) dp[c] = *(const LAS u32x4*)(tile + lane * 72 + 8 * c);
    asm volatile("s_waitcnt lgkmcnt(0)" ::: "memory");
}
__device__ __forceinline__ void vtranspose_phase(unsigned char* ws, LAS unsigned char* lds, int gw, int NGW, int wave, int lane) {
    LAS unsigned short* tile = (LAS unsigned short*)(lds + 4096 + wave * 9216);
    for (int it = gw; it < 3072; it += NGW) {
        if (it < 2048) { const int tt = it & 31, head = (it >> 5) & 7, b = it >> 8;
            vt_item((const bf16_t*)(ws + R_AV) + ((size_t)b * SEQ + 64 * tt) * 512 + 64 * head, 512, (bf16_t*)(ws + R_AVT) + (size_t)(b * 8 + head) * 64 * SEQ + 4096 * tt, tile, lane); }
        else { const int q = it - 2048, which = q >> 9, qq = q & 511, tt = qq & 31, g = (qq >> 5) & 1, b = qq >> 6;
            vt_item((const bf16_t*)(ws + (which ? R_CV : R_BV)) + ((size_t)b * SEQ + 64 * tt) * 128 + 64 * g, 128, (bf16_t*)(ws + (which ? R_CVT : R_BVT)) + (size_t)(b * 2 + g) * 64 * SEQ + 4096 * tt, tile, lane); }
    }
}

__device__ __forceinline__ unsigned sortable(float x) { const unsigned u = __float_as_uint(x + 0.0f); return (u & 0x80000000u) ? ~u : (u | 0x80000000u); }
__device__ __forceinline__ void indexer_phase(unsigned char* ws, LAS unsigned char* lds, int G, int bid, int w, int lane_in, int tid_in) {
    LAS unsigned* cntbuf = (LAS unsigned*)lds;
    LAS unsigned* runb = cntbuf + 512;
    const bf16_t* BQI = (const bf16_t*)(ws + R_BQI); const bf16_t* BKI = (const bf16_t*)(ws + R_BKI); const float* WIDX = (const float*)(ws + R_WIDX);
    unsigned* MASK = (unsigned*)(ws + R_MASK);
    for (int item = bid; item < 256; item += G) {
#pragma unroll 1
        for (int z = 0; z < 2; ++z) {
            int lane = lane_in; asm volatile("" : "+v"(lane));
            const int r = lane & 31, h = lane >> 5, tid = w * 64 + lane;
            const int b = item >> 5, qt = z ? 63 - (item & 31) : (item & 31), c = qt >> 1, q0 = 32 * qt, nsub = 2 * (c + 1);
            const size_t qr = (size_t)b * SEQ + q0 + r;
            unsigned* maskrow = MASK + qr * 64;
            if (c <= 3) {
                for (int st = w; st < nsub; st += 8) if (h == 0) maskrow[st] = 0xFFFFFFFFu;
                continue;
            }
            LAS unsigned char* QL = lds + 40960;
            const char* kbase = (const char*)(BKI + (size_t)b * SEQ * 64);
            const unsigned klane = ((unsigned)(32 * w + r) * 64u + 8u * h) * 2u;
            bf16x8 afn[4];
            f32x4 wq;
            { const int qq = tid >> 4, pc = tid & 15; const u32x4* src = (const u32x4*)(BQI + ((size_t)b * SEQ + q0 + qq) * 256 + 16 * pc);
              const u32x4 v0 = src[0], v1 = src[1];
              wq = *(const f32x4*)(WIDX + qr * 4);
              if (w < nsub) {
#pragma unroll
                  for (int ks = 0; ks < 4; ++ks) afn[ks] = *(const bf16x8*)(kbase + klane + 32 * ks);
              }
              *(LAS u32x4*)(QL + pc * 1024 + qq * 32) = v0; *(LAS u32x4*)(QL + pc * 1024 + qq * 32 + 16) = v1; }
            __syncthreads();
            unsigned key[8][16];
            const LAS unsigned char* qlr = QL + r * 32 + h * 16;
#pragma unroll
            for (int jj = 0; jj < 8; ++jj) {
                const int st = w + 8 * jj;
                if (st < nsub) {
                    bf16x8 af[4];
#pragma unroll
                    for (int ks = 0; ks < 4; ++ks) af[ks] = afn[ks];
                    if (jj < 7 && st + 8 < nsub) { const char* kp = kbase + (klane + (unsigned)(jj + 1) * 32768u);
#pragma unroll
                        for (int ks = 0; ks < 4; ++ks) afn[ks] = *(const bf16x8*)(kp + 32 * ks); }
                    f32x16 sc;
#pragma unroll
                    for (int t = 0; t < 16; ++t) sc[t] = 0.f;
#pragma unroll
                    for (int hh = 0; hh < 4; ++hh) {
                        f32x16 acc;
#pragma unroll
                        for (int t = 0; t < 16; ++t) acc[t] = 0.f;
#pragma unroll
                        for (int ks = 0; ks < 4; ++ks) acc = MFMA32(af[ks], *(const LAS bf16x8*)(qlr + (4 * hh + ks) * 1024), acc);
                        const float wh = wq[hh];
#pragma unroll
                        for (int t = 0; t < 16; ++t) sc[t] += wh * fmaxf(acc[t], 0.f);
                        if (IDX_HEAD_FENCE) asm volatile("" ::: "memory");
                    }
#pragma unroll
                    for (int t = 0; t < 16; ++t) key[jj][t] = sortable(sc[t]);
                } else {
#pragma unroll
                    for (int t = 0; t < 16; ++t) key[jj][t] = 0u;
                }
                asm volatile("" ::: "memory");
            }
            unsigned T = 0u, ge = 0u, gt = 0u;
            int par = 0;
            const int njj = (nsub - w + 7) >> 3;
#ifndef IDX_PACKED16
#define IDX_PACKED16 0
#endif
#ifndef IDX_EXTRA_SYNC
#define IDX_EXTRA_SYNC
#endif
#define IDX_COUNT_GE(CAND, TOT) do { unsigned cnt_ = 0u; \
                _Pragma("unroll") for (int jj = 0; jj < 8; ++jj) { if (jj < njj) { _Pragma("unroll") for (int t = 0; t < 16; ++t) cnt_ += (key[jj][t] >= (CAND)) ? 1u : 0u; } } \
                cnt_ += shxu(cnt_, 32, lane); LAS unsigned* buf_ = cntbuf + par * 256; par ^= 1; if (h == 0) buf_[w * 32 + r] = cnt_; __syncthreads(); \
                TOT = 0u; _Pragma("unroll") for (int ww = 0; ww < 8; ++ww) TOT += buf_[ww * 32 + r]; IDX_EXTRA_SYNC; } while (0)
            unsigned G = 0u;
#if IDX_PACKED16
            typedef short s16x2_t __attribute__((ext_vector_type(2))); typedef unsigned short u16x2_t __attribute__((ext_vector_type(2)));
            unsigned pk16[8][8];
#pragma unroll
            for (int jj = 0; jj < 8; ++jj)
#pragma unroll
                for (int p = 0; p < 8; ++p) pk16[jj][p] = (key[jj][2 * p] >> 17) | ((key[jj][2 * p + 1] >> 1) & 0x7FFF0000u);
#pragma unroll 1
            for (int bit = 31; bit >= 20; --bit) {
                const unsigned cand = T | (1u << bit); unsigned tot;
                const unsigned b1_ = cand >> 17, b2_ = b1_ | (b1_ << 16);
                u16x2_t lt_ = {0, 0};
#pragma unroll
                for (int jj = 0; jj < 8; ++jj) { if (jj < njj) {
#pragma unroll
                    for (int p = 0; p < 8; ++p) { const s16x2_t d_ = __builtin_bit_cast(s16x2_t, pk16[jj][p]) - __builtin_bit_cast(s16x2_t, b2_); lt_ += __builtin_bit_cast(u16x2_t, d_) >> (unsigned short)15; } } }
                const unsigned ltw_ = __builtin_bit_cast(unsigned, lt_);
                unsigned cnt_ = (unsigned)(16 * (njj > 0 ? njj : 0)) - ((ltw_ & 0xFFFFu) + (ltw_ >> 16));
                cnt_ += shxu(cnt_, 32, lane); LAS unsigned* buf_ = cntbuf + par * 256; par ^= 1; if (h == 0) buf_[w * 32 + r] = cnt_; __syncthreads();
                tot = 0u;
#pragma unroll
                for (int ww = 0; ww < 8; ++ww) tot += buf_[ww * 32 + r];
                if (tot >= 256u) { T = cand; ge = tot; } else G = tot;
            }
#else
#pragma unroll 1
            for (int bit = 31; bit >= 20; --bit) {
                const unsigned cand = T | (1u << bit); unsigned tot;
                IDX_COUNT_GE(cand, tot);
                if (tot >= 256u) { T = cand; ge = tot; } else G = tot;
            }
#endif
            const unsigned ncand = ge - G;
            const bool overflow = __builtin_amdgcn_ballot_w64(ncand > 256u) != 0ull;
            if (overflow) {
#pragma unroll 1
                for (int bit = 19; bit >= 0; --bit) {
                    const unsigned cand = T | (1u << bit); unsigned tot;
                    IDX_COUNT_GE(cand, tot);
                    if (tot >= 256u) { T = cand; ge = tot; }
                }
                unsigned tot; IDX_COUNT_GE(T + 1u, tot); gt = (T == 0xFFFFFFFFu) ? 0u : tot;
                __syncthreads();
            } else {
                LAS unsigned* clist = cntbuf + 1024;
                LAS unsigned* ccnt = clist + 8192;
                LAS unsigned* cres = ccnt + 32;
                __syncthreads();
                if (tid < 32) ccnt[tid] = 0u;
                if (w == 0 && h == 0) { cres[r * 4 + 0] = T; cres[r * 4 + 1] = G; }
                __syncthreads();
                {
#pragma unroll
                  for (int jj = 0; jj < 8; ++jj) { if (jj >= njj) continue;
                    unsigned pre = T >> 20; asm volatile("" : "+v"(pre));
#pragma unroll
                    for (int t = 0; t < 16; ++t) { const unsigned kv = key[jj][t];
                        if ((kv >> 20) == pre && kv != 0u) { const unsigned pos = __hip_atomic_fetch_add(ccnt + r, 1u, __ATOMIC_RELAXED, __HIP_MEMORY_SCOPE_WORKGROUP); clist[r * 256 + (pos & 255u)] = kv; } } } }
                __syncthreads();
                {
                    const int q = tid >> 4, s16 = tid & 15; const unsigned nq = ccnt[q]; unsigned Tq = cres[q * 4 + 0]; const unsigned Gq = cres[q * 4 + 1];
                    unsigned c[16];
#pragma unroll
                    for (int i = 0; i < 16; ++i) c[i] = ((unsigned)(16 * i + s16) < nq) ? clist[q * 256 + 16 * i + s16] : 0u;
#define IDX_ROW16_SUM(X) do { X += (unsigned)__builtin_amdgcn_update_dpp(0, (int)X, 0x128, 0xf, 0xf, false); X += (unsigned)__builtin_amdgcn_update_dpp(0, (int)X, 0x124, 0xf, 0xf, false); \
                        X += (unsigned)__builtin_amdgcn_update_dpp(0, (int)X, 0x122, 0xf, 0xf, false); X += (unsigned)__builtin_amdgcn_update_dpp(0, (int)X, 0x121, 0xf, 0xf, false); } while (0)
                    const unsigned nmax = max(max((unsigned)__builtin_amdgcn_readlane((int)nq, 0), (unsigned)__builtin_amdgcn_readlane((int)nq, 16)), max((unsigned)__builtin_amdgcn_readlane((int)nq, 32), (unsigned)__builtin_amdgcn_readlane((int)nq, 48)));
#define IDX_S2_ROUNDS(NI) do { _Pragma("unroll 1") for (int bit = 19; bit >= 0; --bit) { \
                        const unsigned cand = Tq | (1u << bit); unsigned cnt = 0u; \
                        _Pragma("unroll") for (int i = 0; i < (NI); ++i) cnt += (c[i] >= cand) ? 1u : 0u; \
                        IDX_ROW16_SUM(cnt); \
                        if (Gq + cnt >= 256u) Tq = cand; } } while (0)
                    if (nmax <= 64u) IDX_S2_ROUNDS(4); else if (nmax <= 128u) IDX_S2_ROUNDS(8); else IDX_S2_ROUNDS(16);
#undef IDX_S2_ROUNDS
                    unsigned cge = 0u, cgt = 0u;
#pragma unroll
                    for (int i = 0; i < 16; ++i) { cge += (c[i] >= Tq) ? 1u : 0u; cgt += (c[i] > Tq) ? 1u : 0u; }
                    IDX_ROW16_SUM(cge); IDX_ROW16_SUM(cgt);
                    if (s16 == 0) { cres[q * 4 + 0] = Tq; cres[q * 4 + 1] = Gq + cgt; cres[q * 4 + 2] = Gq + cge; }
                }
                __syncthreads();
                T = cres[r * 4 + 0]; gt = cres[r * 4 + 1]; ge = cres[r * 4 + 2];
                __syncthreads();
            }
            if (tid < 32) runb[tid] = 0u;
            __syncthreads();
#undef IDX_COUNT_GE
            const unsigned need = 256u - gt;
            asm volatile("" : "+v"(T));
            const bool anytie = __any(ge > 256u) != 0;
            unsigned idxT = 0xFFFFu; bool slow_ties = false;
            if (anytie) {
                LAS unsigned* clist = cntbuf + 1024; LAS unsigned* ccnt = clist + 8192; LAS unsigned* cres = ccnt + 32;
                __syncthreads();
                if (tid < 32) ccnt[tid] = 0u;
                if (w == 0 && h == 0) { cres[r * 4 + 1] = need; cres[r * 4 + 2] = ge; }
                __syncthreads();
#pragma unroll
                for (int jj = 0; jj < 8; ++jj) { if (jj >= njj) continue;
                    unsigned Tj = T; asm volatile("" : "+v"(Tj));
#pragma unroll
                    for (int t = 0; t < 16; ++t) { const unsigned kv = key[jj][t];
                        if (kv == Tj && kv != 0u) { const unsigned pos = __hip_atomic_fetch_add(ccnt + r, 1u, __ATOMIC_RELAXED, __HIP_MEMORY_SCOPE_WORKGROUP); if (pos < 256u) clist[r * 256 + pos] = (unsigned)(32 * (w + 8 * jj) + crow(t, h)); } } }
                __syncthreads();
                slow_ties = __builtin_amdgcn_ballot_w64(ge > 256u && ccnt[r] > 256u) != 0ull;
                if (!slow_ties) {
                    const int q = tid >> 4, s16 = tid & 15; const unsigned nq = ccnt[q], needq = cres[q * 4 + 1], geq = cres[q * 4 + 2];
                    unsigned c[16];
#pragma unroll
                    for (int i = 0; i < 16; ++i) c[i] = ((unsigned)(16 * i + s16) < nq) ? clist[q * 256 + 16 * i + s16] : 0xFFFFFFFFu;
                    unsigned cur = 0u;
#pragma unroll 1
                    for (int bit = 10; bit >= 0; --bit) {
                        const unsigned cand = cur | (1u << bit); unsigned cnt = 0u;
#pragma unroll
                        for (int i = 0; i < 16; ++i) cnt += (c[i] < cand) ? 1u : 0u;
                        IDX_ROW16_SUM(cnt);
                        if (cnt < needq) cur = cand;
                    }
                    if (s16 == 0) cres[q * 4 + 3] = (geq > 256u) ? cur : 0xFFFFu;
                    __syncthreads();
                    idxT = cres[r * 4 + 3];
                }
            }
#undef IDX_ROW16_SUM
            if (!slow_ties) {
#pragma unroll
                for (int jj = 0; jj < 8; ++jj) {
                    const int st = w + 8 * jj;
                    if (st < nsub) {
                        unsigned word = 0u;
#pragma unroll
                        for (int t = 0; t < 16; ++t) { const unsigned kv = key[jj][t]; const bool sel = (kv > T) || (kv == T && (unsigned)(32 * st + crow(t, h)) <= idxT);
                            word |= sel ? (1u << crow(t, h)) : 0u; }
                        word |= shxu(word, 32, lane);
                        if (h == 0) maskrow[st] = word;
                    }
                }
            } else {
#pragma unroll
                for (int jj = 0; jj < 8; ++jj) {
#pragma unroll 1
                    for (int ww = 0; ww < 8; ++ww) {
                        const int st = ww + 8 * jj;
                        if (st < nsub) {
                            if (w == ww) {
                                unsigned cg[4], pg[4];
#pragma unroll
                                for (int g4 = 0; g4 < 4; ++g4) { cg[g4] = 0u;
#pragma unroll
                                    for (int e = 0; e < 4; ++e) cg[g4] += (key[jj][4 * g4 + e] == T) ? 1u : 0u;
                                    pg[g4] = shxu(cg[g4], 32, lane); }
                                unsigned before = runb[r], word = 0u;
#pragma unroll
                                for (int g4 = 0; g4 < 4; ++g4) {
                                    unsigned rank = before + (h ? pg[g4] : 0u);
#pragma unroll
                                    for (int e = 0; e < 4; ++e) { const unsigned kv = key[jj][4 * g4 + e]; const bool eq = (kv == T);
                                        const bool sel = (kv > T) || (eq && rank < need); rank += eq ? 1u : 0u;
                                        word |= sel ? (1u << crow(4 * g4 + e, h)) : 0u; }
                                    before += cg[g4] + pg[g4];
                                }
                                word |= shxu(word, 32, lane);
                                if (h == 0) { maskrow[st] = word; runb[r] = before; }
                            }
                            __syncthreads();
                        }
                    }
                }
            }
            __syncthreads();
        }
    }
}
__device__ __forceinline__ float max3f(float a, float b, float c) { float r; asm("v_max3_f32 %0, %1, %2, %3" : "=v"(r) : "v"(a), "v"(b), "v"(c)); return r; }
__device__ __forceinline__ int pi32(int r) { return (r & ~12) | ((r & 4) << 1) | ((r & 8) >> 1); }
constexpr int AT_KPE = 8192, AT_VSLOT = 8192;
template <int MODE> struct AtMap { static constexpr int KSLOT = (MODE == 0) ? 12288 : 8192, VR = 4 * KSLOT, MASK = VR + 5 * AT_VSLOT; };
static_assert(AtMap<1>::MASK + 8 * 32 * 65 * 4 <= 147456 - 64 && AtMap<0>::MASK <= 147456 - 64, "attention LDS map");
template <int MODE>
__device__ __forceinline__ void attn_stage(LAS unsigned char* lds, int ks_, int vs_, const bf16_t* k1, int ldk1, const bf16_t* k2, const bf16_t* vt, int kt, unsigned voK, unsigned voV, unsigned voP, int wave) {
    const char* kb = (const char*)(k1 + (size_t)kt * ldk1); const char* vb = (const char*)(vt + (size_t)kt * 64);
    __builtin_amdgcn_global_load_lds((const unsigned*)(kb + voK), (LAS unsigned*)(lds + ks_ * AtMap<MODE>::KSLOT + wave * 1024), 16, 0, 0);
    __builtin_amdgcn_global_load_lds((const unsigned*)(vb + voV), (LAS unsigned*)(lds + AtMap<MODE>::VR + vs_ * AT_VSLOT + wave * 1024), 16, 0, 0);
    if (MODE == 0) { if (wave < 4) { const char* pb = (const char*)(k2 + (size_t)kt * 32);
        __builtin_amdgcn_global_load_lds((const unsigned*)(pb + voP), (LAS unsigned*)(lds + ks_ * AtMap<MODE>::KSLOT + AT_KPE + wave * 1024), 16, 0, 0); } }
}
template <int NKS, int MODE>
__device__ __forceinline__ void attn_wg_item(LAS unsigned char* lds, const bf16_t* qrow, const bf16_t* k1, int ldk1, const bf16_t* k2, const bf16_t* vt,
                                             int kt_begin, int kt_end, int my_end, const unsigned* maskrow, float sink_l2, bf16_t* orow, int tid, int wave, int lane) {
    const int r = lane & 31, h = lane >> 5, pr = pi32(r);
    bf16x8 qf[NKS];
#pragma unroll
    for (int ks = 0; ks < NKS; ++ks) qf[ks] = *(const bf16x8*)(qrow + 16 * ks + 8 * h);
#pragma unroll
    for (int ks = 0; ks < NKS; ++ks) asm volatile("" :: "v"(qf[ks]));
    f32x16 o0, o1, s0, s1;
#pragma unroll
    for (int t = 0; t < 16; ++t) { o0[t] = 0.f; o1[t] = 0.f; s0[t] = 0.f; s1[t] = 0.f; }
    float mref = 0.f, l = 0.f; bool init = false;
    const int kx0 = pr * 128, kx1 = (32 + pr) * 128, ksw = (pr >> 1) & 7;
    const int px0 = AT_KPE + pr * 64, px1 = AT_KPE + (32 + pr) * 64, psw = (pr >> 2) & 3;
    const int vx0 = AtMap<MODE>::VR + r * 128, vx1 = AtMap<MODE>::VR + (32 + r) * 128, vsw = (r >> 1) & 7;
    const bool skew = wave >= 4;
    __syncthreads();
    LAS unsigned* mrow = (LAS unsigned*)(lds + AtMap<MODE>::MASK) + (wave * 32 + r) * 65;
    if (MODE == 1) {
        LAS unsigned* mw = (LAS unsigned*)(lds + AtMap<MODE>::MASK) + (wave * 32) * 65;
        const unsigned* mg = maskrow;
        const int nw = my_end >> 5;
        const unsigned lo4 = (unsigned)lane * 4u;
        for (int q = 0; q < 32; ++q) { const char* mq = (const char*)(mg + (size_t)q * 64); if (lane < nw) mw[q * 65 + lane] = *(const unsigned*)(mq + lo4); }
        asm volatile("s_waitcnt vmcnt(0)" ::: "memory");
    }
    const int ntile = (kt_end - kt_begin) >> 6;
    unsigned voK, voV, voP;
    { const int row = tid >> 3, cp = tid & 7, c = cp ^ ((row >> 1) & 7); voK = (unsigned)(row * ldk1 + 8 * c) * 2u; voV = (unsigned)(row * 64 + 8 * c) * 2u;
      const int key = (tid & 255) >> 2, cq = tid & 3, cc = cq ^ ((key >> 2) & 3); voP = (unsigned)(key * 32 + 8 * cc) * 2u; }
    attn_stage<MODE>(lds, 0, 0, k1, ldk1, k2, vt, kt_begin, voK, voV, voP, wave);
    if (ntile > 1) attn_stage<MODE>(lds, 1, 1, k1, ldk1, k2, vt, kt_begin + 64, voK, voV, voP, wave);
    if (ntile > 2) attn_stage<MODE>(lds, 2, 2, k1, ldk1, k2, vt, kt_begin + 128, voK, voV, voP, wave);
#define AT_QK(KSL) do { const LAS unsigned char* B_ = lds + (KSL) * AtMap<MODE>::KSLOT; bf16x8 ka_[NKS], kb_[NKS]; \
        _Pragma("unroll") for (int ks = 0; ks < NKS; ++ks) { \
            if (ks < 4) { const int sw = ((2 * ks + h) ^ ksw) << 4; ka_[ks] = *(const LAS bf16x8*)(B_ + kx0 + sw); kb_[ks] = *(const LAS bf16x8*)(B_ + kx1 + sw); } \
            else { const int sw = ((2 * (ks - 4) + h) ^ psw) << 4; ka_[ks] = *(const LAS bf16x8*)(B_ + px0 + sw); kb_[ks] = *(const LAS bf16x8*)(B_ + px1 + sw); } } \
        __builtin_amdgcn_sched_barrier(0); \
        _Pragma("unroll") for (int t = 0; t < 16; ++t) { s0[t] = 0.f; s1[t] = 0.f; } \
        _Pragma("unroll") for (int ks = 0; ks < NKS; ++ks) { s0 = MFMA32(ka_[ks], qf[ks], s0); s1 = MFMA32(kb_[ks], qf[ks], s1); } \
        __builtin_amdgcn_sched_barrier(0); } while (0)
#define AT_SMPV(KT, VSL) do { const LAS unsigned char* V_ = lds + (VSL) * AT_VSLOT; \
        unsigned w0 = 0u, w1 = 0u; if (MODE == 1) { w0 = mrow[(KT) >> 5] >> (8 * h); w1 = mrow[((KT) >> 5) + 1] >> (8 * h); } \
        float mxl = fmaxf(s0[0], s1[0]); _Pragma("unroll") for (int t = 1; t < 16; ++t) mxl = max3f(mxl, s0[t], s1[t]); \
        if (__builtin_amdgcn_ballot_w64((mxl - mref > 8.0f) || !init) != 0ull) { \
            if (MODE == 1) { _Pragma("unroll") for (int t = 0; t < 16; ++t) { const int bit = (t & 3) + 4 * ((t >> 2) & 1) + 16 * (t >> 3); \
                if (!((w0 >> bit) & 1u)) s0[t] = -INFINITY; if (!((w1 >> bit) & 1u)) s1[t] = -INFINITY; } } \
            float mx = fmaxf(s0[0], s1[0]); _Pragma("unroll") for (int t = 1; t < 16; ++t) mx = max3f(mx, s0[t], s1[t]); \
            mx = fmaxf(mx, shx(mx, 32, lane)); const bool seen = mx > -INFINITY; \
            const float mnew = init ? fmaxf(mx, mref) : (seen ? mx : 0.f); const float alpha = init ? __builtin_amdgcn_exp2f(mref - mnew) : 1.0f; \
            init = init || seen; mref = mnew; l *= alpha; \
            _Pragma("unroll") for (int t = 0; t < 16; ++t) { o0[t] *= alpha; o1[t] *= alpha; } } \
        float ps0 = 0.f, ps1 = 0.f; \
        _Pragma("unroll") for (int t = 0; t < 16; ++t) { float p0 = __builtin_amdgcn_exp2f(s0[t] - mref), p1 = __builtin_amdgcn_exp2f(s1[t] - mref); \
            if (MODE == 1) { const int bit = (t & 3) + 4 * ((t >> 2) & 1) + 16 * (t >> 3); \
                p0 = __uint_as_float(__float_as_uint(p0) & (unsigned)__builtin_amdgcn_sbfe((int)w0, bit, 1)); p1 = __uint_as_float(__float_as_uint(p1) & (unsigned)__builtin_amdgcn_sbfe((int)w1, bit, 1)); } \
            s0[t] = p0; s1[t] = p1; ps0 += p0; ps1 += p1; } \
        l += ps0 + ps1; \
        bf16x8 va_[4], vb_[4]; \
        _Pragma("unroll") for (int s4 = 0; s4 < 4; ++s4) { const int sw = ((2 * s4 + h) ^ vsw) << 4; va_[s4] = *(const LAS bf16x8*)(V_ + vx0 + sw); vb_[s4] = *(const LAS bf16x8*)(V_ + vx1 + sw); } \
        bf16x8 pb[4]; pb[0] = pack8(s0, 0); pb[1] = pack8(s0, 1); pb[2] = pack8(s1, 0); pb[3] = pack8(s1, 1); \
        __builtin_amdgcn_sched_barrier(0); \
        _Pragma("unroll") for (int s4 = 0; s4 < 4; ++s4) { o0 = MFMA32(va_[s4], pb[s4], o0); o1 = MFMA32(vb_[s4], pb[s4], o1); } \
        __builtin_amdgcn_sched_barrier(0); } while (0)
    int ksl = 0, vsl = 0;
#pragma unroll 1
    for (int ti = 0; ti <= ntile; ++ti) {
        const int kt = kt_begin + 64 * ti;
        if (ti + 2 < ntile) { if (MODE == 0 && wave < 4) asm volatile("s_waitcnt vmcnt(6)" ::: "memory"); else asm volatile("s_waitcnt vmcnt(4)" ::: "memory"); }
        else if (ti + 1 < ntile) { if (MODE == 0 && wave < 4) asm volatile("s_waitcnt vmcnt(3)" ::: "memory"); else asm volatile("s_waitcnt vmcnt(2)" ::: "memory"); }
        else asm volatile("s_waitcnt vmcnt(0)" ::: "memory");
        __builtin_amdgcn_s_barrier();
        asm volatile("" ::: "memory");
        if (ti + 3 < ntile) attn_stage<MODE>(lds, (ksl + 3) & 3, (vsl + 3 >= 5) ? vsl - 2 : vsl + 3, k1, ldk1, k2, vt, kt + 192, voK, voV, voP, wave);
        const bool cur_ok = (ti < ntile) && (kt < my_end);
        if (!skew && cur_ok) AT_QK(ksl);
        { const int xt = skew ? kt - 64 : kt, xv = skew ? ((vsl == 0) ? 4 : vsl - 1) : vsl;
          if (xt >= kt_begin && xt < kt_end && xt < my_end) AT_SMPV(xt, xv); }
        if (skew && cur_ok) AT_QK(ksl);
        ksl = (ksl + 1) & 3; vsl = (vsl == 4) ? 0 : vsl + 1;
    }
#undef AT_QK
#undef AT_SMPV
    float lt = l + shx(l, 32, lane);
    if (MODE == 2) lt += __builtin_amdgcn_exp2f(sink_l2 - mref);
    const float inv = 1.0f / lt;
#pragma unroll
    for (int g = 0; g < 4; ++g) {
        u32x2 w0, w1;
        w0.x = pk2(o0[4 * g] * inv, o0[4 * g + 1] * inv); w0.y = pk2(o0[4 * g + 2] * inv, o0[4 * g + 3] * inv);
        w1.x = pk2(o1[4 * g] * inv, o1[4 * g + 1] * inv); w1.y = pk2(o1[4 * g + 2] * inv, o1[4 * g + 3] * inv);
        *(u32x2*)(orow + 8 * g + 4 * h) = w0; *(u32x2*)(orow + 32 + 8 * g + 4 * h) = w1;
    }
}

#define A5_SB() __builtin_amdgcn_sched_barrier(0)
#ifndef A5_NEGM
#define A5_NEGM 1
#endif
#ifndef A5_GV
#define A5_GV 2
#endif
#ifndef A5_GK
#define A5_GK 5
#endif
#ifndef A5_TRIG
#define A5_TRIG 256.0f
#endif
#ifndef A5_RISE
#define A5_RISE 8.0f
#endif
#ifndef A5_LSUM
#define A5_LSUM 0
#endif
#ifndef A5_WIDE_STORE
#define A5_WIDE_STORE 1
#endif
#ifndef A5_MASK_DMA
#define A5_MASK_DMA 1
#endif
#ifndef BR_F8
#define BR_F8 1
#endif
#if BR_F8
#define A5_OPTR(base, off) ((bf16_t*)((unsigned char*)(base) + (off)))
#else
#define A5_OPTR(base, off) ((base) + (off))
#endif
#ifndef A5_VLATE
#define A5_VLATE 1
#endif
template <int MODE> struct A5Map { static constexpr int KSLOT = (MODE == 0) ? 12288 : 8192, NKR = (MODE == 0) ? 5 : 4, VR = NKR * KSLOT, MASK = VR + 5 * AT_VSLOT; };
static_assert(A5Map<1>::MASK + 8 * 32 * 65 * 4 <= 147456 - 64 && A5Map<0>::MASK <= 147456 - 64, "attention v5 LDS map");
template <int MODE> __device__ __forceinline__ void a5_stage_k(LAS unsigned char* lds, int slot, const bf16_t* k1, int ldk1, const bf16_t* k2, int kt, unsigned voK, unsigned voP, int wave) {
    const char* kb = (const char*)(k1 + (size_t)kt * ldk1);
    __builtin_amdgcn_global_load_lds((const unsigned*)(kb + voK), (LAS unsigned*)(lds + slot * A5Map<MODE>::KSLOT + wave * 1024), 16, 0, 0);
    if (MODE == 0) { if (wave < 4) { const char* pb = (const char*)(k2 + (size_t)kt * 32);
        __builtin_amdgcn_global_load_lds((const unsigned*)(pb + voP), (LAS unsigned*)(lds + slot * A5Map<MODE>::KSLOT + AT_KPE + wave * 1024), 16, 0, 0); } }
}
template <int MODE> __device__ __forceinline__ void a5_stage_v(LAS unsigned char* lds, int slot, const bf16_t* vt, int kt, unsigned voV, int wave) {
    const char* vb = (const char*)(vt + (size_t)kt * 64);
    __builtin_amdgcn_global_load_lds((const unsigned*)(vb + voV), (LAS unsigned*)(lds + A5Map<MODE>::VR + slot * AT_VSLOT + wave * 1024), 16, 0, 0);
}
__device__ __forceinline__ void a5_wait_bar(int allowed) {
    if (allowed >= 6) asm volatile("s_waitcnt vmcnt(6) lgkmcnt(0)\n\ts_barrier" ::: "memory");
    else if (allowed >= 4) asm volatile("s_waitcnt vmcnt(4) lgkmcnt(0)\n\ts_barrier" ::: "memory");
    else if (allowed == 3) asm volatile("s_waitcnt vmcnt(3) lgkmcnt(0)\n\ts_barrier" ::: "memory");
    else if (allowed == 2) asm volatile("s_waitcnt vmcnt(2) lgkmcnt(0)\n\ts_barrier" ::: "memory");
    else if (allowed == 1) asm volatile("s_waitcnt vmcnt(1) lgkmcnt(0)\n\ts_barrier" ::: "memory");
    else asm volatile("s_waitcnt vmcnt(0) lgkmcnt(0)\n\ts_barrier" ::: "memory");
}
template <int NKS, int MODE, int PV = 0>
__device__ __forceinline__ void attn5_item(LAS unsigned char* lds, const bf16_t* qrow, const bf16_t* k1, int ldk1, const bf16_t* k2, const bf16_t* vt,
                                           int kt_begin, int nt, int ntm, const unsigned* maskrow, float sink_l2, bf16_t* orow, int tid, int wave, int lane) {
    constexpr int KSLOT = A5Map<MODE>::KSLOT, VR = A5Map<MODE>::VR, NKR = A5Map<MODE>::NKR;
    const int r = lane & 31, h = lane >> 5, pr = pi32(r);
    const unsigned ko0 = (unsigned)(pr * 128 + ((h ^ ((pr >> 1) & 7)) << 4)), kp0 = (unsigned)(AT_KPE + pr * 64 + ((h ^ ((pr >> 2) & 3)) << 4)), vo0 = (unsigned)(r * 128 + ((h ^ ((r >> 1) & 7)) << 4));
    unsigned voK, voV, voP;
    { const int row = tid >> 3, cp = tid & 7, c = cp ^ ((row >> 1) & 7); voK = (unsigned)(row * ldk1 + 8 * c) * 2u; voV = (unsigned)(row * 64 + 8 * c) * 2u;
      const int key = (tid & 255) >> 2, cq = tid & 3, cc = cq ^ ((key >> 2) & 3); voP = (unsigned)(key * 32 + 8 * cc) * 2u; }
    const int KP = (MODE == 0 && wave < 4) ? 2 : 1;
    asm volatile("s_waitcnt lgkmcnt(0)\n\ts_barrier" ::: "memory");
    LAS unsigned* mrow = (LAS unsigned*)(lds + A5Map<MODE>::MASK) + (wave * 32 + r) * 65;
    a5_stage_k<MODE>(lds, 0, k1, ldk1, k2, kt_begin, voK, voP, wave);
    a5_stage_v<MODE>(lds, 0, vt, kt_begin, voV, wave);
    if (nt > 1) { a5_stage_k<MODE>(lds, 1, k1, ldk1, k2, kt_begin + 64, voK, voP, wave); a5_stage_v<MODE>(lds, 1, vt, kt_begin + 64, voV, wave); }
    if (nt > 2) { a5_stage_k<MODE>(lds, 2, k1, ldk1, k2, kt_begin + 128, voK, voP, wave); a5_stage_v<MODE>(lds, 2, vt, kt_begin + 128, voV, wave); }
    if (nt > 3) a5_stage_k<MODE>(lds, 3, k1, ldk1, k2, kt_begin + 192, voK, voP, wave);
    bf16x8 qf[NKS];
#pragma unroll
    for (int ks = 0; ks < NKS; ++ks) qf[ks] = *(const bf16x8*)(qrow + 16 * ks + 8 * h);
    if (MODE == 1) {
        LAS unsigned* mw = (LAS unsigned*)(lds + A5Map<MODE>::MASK) + (wave * 32) * 65;
        const unsigned lo4 = (unsigned)lane * 4u;
#if A5_MASK_DMA
#pragma unroll 4
        for (int q = 0; q < 32; ++q) { const char* mq = (const char*)(maskrow + (size_t)q * 64);
            __builtin_amdgcn_global_load_lds((const unsigned*)(mq + lo4), (LAS unsigned*)(mw + q * 65), 4, 0, 0); }
#else
#pragma unroll 8
        for (int q = 0; q < 32; ++q) { const char* mq = (const char*)(maskrow + (size_t)q * 64); mw[q * 65 + lane] = *(const unsigned*)(mq + lo4); }
#endif
    }
#pragma unroll
    for (int ks = 0; ks < NKS; ++ks) asm volatile("" :: "v"(qf[ks]));
    asm volatile("s_waitcnt vmcnt(0) lgkmcnt(0)\n\ts_barrier" ::: "memory");
    f32x16 C[2], o0, o1; float P[32];
    bf16x8 kf[2 * NKS], vf[8]; u32x4 pw[4];
#pragma unroll
    for (int t = 0; t < 16; ++t) { o0[t] = 0.f; o1[t] = 0.f; }
    constexpr bool NEGM = A5_NEGM != 0;
    constexpr bool LSUM = (MODE == 1) && (A5_LSUM != 0);
    float mref = 0.f, l = 0.f, al_pend = 1.f, al_a = 1.f; bool pend = false, pend_a = false; f32x16 negm, lacc;
    bf16x8 ones_;
#pragma unroll
    for (int t = 0; t < 16; ++t) lacc[t] = 0.f;
#pragma unroll
    for (int t = 0; t < 8; ++t) ones_[t] = (short)0x3F80;
    if (PV != 0) { _Pragma("unroll") for (int i_ = 0; i_ < 4; ++i_) { pw[i_].x = 0x3c003c00u; pw[i_].y = 0x3c003c00u; pw[i_].z = 0x3c003c00u; pw[i_].w = 0x3c003c00u; }
                   _Pragma("unroll") for (int i_ = 0; i_ < 8; ++i_) vf[i_] = qf[i_ % NKS]; _Pragma("unroll") for (int i_ = 8; i_ < 2 * NKS; ++i_) kf[i_] = qf[i_ % NKS]; }
#define A5_DSRD(dst, addr, OFF) asm volatile("ds_read_b128 %0, %1 offset:%2" : "=&v"(dst) : "v"(addr), "i"(OFF))
#define A5_KRD(i, KA) do { if (((i) >> 1) < 4) A5_DSRD(kf[i], ((KA) + ko0) ^ (unsigned)(((i) >> 1) << 5), ((i) & 1) ? 4096 : 0); \
                           else A5_DSRD(kf[i], ((KA) + kp0) ^ (unsigned)((((i) >> 1) - 4) << 5), ((i) & 1) ? 2048 : 0); } while (0)
#define A5_VRD(i, VA) A5_DSRD(vf[i], ((VA) + vo0) ^ (unsigned)(((i) >> 1) << 5), ((i) & 1) ? 4096 : 0)
#define A5_LGKM(N, x) asm volatile("s_waitcnt lgkmcnt(%1)" : "+v"(x) : "n"(N))
#define A5_SUMPK(g) do { const int b_ = 4 * (g); \
        if (!LSUM) { sacc += P[b_]; sacc += P[b_ + 1]; sacc += P[b_ + 2]; sacc += P[b_ + 3]; asm volatile("" : "+v"(sacc)); } \
        pw[(g) >> 1][((g) & 1) * 2] = pk2(P[b_], P[b_ + 1]); pw[(g) >> 1][((g) & 1) * 2 + 1] = pk2(P[b_ + 2], P[b_ + 3]); \
        if ((g) & 1) asm volatile("" : "+v"(pw[(g) >> 1])); } while (0)
#define A5_EXP(j) do { _Pragma("unroll") for (int e_ = 4 * (j); e_ < 4 * (j) + 4; ++e_) { const int a_ = e_ >> 4, t_ = e_ & 15; \
        float p_ = __builtin_amdgcn_exp2f(NEGM ? C[a_][t_] : C[a_][t_] - mref); \
        if (MODE == 1) { const int bit_ = (t_ & 3) + 4 * ((t_ >> 2) & 1) + 16 * (t_ >> 3); p_ = __uint_as_float(__float_as_uint(p_) & (unsigned)__builtin_amdgcn_sbfe((int)(a_ ? w1 : w0), bit_, 1)); } \
        P[e_] = p_; } \
        asm volatile("" : "+v"(P[4 * (j)]), "+v"(P[4 * (j) + 1]), "+v"(P[4 * (j) + 2]), "+v"(P[4 * (j) + 3])); } while (0)
    {
        const unsigned KB0 = (unsigned)(size_t)lds;
#pragma unroll
        for (int i = 0; i < 8; ++i) A5_KRD(i, KB0);
        asm volatile("s_waitcnt lgkmcnt(0)\n\ts_barrier" ::: "memory");
#pragma unroll
        for (int i = 0; i < 8; ++i) asm volatile("" : "+v"(kf[i]));
    }
    int vprev = 4, kcur = 0;
#define A5_ISSUE_V(t) do { if (PV != 1 && (t) + 3 < nt) a5_stage_v<MODE>(lds, (vprev + 4 >= 5) ? vprev - 1 : vprev + 4, vt, kt_begin + 64 * (t) + 192, voV, wave); } while (0)
#define A5_ISSUE_K(t) do { if (PV != 1 && (t) + 4 < nt) a5_stage_k<MODE>(lds, (NKR == 4) ? kcur : ((kcur == 0) ? 4 : kcur - 1), k1, ldk1, k2, kt_begin + 64 * (t) + 256, voK, voP, wave); } while (0)
#define A5_SLOTS() \
        const int knext = (kcur == NKR - 1) ? 0 : kcur + 1; \
        const unsigned KBn = (unsigned)(size_t)lds + knext * KSLOT, KBc = (unsigned)(size_t)lds + kcur * KSLOT, VBp = (unsigned)(size_t)lds + VR + vprev * AT_VSLOT; (void)KBn; (void)KBc; (void)VBp;
#define A5_ISSUE(t) A5_ISSUE_V(t); A5_ISSUE_K(t); A5_SLOTS()
#define A5_CLOSE(t) do { int allowed_; \
        if ((t) + 2 < nt) allowed_ = 1 + (((t) + 3 < nt) ? KP + 1 : 0) + (((t) + 4 < nt) ? KP : 0); \
        else allowed_ = ((t) + 1 < nt) ? KP + 1 : 0; \
        a5_wait_bar(allowed_); vprev = (vprev == 4) ? 0 : vprev + 1; kcur = knext; \
        _Pragma("unroll") for (int i_ = 0; i_ < 8; ++i_) asm volatile("" : "+v"(kf[i_])); } while (0)
    {
        A5_ISSUE(0);
        unsigned w0 = 0u, w1 = 0u; if (MODE == 1) { w0 = mrow[0] >> (8 * h); w1 = mrow[1] >> (8 * h); }
#pragma unroll
        for (int i = 8; i < 2 * NKS; ++i) A5_KRD(i, KBc);
#pragma unroll
        for (int i = 8; i < 2 * NKS; ++i) A5_LGKM(0, kf[i]);
#pragma unroll
        for (int i = 0; i < 2 * NKS; ++i) {
            if (i < 2) { f32x16 z_; _Pragma("unroll") for (int t_ = 0; t_ < 16; ++t_) z_[t_] = 0.f; C[i & 1] = MFMA32(kf[i], qf[i >> 1], z_); }
            else C[i & 1] = MFMA32(kf[i], qf[i >> 1], C[i & 1]);
        }
        A5_SB();
        {
            asm volatile("s_nop 15\n\ts_nop 3" : "+v"(C[0]), "+v"(C[1]) :: "memory");
            float ma_ = max3f(C[0][0], C[0][1], C[0][2]), mb_ = max3f(C[1][0], C[1][1], C[1][2]);
            _Pragma("unroll") for (int t_ = 3; t_ < 15; t_ += 2) { ma_ = max3f(ma_, C[0][t_], C[0][t_ + 1]); mb_ = max3f(mb_, C[1][t_], C[1][t_ + 1]); }
            float mx_ = max3f(ma_, mb_, C[0][15]); mx_ = max3f(mx_, C[1][15], C[1][15]);
            mref = fmaxf(mx_, shx(mx_, 32, lane));
            if (NEGM) { _Pragma("unroll") for (int t_ = 0; t_ < 16; ++t_) { C[0][t_] -= mref; C[1][t_] -= mref; negm[t_] = -mref; } }
        }
#pragma unroll
        for (int i = 0; i < 8; ++i) A5_KRD(i, KBn);
#pragma unroll
        for (int j = 0; j < 8; ++j) A5_EXP(j);
        A5_SB();
        A5_CLOSE(0);
    }
#pragma unroll 1
    for (int t = 1; t < ntm; ++t) {
        if (A5_GV < 0) A5_ISSUE_V(t);
        if (A5_GK < 0) A5_ISSUE_K(t);
        A5_SLOTS();
        unsigned w0 = 0u, w1 = 0u;
        if (MODE == 1) { const unsigned ma_ = (unsigned)(size_t)mrow + 8u * (unsigned)t;
            asm volatile("ds_read_b32 %0, %1" : "=&v"(w0) : "v"(ma_)); asm volatile("ds_read_b32 %0, %1 offset:4" : "=&v"(w1) : "v"(ma_)); }
        float sacc = 0.f;
        A5_SB();
#pragma unroll
        for (int i = 0; i < 2 * NKS; ++i) {
            if (PV != 4) { if (A5_VLATE ? (i >= 2 * NKS - 3) : (i >= 2 * NKS - 8)) A5_VRD(i - (A5_VLATE ? 2 * NKS - 3 : 2 * NKS - 8), VBp); }
            if (PV != 4) { if (NKS > 4 && i < 2 * NKS - 8) A5_KRD(8 + i, KBc); }
            if (NKS > 4 && i >= 8) A5_LGKM(A5_VLATE ? 3 : 8, kf[i]);
            if (PV != 3) { if (i < 2 && !NEGM) { f32x16 z_; _Pragma("unroll") for (int t_ = 0; t_ < 16; ++t_) z_[t_] = 0.f; C[i & 1] = MFMA32(kf[i], qf[i >> 1], z_); }
                           else C[i & 1] = MFMA32(kf[i], qf[i >> 1], (i < 2) ? negm : C[i & 1]); }
            if (PV != 2) { if (i < 8) A5_SUMPK(i); }
            A5_SB();
            if (i == A5_GV) { A5_ISSUE_V(t); A5_SB(); }
            if (i == A5_GK) { A5_ISSUE_K(t); A5_SB(); }
        }
        l += sacc;
        if (LSUM) {
            if (t + 1 < ntm && __builtin_amdgcn_ballot_w64(lacc[0] > 4294967296.0f) != 0ull) {
                const float rise_ = __builtin_amdgcn_logf(fmaxf(lacc[0], 1.0f)), dl_ = (rise_ > 8.0f) ? rise_ : 0.f;
                al_a = __builtin_amdgcn_exp2f(-dl_); mref += dl_; pend_a = true;
                if (NEGM) { _Pragma("unroll") for (int t_ = 0; t_ < 16; ++t_) negm[t_] = -mref; }
            }
        } else
        if (PV != 2 && t + 1 < ntm && __builtin_amdgcn_ballot_w64(sacc > A5_TRIG) != 0ull) {
            float ma_ = max3f(P[0], P[1], P[2]), mb_ = max3f(P[3], P[4], P[5]);
#pragma unroll
            for (int e_ = 6; e_ < 30; e_ += 4) { ma_ = max3f(ma_, P[e_], P[e_ + 1]); mb_ = max3f(mb_, P[e_ + 2], P[e_ + 3]); }
            float mxp_ = max3f(ma_, mb_, P[30]); mxp_ = fmaxf(mxp_, P[31]); mxp_ = fmaxf(mxp_, shx(mxp_, 32, lane));
            const float rise_ = __builtin_amdgcn_logf(fmaxf(mxp_, 1.0f)), dl_ = (rise_ > A5_RISE) ? rise_ : 0.f;
            al_a = __builtin_amdgcn_exp2f(-dl_); mref += dl_; pend_a = true;
            if (NEGM) { _Pragma("unroll") for (int t_ = 0; t_ < 16; ++t_) negm[t_] = -mref; }
        }
#pragma unroll
        for (int j = 0; j < 8; ++j) {
            if (PV != 4) { if (j >= 2 && j < 6) { A5_KRD(2 * (j - 2), KBn); A5_KRD(2 * (j - 2) + 1, KBn); } }
            if (PV != 4 && A5_VLATE) { if (j < 5) A5_VRD(j + 3, VBp); }
            { constexpr int NW0[8] = {7, 6, 7, 8, 9, 10, 9, 8}, NW1[8] = {3, 3, 5, 7, 9, 8, 5, 2};
              if (MODE == 1 && j == 0) { asm volatile("s_waitcnt lgkmcnt(%3)" : "+v"(vf[0]), "+v"(w0), "+v"(w1) : "n"(A5_VLATE ? 3 : 7)); w0 >>= 8 * h; w1 >>= 8 * h; }
              else A5_LGKM(A5_VLATE ? NW1[j] : NW0[j], vf[j]); }
            if (PV != 3) { if (j & 1) o1 = MFMA32(vf[j], __builtin_bit_cast(bf16x8, pw[j >> 1]), o1); else o0 = MFMA32(vf[j], __builtin_bit_cast(bf16x8, pw[j >> 1]), o0); }
            if (LSUM && (j & 1)) lacc = MFMA32(ones_, __builtin_bit_cast(bf16x8, pw[j >> 1]), lacc);
            if (PV != 2) A5_EXP(j);
            A5_SB();
        }
        A5_CLOSE(t);
        if (pend) {
#pragma unroll
            for (int t_ = 0; t_ < 16; ++t_) { o0[t_] *= al_pend; o1[t_] *= al_pend; }
            l *= al_pend; pend = false;
            if (LSUM) { _Pragma("unroll") for (int t_ = 0; t_ < 16; ++t_) lacc[t_] *= al_pend; }
        }
        if (pend_a) { pend = true; al_pend = al_a; pend_a = false; }
    }
    {
        if (ntm < nt) { A5_ISSUE(ntm); (void)knext; }
        const unsigned VBl = (unsigned)(size_t)lds + VR + vprev * AT_VSLOT;
        float sacc = 0.f;
#pragma unroll
        for (int i = 0; i < 8; ++i) A5_VRD(i, VBl);
#pragma unroll
        for (int g = 0; g < 8; ++g) A5_SUMPK(g);
#pragma unroll
        for (int i = 0; i < 8; ++i) A5_LGKM(0, vf[i]);
        l += sacc;
        A5_SB();
#pragma unroll
        for (int j = 0; j < 8; ++j) { if (j & 1) o1 = MFMA32(vf[j], __builtin_bit_cast(bf16x8, pw[j >> 1]), o1); else o0 = MFMA32(vf[j], __builtin_bit_cast(bf16x8, pw[j >> 1]), o0);
            if (LSUM && (j & 1)) lacc = MFMA32(ones_, __builtin_bit_cast(bf16x8, pw[j >> 1]), lacc); }
        A5_SB();
    }
#pragma unroll 1
    for (int t = ntm; t < nt; ++t) {
        if (t > ntm) { A5_ISSUE(t); A5_CLOSE(t); }
        else { const int knext = (kcur == NKR - 1) ? 0 : kcur + 1; A5_CLOSE(t); }
    }
#undef A5_ISSUE
#undef A5_ISSUE_V
#undef A5_ISSUE_K
#undef A5_SLOTS
#undef A5_CLOSE
#undef A5_KRD
#undef A5_DSRD
#undef A5_LGKM
#undef A5_VRD
#undef A5_SUMPK
#undef A5_EXP
    float lt = LSUM ? lacc[0] : l + shx(l, 32, lane);
    if (MODE == 2) lt += __builtin_amdgcn_exp2f(sink_l2 - mref);
    const float inv = 1.0f / lt;
#if BR_F8
    { const float inv16 = inv * 16.0f;
#pragma unroll
      for (int p = 0; p < 2; ++p) { const int ge = 2 * p, go = 2 * p + 1; int xe0 = 0, xo0 = 0, xe1 = 0, xo1 = 0;
        xe0 = f8x4(o0[4 * ge] * inv16, o0[4 * ge + 1] * inv16, o0[4 * ge + 2] * inv16, o0[4 * ge + 3] * inv16); xo0 = f8x4(o0[4 * go] * inv16, o0[4 * go + 1] * inv16, o0[4 * go + 2] * inv16, o0[4 * go + 3] * inv16);
        xe1 = f8x4(o1[4 * ge] * inv16, o1[4 * ge + 1] * inv16, o1[4 * ge + 2] * inv16, o1[4 * ge + 3] * inv16); xo1 = f8x4(o1[4 * go] * inv16, o1[4 * go + 1] * inv16, o1[4 * go + 2] * inv16, o1[4 * go + 3] * inv16);
        const auto a = __builtin_amdgcn_permlane32_swap((unsigned)xe0, (unsigned)xo0, false, false), b = __builtin_amdgcn_permlane32_swap((unsigned)xe1, (unsigned)xo1, false, false);
        u32x2 c0, c1; c0.x = a[0]; c0.y = a[1]; c1.x = b[0]; c1.y = b[1];
        unsigned char* q = (unsigned char*)orow + 8 * (h ? go : ge);
        *(u32x2*)q = c0; *(u32x2*)(q + 32) = c1; } }
#elif A5_WIDE_STORE
#pragma unroll
    for (int p = 0; p < 2; ++p) {
        u32x2 we0, wo0, we1, wo1; const int ge = 2 * p, go = 2 * p + 1;
        we0.x = pk2(o0[4 * ge] * inv, o0[4 * ge + 1] * inv); we0.y = pk2(o0[4 * ge + 2] * inv, o0[4 * ge + 3] * inv);
        wo0.x = pk2(o0[4 * go] * inv, o0[4 * go + 1] * inv); wo0.y = pk2(o0[4 * go + 2] * inv, o0[4 * go + 3] * inv);
        we1.x = pk2(o1[4 * ge] * inv, o1[4 * ge + 1] * inv); we1.y = pk2(o1[4 * ge + 2] * inv, o1[4 * ge + 3] * inv);
        wo1.x = pk2(o1[4 * go] * inv, o1[4 * go + 1] * inv); wo1.y = pk2(o1[4 * go + 2] * inv, o1[4 * go + 3] * inv);
        const auto a0 = __builtin_amdgcn_permlane32_swap(we0.x, wo0.x, false, false), a1 = __builtin_amdgcn_permlane32_swap(we0.y, wo0.y, false, false);
        const auto b0 = __builtin_amdgcn_permlane32_swap(we1.x, wo1.x, false, false), b1 = __builtin_amdgcn_permlane32_swap(we1.y, wo1.y, false, false);
        u32x4 c0, c1; c0.x = a0[0]; c0.y = a1[0]; c0.z = a0[1]; c0.w = a1[1]; c1.x = b0[0]; c1.y = b1[0]; c1.z = b0[1]; c1.w = b1[1];
        bf16_t* q = orow + 8 * (h ? go : ge);
        *(u32x4*)q = c0; *(u32x4*)(q + 32) = c1;
    }
#else
#pragma unroll
    for (int g = 0; g < 4; ++g) {
        u32x2 w0, w1;
        w0.x = pk2(o0[4 * g] * inv, o0[4 * g + 1] * inv); w0.y = pk2(o0[4 * g + 2] * inv, o0[4 * g + 3] * inv);
        w1.x = pk2(o1[4 * g] * inv, o1[4 * g + 1] * inv); w1.y = pk2(o1[4 * g + 2] * inv, o1[4 * g + 3] * inv);
        *(u32x2*)(orow + 8 * g + 4 * h) = w0; *(u32x2*)(orow + 32 + 8 * g + 4 * h) = w1;
    }
#endif
}

#define AT_OPAQUE_WS() size_t zz_ = 0; asm volatile("" : "+s"(zz_)); unsigned char* ws = ws_in + zz_; int lane = lane_in; asm volatile("" : "+v"(lane)); const int r = lane & 31; const int tid = wave * 64 + lane;
__device__ __forceinline__ void attention_phase2(unsigned char* ws_in, LAS unsigned char* lds, const float* sinks, int G, int bid, int tid_in, int wave, int lane_in, int which = 7, bool dummy = false) {
    for (int j0 = bid; j0 < 256; j0 += G) {
        const int j = (G == 256) ? ((j0 & 7) * 32 + (j0 >> 3)) : j0;
        const int b = j >> 5; const size_t tb = (size_t)b * SEQ;
        if (which & 1) {
            AT_OPAQUE_WS();
            const bf16_t* AQ = (const bf16_t*)(ws + R_AQ); const bf16_t* AKN = (const bf16_t*)(ws + R_AKN); const bf16_t* KPE = (const bf16_t*)(ws + R_KPE); const bf16_t* AVT = (const bf16_t*)(ws + R_AVT);
            bf16_t* OA = (bf16_t*)(ws + (dummy ? R_AV : WS_OABC));
            const int head = (j >> 2) & 7, qp = j & 3;
#pragma unroll 1
            for (int z = 0; z < 2; ++z) {
                const int Q = z ? qp : 7 - qp, c = 4 * Q + (wave >> 1), q0 = 64 * c + 32 * (wave & 1); const size_t qr = tb + q0 + r;
#ifdef A5_PROBE_VARIANT
                if (dummy) attn5_item<6, 0, A5_PROBE_VARIANT>(lds, AQ + qr * 768 + head * 96, AKN + tb * 512 + head * 64, 512, KPE + tb * 32, AVT + (size_t)(b * 8 + head) * 64 * SEQ,
                                 0, 4 * Q + 4, c + 1, nullptr, 0.f, A5_OPTR(OA, qr * 512 + head * 64), tid, wave, lane); else
#endif
                attn5_item<6, 0>(lds, AQ + qr * 768 + head * 96, AKN + tb * 512 + head * 64, 512, KPE + tb * 32, AVT + (size_t)(b * 8 + head) * 64 * SEQ,
                                 0, 4 * Q + 4, c + 1, nullptr, 0.f, A5_OPTR(OA, qr * 512 + head * 64), tid, wave, lane);
            }
        }
        const int g = (j >> 4) & 1, cp = j & 15, head = 4 * g + (wave >> 1);
        if (which & 2) {
            AT_OPAQUE_WS();
            const bf16_t* BQ = (const bf16_t*)(ws + R_BQ); const bf16_t* BK = (const bf16_t*)(ws + R_BK); const bf16_t* BVT = (const bf16_t*)(ws + R_BVT); const unsigned* MASK = (const unsigned*)(ws + R_MASK);
            bf16_t* OB = A5_OPTR((bf16_t*)(ws + (dummy ? R_AV : WS_OABC)), (dummy ? (size_t)0 : (size_t)NT * 512));
#pragma unroll 1
            for (int z = 0; z < 2; ++z) {
                const int c = z ? cp : 31 - cp, q0 = 64 * c + 32 * (wave & 1); const size_t qr = tb + q0 + r;
                attn5_item<4, 1>(lds, BQ + qr * 512 + head * 64, BK + tb * 128 + g * 64, 128, nullptr, BVT + (size_t)(b * 2 + g) * 64 * SEQ,
                                 0, c + 1, c + 1, MASK + (tb + q0) * 64, 0.f, A5_OPTR(OB, qr * 512 + head * 64), tid, wave, lane);
            }
        }
        if (which & 4) {
            AT_OPAQUE_WS();
            const bf16_t* CQ = (const bf16_t*)(ws + R_CQ); const bf16_t* CK = (const bf16_t*)(ws + R_CK); const bf16_t* CVT = (const bf16_t*)(ws + R_CVT);
            bf16_t* OC = A5_OPTR((bf16_t*)(ws + (dummy ? R_AV : WS_OABC)), (dummy ? (size_t)0 : (size_t)2 * NT * 512));
            const float sink = sinks[head] * LOG2E;
#pragma unroll 1
            for (int z = 0; z < 2; ++z) {
                const int c = z ? cp : 31 - cp, q0 = 64 * c + 32 * (wave & 1); const size_t qr = tb + q0 + r;
                attn5_item<4, 2>(lds, CQ + qr * 512 + head * 64, CK + tb * 128 + g * 64, 128, nullptr, CVT + (size_t)(b * 2 + g) * 64 * SEQ,
                                 (c >= 2) ? 64 * (c - 2) : 0, (c >= 2) ? 3 : c + 1, (c >= 2) ? 3 : c + 1, nullptr, sink, A5_OPTR(OC, qr * 512 + head * 64), tid, wave, lane);
            }
        }
    }
}
#ifndef GATE_F8
#define GATE_F8 1
#endif
#ifndef MOE_F8
#define MOE_F8 1
#endif
#ifndef OUT_F8
#define OUT_F8 1
#endif
__device__ __forceinline__ void ln_rows(f32x4 (&v)[4], const float* g, const float* b, int lane) {
    float s = 0.f;
#pragma unroll
    for (int j = 0; j < 4; ++j) s += (v[j][0] + v[j][1]) + (v[j][2] + v[j][3]);
    const float mean = wave_sum(s, lane) * (1.0f / DM); float s2 = 0.f;
#pragma unroll
    for (int j = 0; j < 4; ++j) { v[j] = v[j] - mean; s2 += (v[j][0] * v[j][0] + v[j][1] * v[j][1]) + (v[j][2] * v[j][2] + v[j][3] * v[j][3]); }
    const float rstd = 1.0f / sqrtf(wave_sum(s2, lane) * (1.0f / DM) + LN_EPS);
#pragma unroll
    for (int j = 0; j < 4; ++j) { const f32x4 gg = *(const f32x4*)(g + 4 * lane + 256 * j), bb = *(const f32x4*)(b + 4 * lane + 256 * j); v[j] = v[j] * rstd * gg + bb; }
}
__device__ __forceinline__ void store_row(const f32x4 (&v)[4], float* orow, bf16_t* brow, int lane, unsigned char* qrow = nullptr) {
#pragma unroll
    for (int j = 0; j < 4; ++j) {
        if (orow) *(f32x4*)(orow + 4 * lane + 256 * j) = v[j];
        if (brow) { u32x2 w; w.x = pk2(v[j][0], v[j][1]); w.y = pk2(v[j][2], v[j][3]); *(u32x2*)(brow + 4 * lane + 256 * j) = w; }
        if (qrow) *(int*)(qrow + 4 * lane + 256 * j) = f8x4(v[j][0], v[j][1], v[j][2], v[j][3]);
    }
}

__device__ __forceinline__ void conv_item(const float* srccol  , int ldw, const float* gain, bf16_t* dst  , int K, int k0, LAS float* scr, int lane, float f8s = 0.f  ) {
    const int n4 = lane & 7, kr = lane >> 3;
    f32x4 v[8];
#pragma unroll
    for (int i = 0; i < 8; ++i) v[i] = srccol ? *(const f32x4*)(srccol + (size_t)(k0 + 8 * i + kr) * ldw) : (f32x4){0.f, 0.f, 0.f, 0.f};
    if (gain) {
#pragma unroll
        for (int i = 0; i < 8; ++i) v[i] = v[i] * gain[k0 + 8 * i + kr];
    }
#pragma unroll
    for (int i = 0; i < 8; ++i) *(LAS f32x4*)(scr + (8 * i + kr) * 36 + 4 * n4) = v[i];
    asm volatile("s_waitcnt lgkmcnt(0)" ::: "memory");
    const int c = lane & 7;
#pragma unroll
    for (int j = 0; j < 4; ++j) { const int n = (lane >> 3) + 8 * j; const LAS float* s = scr + (8 * c) * 36 + n;
        if (f8s != 0.f) { const int p0 = f8x4(s[0 * 36] * f8s, s[1 * 36] * f8s, s[2 * 36] * f8s, s[3 * 36] * f8s), p1 = f8x4(s[4 * 36] * f8s, s[5 * 36] * f8s, s[6 * 36] * f8s, s[7 * 36] * f8s);
            u32x2 o8; o8.x = (unsigned)p0; o8.y = (unsigned)p1; *(u32x2*)((unsigned char*)dst + (size_t)n * K + k0 + 8 * c) = o8; }
        else {
        u32x4 o; o.x = pk2(s[0 * 36], s[1 * 36]); o.y = pk2(s[2 * 36], s[3 * 36]); o.z = pk2(s[4 * 36], s[5 * 36]); o.w = pk2(s[6 * 36], s[7 * 36]);
        *(u32x4*)(dst + (size_t)n * K + k0 + 8 * c) = o; } }
    asm volatile("s_waitcnt lgkmcnt(0)" ::: "memory");
}
__device__ __forceinline__ int w1_src(int n) {
    const int T = n >> 8, tc = n & 255, p = tc & 127, sec = tc >> 7;
    switch (T) {
        case 0: return 672 + (p >> 5) * 64 + (p & 31) + 32 * sec;
        case 1: return 672 + (4 + (p >> 5)) * 64 + (p & 31) + 32 * sec;
        case 2: return 1764 + (p >> 5) * 64 + (p & 31) + 32 * sec;
        case 3: return 1764 + (4 + (p >> 5)) * 64 + (p & 31) + 32 * sec;
        case 4: return 1440 + (p >> 5) * 64 + (p & 31) + 32 * sec;
        case 5: return (p < 64) ? 1184 + (p >> 5) * 64 + (p & 31) + 32 * sec : 2276 + ((p - 64) >> 5) * 64 + (p & 31) + 32 * sec;
        case 6: return (p < 32) ? 1696 + p + 32 * sec : ((p < 48) ? 640 + (p - 32) + 16 * sec : -1);
        case 7: return tc;
        case 8: return (tc < 128) ? 256 + tc : 1312 + (tc - 128);
        case 9: return 384 + tc;
        default: return (tc < 128) ? 2404 + tc : ((tc < 132) ? 1760 + (tc - 128) : -1);
    }
}
__device__ __forceinline__ int wuq_src(int n) { const int T = n >> 8, tc = n & 255; if (T < 2) return (4 * T + (tc >> 6)) * 96 + (tc & 63); const int p = tc & 127, sec = tc >> 7; return (p >> 4) * 96 + 64 + (p & 15) + 16 * sec; }
__device__ __forceinline__ int wukv_src(int n) { const int T = n >> 8, tc = n & 255; return (T < 2) ? (4 * T + (tc >> 6)) * 128 + (tc & 63) : (4 * (T - 2) + (tc >> 6)) * 128 + 64 + (tc & 63); }

__device__ __forceinline__ void convert_phase(KernArgP P, unsigned char* ws, int layer, LAS unsigned char* lds, int gw, int NGW, int wave, int lane, int part = -1, unsigned* qcnt = nullptr) {
    LAS float* scr = (LAS float*)(lds + wave * 16384);
    constexpr int I_W1 = 88 * 16, I_WG = 96 * 16, I_UQ = 24 * 6, I_UKV = 32 * 4, I_BR = 3 * 32 * 8, I_OUT = 32 * 16, I_GU = 16 * 32 * 16, I_DN = 16 * 32 * 8;
    constexpr int NITEMS = I_W1 + I_WG + I_UQ + I_UKV + I_BR + I_OUT + I_GU + I_DN, I_MIX = I_W1 + I_WG + I_UQ + I_UKV + I_BR + I_OUT;
    const float* w_in = P->w_in + (size_t)layer * DM * INC;
    const int ln = 4 * (lane & 7);
    const int it_lo = (part == 1) ? I_MIX : 0, it_hi = (part == 0) ? I_MIX : NITEMS;
    int it = it_lo + gw, chunk_end = 0;
    if (qcnt) { it = 0; chunk_end = 0; }
    for (;;) {
        if (qcnt) {
            if (it >= chunk_end) { unsigned b_ = 0u; if (lane == 0) b_ = __hip_atomic_fetch_add(qcnt, 8u, __ATOMIC_RELAXED, __HIP_MEMORY_SCOPE_AGENT); it = it_lo + (int)__builtin_amdgcn_readfirstlane((int)b_); chunk_end = it + 8; }
            if (it >= it_hi) break;
        } else if (it >= it_hi) break;
        const int it_cur = it; it += qcnt ? 1 : NGW;
        int q = it_cur;
        if (q < I_W1) { const int kb = q / 88, nb = q % 88, s = w1_src(32 * nb + ln);
            conv_item(s >= 0 ? w_in + s : nullptr, INC, nullptr, (bf16_t*)(ws + WB_W1) + (size_t)(32 * nb) * 1024, 1024, 64 * kb, scr, lane); continue; } q -= I_W1;
        if (q < I_WG) { const int kb = q / 96, nb = q % 96;
            if (GATE_F8) conv_item(w_in + 2532 + 32 * nb + ln, INC, nullptr, (bf16_t*)((unsigned char*)(ws + WB_WG) + (size_t)(32 * nb) * 1024), 1024, 64 * kb, scr, lane, 32.0f);
            else conv_item(w_in + 2532 + 32 * nb + ln, INC, nullptr, (bf16_t*)(ws + WB_WG) + (size_t)(32 * nb) * 1024, 1024, 64 * kb, scr, lane);
            continue; } q -= I_WG;
        if (q < I_UQ) { const int kb = q / 24, nb = q % 24;
            conv_item(P->a_w_uq + (size_t)layer * 384 * 768 + wuq_src(32 * nb + ln), 768, P->a_q_ln_g + layer * 384, (bf16_t*)(ws + WB_WUQ) + (size_t)(32 * nb) * 384, 384, 64 * kb, scr, lane); continue; } q -= I_UQ;
        if (q < I_UKV) { const int kb = q / 32, nb = q % 32;
            conv_item(P->a_w_ukv + (size_t)layer * 256 * 1024 + wukv_src(32 * nb + ln), 1024, P->a_kv_ln_g + layer * 256, (bf16_t*)(ws + WB_WUKV) + (size_t)(32 * nb) * 256, 256, 64 * kb, scr, lane); continue; } q -= I_UKV;
        if (q < I_BR) { const int br = q / 256, qq = q % 256, kb = qq / 32, nb = qq % 32; const float* src = (br == 0 ? P->w_br_a : (br == 1 ? P->w_br_b : P->w_br_c)) + (size_t)layer * 512 * 1024;
            if (BR_F8) conv_item(src + 32 * nb + ln, 1024, nullptr, (bf16_t*)((unsigned char*)(ws + WB_WBR) + (size_t)(br * 1024 + 32 * nb) * 512), 512, 64 * kb, scr, lane, 32.0f);
            else conv_item(src + 32 * nb + ln, 1024, nullptr, (bf16_t*)(ws + WB_WBR) + (size_t)(br * 1024 + 32 * nb) * 512, 512, 64 * kb, scr, lane);
            continue; } q -= I_BR;
        if (q < I_OUT) { const int kb = q / 32, nb = q % 32;
            if (OUT_F8) conv_item(P->w_out + (size_t)layer * 1024 * 1024 + 32 * nb + ln, 1024, nullptr, (bf16_t*)((unsigned char*)(ws + WB_WOUT) + (size_t)(32 * nb) * 1024), 1024, 64 * kb, scr, lane, 32.0f);
            else conv_item(P->w_out + (size_t)layer * 1024 * 1024 + 32 * nb + ln, 1024, nullptr, (bf16_t*)(ws + WB_WOUT) + (size_t)(32 * nb) * 1024, 1024, 64 * kb, scr, lane);
            continue; } q -= I_OUT;
        if (q < I_GU) { const int e = q / 512, qq = q % 512, kb = qq / 32, nb = qq % 32, n = 32 * nb + ln, jt = n >> 8, tc = n & 255;
            const float* src = (tc < 128 ? P->w_exp_gate : P->w_exp_up) + ((size_t)layer * NEXP + e) * 1024 * 512 + 128 * jt + (tc & 127);
            if (MOE_F8) conv_item(src, 512, nullptr, (bf16_t*)((unsigned char*)(ws + WB_WGU) + (size_t)(e * 1024 + 32 * nb) * 1024), 1024, 64 * kb, scr, lane, 32.0f);
            else conv_item(src, 512, nullptr, (bf16_t*)(ws + WB_WGU) + (size_t)(e * 1024 + 32 * nb) * 1024, 1024, 64 * kb, scr, lane);
            continue; } q -= I_GU;
        { const int e = q / 256, qq = q % 256, kb = qq / 32, nb = qq % 32;
            if (MOE_F8) conv_item(P->w_exp_down + ((size_t)layer * NEXP + e) * 512 * 1024 + 32 * nb + ln, 1024, nullptr, (bf16_t*)((unsigned char*)(ws + WB_WDN) + (size_t)(e * 1024 + 32 * nb) * 512), 512, 64 * kb, scr, lane, 32.0f);
            else conv_item(P->w_exp_down + ((size_t)layer * NEXP + e) * 512 * 1024 + 32 * nb + ln, 1024, nullptr, (bf16_t*)(ws + WB_WDN) + (size_t)(e * 1024 + 32 * nb) * 512, 512, 64 * kb, scr, lane); }
    }
}

__device__ __forceinline__ void prep_phase(KernArgP P, unsigned char* ws, LAS unsigned char* lds, int gw, int NGW, int wave, int lane) {
    const int gt = gw * 64 + lane, NGT = NGW * 64;
    for (int i = gt; i < 1024; i += NGT) ((unsigned*)(ws + WS_CNT))[i] = 0u;
    for (int i = gt; i < DEPTH * 2 * NT; i += NGT) ((u64*)(ws + WS_SSQ))[i] = 0ull;
    for (int i = gt; i < SEQ * 48; i += NGT) {
        const int t = i / 48, k = i % 48; const int half = (k < 32) ? 32 : 16, idx = (k < 32) ? k : k - 32;
        const float inv = (float)pow(10000.0, -(double)idx / (double)half); const float ang = (float)t * inv;
        f32x2 cs; cs.x = (float)cos((double)ang); cs.y = (float)sin((double)ang);
        if (k < 32) ((f32x2*)(ws + WS_CS64))[t * 32 + idx] = cs; else ((f32x2*)(ws + WS_CS32))[t * 16 + idx] = cs;
    }
    f32x4 vn[4];
    if (gw < NT) {
#pragma unroll
        for (int j = 0; j < 4; ++j) vn[j] = *(const f32x4*)(P->x + (size_t)gw * DM + 4 * lane + 256 * j);
    }
    for (int row = gw; row < NT; row += NGW) {
        f32x4 v[4];
#pragma unroll
        for (int j = 0; j < 4; ++j) v[j] = vn[j];
        if (row + NGW < NT) {
#pragma unroll
            for (int j = 0; j < 4; ++j) vn[j] = *(const f32x4*)(P->x + (size_t)(row + NGW) * DM + 4 * lane + 256 * j);
        }
        ln_rows(v, P->ln_in_g, P->ln_in_b, lane);
        store_row(v, nullptr, (bf16_t*)(ws + WS_XB) + (size_t)row * DM, lane, GATE_F8 ? (unsigned char*)(ws + R_XB8) + (size_t)row * DM : nullptr);
    }
}

__device__ __forceinline__ void ln1_router_phase(KernArgP P, unsigned char* ws, int layer, LAS unsigned char* lds, int gw, int NGW, int lane, int tid, int bid) {
    LAS float* WRT = (LAS float*)lds;
    LAS unsigned* LCNT = (LAS unsigned*)(lds + 65536);
    if (tid < 16) LCNT[tid] = 0u;
    for (int i = tid; i < 16 * 1024; i += 512) { const int d = i >> 4, e = i & 15; WRT[e * 1024 + d] = P->w_router[i]; }
    __syncthreads();
    f32x4 vn[4];
    if (gw < NT) {
#pragma unroll
        for (int j = 0; j < 4; ++j) vn[j] = *(const f32x4*)(P->out + (size_t)gw * DM + 4 * lane + 256 * j);
    }
    for (int row = gw; row < NT; row += NGW) {
        f32x4 v[4];
#pragma unroll
        for (int j = 0; j < 4; ++j) v[j] = vn[j];
        if (row + NGW < NT) {
#pragma unroll
            for (int j = 0; j < 4; ++j) vn[j] = *(const f32x4*)(P->out + (size_t)(row + NGW) * DM + 4 * lane + 256 * j);
        }
        float pe[16];
#pragma unroll
        for (int e = 0; e < 16; ++e) { float a = 0.f;
#pragma unroll
            for (int j = 0; j < 4; ++j) { const f32x4 wv = *(const LAS f32x4*)(WRT + e * 1024 + 4 * lane + 256 * j); a += (v[j][0] * wv[0] + v[j][1] * wv[1]) + (v[j][2] * wv[2] + v[j][3] * wv[3]); }
            pe[e] = a; if ((e & 3) == 3) asm volatile("" ::: "memory"); }
        float r8[8], r4[4], r2[2], r1;
        { const bool hi = (lane & 32) != 0;
#pragma unroll
          for (int k = 0; k < 8; ++k) { const float keep = hi ? pe[k + 8] : pe[k], send = hi ? pe[k] : pe[k + 8]; r8[k] = keep + shx(send, 32, lane); } }
        { const bool hi = (lane & 16) != 0;
#pragma unroll
          for (int k = 0; k < 4; ++k) { const float keep = hi ? r8[k + 4] : r8[k], send = hi ? r8[k] : r8[k + 4]; r4[k] = keep + shx(send, 16, lane); } }
        { const bool hi = (lane & 8) != 0;
#pragma unroll
          for (int k = 0; k < 2; ++k) { const float keep = hi ? r4[k + 2] : r4[k], send = hi ? r4[k] : r4[k + 2]; r2[k] = keep + shx(send, 8, lane); } }
        { const bool hi = (lane & 4) != 0; const float keep = hi ? r2[1] : r2[0], send = hi ? r2[0] : r2[1]; r1 = keep + shx(send, 4, lane); }
        r1 += shx(r1, 2, lane); r1 += shx(r1, 1, lane);
        float lg[16];
#pragma unroll
        for (int e = 0; e < 16; ++e) lg[e] = __int_as_float(__builtin_amdgcn_readlane(__float_as_int(r1), 4 * e));
        float sco[16], bsd[16];
#pragma unroll
        for (int e = 0; e < 16; ++e) { sco[e] = __builtin_amdgcn_rcpf(1.0f + __builtin_amdgcn_exp2f(-lg[e] * 1.4426950408889634f)); bsd[e] = sco[e] + P->router_bias[e]; }
        float best_gs = -3.0e38f; int gsel = 0; int i1s = 0, i2s = 1; float w1s = 0.f, w2s = 0.f;
#pragma unroll
        for (int g = 0; g < 4; ++g) {
            int i1 = 0; float b1 = bsd[4 * g], s1 = sco[4 * g];
#pragma unroll
            for (int k = 1; k < 4; ++k) if (bsd[4 * g + k] > b1) { b1 = bsd[4 * g + k]; s1 = sco[4 * g + k]; i1 = k; }
            int i2 = -1; float b2 = -3.0e38f, s2 = 0.f;
#pragma unroll
            for (int k = 0; k < 4; ++k) if (k != i1 && bsd[4 * g + k] > b2) { b2 = bsd[4 * g + k]; s2 = sco[4 * g + k]; i2 = k; }
            const float gs = b1 + b2;
            if (gs > best_gs) { best_gs = gs; gsel = g; i1s = 4 * g + i1; i2s = 4 * g + i2; w1s = s1; w2s = s2; }
        }
        (void)gsel;
        if (lane == 0) {
            const float ws_ = w1s + w2s; const float wa = w1s / ws_, wb = w2s / ws_;
            const unsigned sl1 = __hip_atomic_fetch_add(LCNT + i1s, 1u, __ATOMIC_RELAXED, __HIP_MEMORY_SCOPE_WORKGROUP), sl2 = __hip_atomic_fetch_add(LCNT + i2s, 1u, __ATOMIC_RELAXED, __HIP_MEMORY_SCOPE_WORKGROUP);
            int* rt = (int*)(ws + WS_ROUTE) + (size_t)row * 6;
            rt[0] = i1s; rt[1] = i2s; rt[2] = (int)sl1; rt[3] = (int)sl2; ((float*)rt)[4] = wa; ((float*)rt)[5] = wb;
        }
    }
    __syncthreads();
    if (tid < 16) ((unsigned*)(ws + WS_WGCNT))[bid * 16 + tid] = LCNT[tid];
}
__device__ __forceinline__ void moe_tiles(const unsigned* CNT, int (&ts)[16], int (&cn)[16], int& ntiles) {
    int acc = 0;
#pragma unroll
    for (int e = 0; e < 16; ++e) { cn[e] = (int)__builtin_amdgcn_readfirstlane(CNT[e]); ts[e] = acc; acc += (cn[e] + 255) >> 8; }
    ntiles = acc;
}
__device__ __forceinline__ void gather_phase(unsigned char* ws, int layer, LAS unsigned char* lds, int gw, int NGW, int lane, int tid, int bid, int G) {
    LAS unsigned* RAW = (LAS unsigned*)lds;
    LAS unsigned* PART = RAW + 4096;
    LAS int* TS = (LAS int*)(PART + 1024);
    LAS int* CN = TS + 16;
    const unsigned* WGC = (const unsigned*)(ws + WS_WGCNT);
    for (int i = tid; i < 4096; i += 512) RAW[i] = (i < G * 16) ? WGC[i] : 0u;
    __syncthreads();
    { const int e = tid & 15, part = tid >> 4; unsigned tot = 0u, pre = 0u;
#pragma unroll
      for (int k = 0; k < 8; ++k) { const int b2 = part * 8 + k; const unsigned v = RAW[b2 * 16 + e]; tot += v; pre += (b2 < bid) ? v : 0u; }
      PART[part * 32 + e] = tot; PART[part * 32 + 16 + e] = pre; }
    __syncthreads();
    if (tid < 16) { unsigned tot = 0u, pre = 0u;
        for (int p2 = 0; p2 < 32; ++p2) { tot += PART[p2 * 32 + tid]; pre += PART[p2 * 32 + 16 + tid]; }
        CN[tid] = (int)tot; TS[tid] = (int)pre;
        if (bid == 0) ((unsigned*)(ws + WS_CNT))[layer * 16 + tid] = tot; }
    __syncthreads();
    int ts[16], cn[16];
    { int acc = 0;
#pragma unroll
      for (int e = 0; e < 16; ++e) { cn[e] = __builtin_amdgcn_readfirstlane(CN[e]); ts[e] = acc; acc += (cn[e] + 255) >> 8; } }
    __syncthreads();
    if (tid < 16) { int base = 0;
#pragma unroll
        for (int e = 0; e < 16; ++e) if (e == tid) base = 256 * ts[e];
        TS[tid] += base; }
    __syncthreads();
    int* ROWTOK = (int*)(ws + WS_ROWTOK); float* ROWW = (float*)(ws + WS_ROWW);
    if (NGW * 8 == NT) {
        int ev[8], sv[8]; float wv[8];
        if (lane < 2) {
#pragma unroll
            for (int k = 0; k < 8; ++k) { const int* rt = (const int*)(ws + WS_ROUTE) + (size_t)(gw + k * NGW) * 6; ev[k] = rt[lane]; sv[k] = rt[2 + lane]; wv[k] = ((const float*)rt)[4 + lane]; }
            __builtin_amdgcn_sched_barrier(0);
#pragma unroll
            for (int k = 0; k < 8; ++k) { const int row = TS[ev[k]] + sv[k]; ROWTOK[row] = 2 * (gw + k * NGW) + lane; ROWW[row] = wv[k]; }
        }
    } else
    for (int t = gw; t < NT; t += NGW) {
        if (lane < 2) { const int* rt = (const int*)(ws + WS_ROUTE) + (size_t)t * 6; const int e = rt[lane], slot = rt[2 + lane]; const int row = TS[e] + slot;
            ROWTOK[row] = 2 * t + lane; ROWW[row] = ((const float*)rt)[4 + lane]; }
    }
#pragma unroll
    for (int e = 0; e < 16; ++e) {
        const int tiles = (cn[e] + 255) >> 8;
        for (int pr = cn[e] + gw * 64 + lane; pr < 256 * tiles; pr += NGW * 64) { const int row = 256 * ts[e] + pr; ROWTOK[row] = -1; ROWW[row] = 0.f; }
    }
}
__device__ __forceinline__ void ln2_phase(KernArgP P, unsigned char* ws, int layer, int gw, int NGW, int lane, float* outp, bf16_t* xbp) { const bf16_t* Y2 = (const bf16_t*)(ws + R_Y2);
    u32x2 xn[4], y0n[4], y1n[4];
#define LN2_LOAD(ROW) do { _Pragma("unroll") for (int j = 0; j < 4; ++j) { xn[j] = *(const u32x2*)((const bf16_t*)(ws + WS_XB) + (size_t)(ROW) * DM + 4 * lane + 256 * j); \
        y0n[j] = *(const u32x2*)(Y2 + (size_t)(2 * (ROW)) * DM + 4 * lane + 256 * j); y1n[j] = *(const u32x2*)(Y2 + (size_t)(2 * (ROW) + 1) * DM + 4 * lane + 256 * j); } } while (0)
    if (gw < NT) LN2_LOAD(gw);
    for (int row = gw; row < NT; row += NGW) {
        f32x4 v[4];
#pragma unroll
        for (int j = 0; j < 4; ++j) {
            const u32x2 xw = xn[j]; const f32x4 x = {bf_lo(xw.x), bf_hi(xw.x), bf_lo(xw.y), bf_hi(xw.y)};
            const u32x2 y0 = y0n[j], y1 = y1n[j];
            v[j][0] = x[0] * ALPHA + (bf_lo(y0.x) + bf_lo(y1.x)); v[j][1] = x[1] * ALPHA + (bf_hi(y0.x) + bf_hi(y1.x));
            v[j][2] = x[2] * ALPHA + (bf_lo(y0.y) + bf_lo(y1.y)); v[j][3] = x[3] * ALPHA + (bf_hi(y0.y) + bf_hi(y1.y));
        }
        if (row + NGW < NT) LN2_LOAD(row + NGW);
        ln_rows(v, P->ln2_g + layer * DM, P->ln2_b + layer * DM, lane);
        store_row(v, outp ? outp + (size_t)row * DM : nullptr, xbp ? xbp + (size_t)row * DM : nullptr, lane, (GATE_F8 && xbp) ? (unsigned char*)(ws + R_XB8) + (size_t)row * DM : nullptr);
    }
#undef LN2_LOAD
}
#ifndef XB_FLAT
#define XB_FLAT 1
#endif
#define XB_TMO      128
#define XB_XCNT(j)  (256  + 64 * (j))
#define XB_XSUB(j)  (1280 + 64 * (j))
#define XB_XGEN(j)  (2304 + 64 * (j))
#define XB_TOP      3328
#define XB_TOPGEN   3392
#define XCD_BAR_WORDS 3456
#define XB_SPIN_CAP (1u << 18)
__device__ __forceinline__ unsigned xb_ld(unsigned* p)              { return __hip_atomic_load(p, __ATOMIC_RELAXED, __HIP_MEMORY_SCOPE_AGENT); }
__device__ __forceinline__ unsigned xb_add(unsigned* p, unsigned v) { return __hip_atomic_fetch_add(p, v, __ATOMIC_RELAXED, __HIP_MEMORY_SCOPE_AGENT); }
__device__ __forceinline__ unsigned xb_xcc_id() { return (unsigned)__builtin_amdgcn_s_getreg((3 << 11) | 20) & 0xFu; }
#define XB_SPIN(cond, bar) do { unsigned _sp = 0; while (cond) { __builtin_amdgcn_s_sleep(1); \
    if ((++_sp & 255u) == 0u) { if (xb_ld(&(bar)[XB_TMO])) break; if (_sp > XB_SPIN_CAP) { atomicAdd(&(bar)[XB_TMO], 1u); break; } } } } while (0)
struct XcdBarrier { unsigned* bar; unsigned x; volatile LAS unsigned* st; };
__device__ __forceinline__ XcdBarrier xcd_barrier_post(unsigned* bar, volatile LAS unsigned* st, int tid) {
    XcdBarrier b; b.bar = bar; b.x = xb_xcc_id(); b.st = st;
    if (tid == 0) (void)xb_add(&bar[XB_XCNT(b.x)], 1u);
    return b;
}
__device__ __forceinline__ void xcd_barrier_complete(unsigned* bar, unsigned x, unsigned G, unsigned& nloc, unsigned& nx) {
    unsigned sum, cnt, mine, sp = 0u;
    for (;;) {
        sum = 0u; cnt = 0u; mine = 0u;
#pragma unroll
        for (unsigned j = 0; j < 16; ++j) { const unsigned c = xb_ld(&bar[XB_XCNT(j)]); sum += c; cnt += (c > 0u) ? 1u : 0u; mine = (j == x) ? c : mine; }
        if (sum == G) break;
        __builtin_amdgcn_s_sleep(1);
        if ((++sp & 255u) == 0u) { if (xb_ld(&bar[XB_TMO])) break; if (sp > XB_SPIN_CAP) { atomicAdd(&bar[XB_TMO], 1u); break; } }
    }
    nloc = mine > 0u ? mine : 1u; nx = cnt > 0u ? cnt : 1u;
}
__device__ __forceinline__ void xcd_barrier(const XcdBarrier& b, int tid, unsigned G) {
    asm volatile("s_waitcnt vmcnt(0)" ::: "memory");
    __syncthreads();
    if (tid == 0) {
        unsigned* bar = b.bar;
        __builtin_amdgcn_s_waitcnt(0);
        unsigned nloc = b.st[0], nx = b.st[1];
        if (nloc == 0u) { xcd_barrier_complete(bar, b.x, G, nloc, nx); b.st[0] = nloc; b.st[1] = nx; }
        const unsigned old = xb_add(&bar[XB_XSUB(b.x)], 1u);
        const unsigned gen = old / nloc;
        if (old + 1u == (gen + 1u) * nloc) {
            __builtin_amdgcn_fence(__ATOMIC_RELEASE, "agent");
            asm volatile("s_waitcnt vmcnt(0)" ::: "memory");
            const unsigned og = xb_add(&bar[XB_TOP], 1u);
            const unsigned tg = og / nx;
            if (og + 1u == (tg + 1u) * nx) xb_add(&bar[XB_TOPGEN], 1u);
            else XB_SPIN(xb_ld(&bar[XB_TOPGEN]) == tg, bar);
            __builtin_amdgcn_fence(__ATOMIC_ACQUIRE, "agent");
            if (!XB_FLAT) xb_add(&bar[XB_XGEN(b.x)], 1u);
            asm volatile("s_waitcnt vmcnt(0)" ::: "memory");
        } else {
            if (XB_FLAT) XB_SPIN(xb_ld(&bar[XB_TOPGEN]) == gen, bar);
            else XB_SPIN(xb_ld(&bar[XB_XGEN(b.x)]) == gen, bar);
            __builtin_amdgcn_fence(__ATOMIC_ACQUIRE, "agent");
            asm volatile("s_waitcnt vmcnt(0)" ::: "memory");
        }
    }
    __syncthreads();
}
#define PHASE_BEGIN() int lane; asm volatile("v_mbcnt_lo_u32_b32 %0, -1, 0\n\tv_mbcnt_hi_u32_b32 %0, -1, %0" : "=v"(lane)); int wave = wave0; asm volatile("" : "+s"(wave)); \
    const int tid = wave * 64 + lane; KernArgP kp_ = (KernArgP)__builtin_amdgcn_kernarg_segment_ptr(); asm volatile("" : "+s"(kp_)); KernArgP P = kp_;     \
    size_t z_ = 0; asm volatile("" : "+s"(z_)); unsigned char* ws = P->ws + z_; const int gw = bid * 8 + wave; int G = G0; asm volatile("" : "+s"(G)); const int NGW = G * 8; (void)tid; (void)gw; (void)NGW;
__global__ void __launch_bounds__(512, 2) mk_forward(Params Pkernarg) {
    extern __shared__ __attribute__((aligned(128))) unsigned char smem[];
    LAS unsigned char* lds = (LAS unsigned char*)smem;
    const int G0 = gridDim.x, bid = blockIdx.x, wave0 = __builtin_amdgcn_readfirstlane(threadIdx.x >> 6);
    XcdBarrier xbar;
    { PHASE_BEGIN(); volatile LAS unsigned* st = (volatile LAS unsigned*)(lds + LDS_MISC); if (tid < 2) st[tid] = 0u; __syncthreads();
      xbar = xcd_barrier_post((unsigned*)(ws + WS_BAR), st, tid); (void)xbar; }
#ifndef P2_SPLIT
#define P2_SPLIT 0
#endif
#ifndef GATE_F8MMA
#define GATE_F8MMA true
#endif
#ifndef CV_SPLIT
#define CV_SPLIT 0
#endif
#define GRID_BAR() do { PHASE_BEGIN(); XcdBarrier xb_; xb_.bar = (unsigned*)(ws + WS_BAR); xb_.x = xb_xcc_id(); xb_.st = (volatile LAS unsigned*)(lds + LDS_MISC); xcd_barrier(xb_, tid, (unsigned)G); } while (0)
    { PHASE_BEGIN(); prep_phase(P, ws, lds, gw, NGW, wave, lane); }
    { PHASE_BEGIN(); convert_phase(P, ws, 0, lds, gw, NGW, wave, lane); }
    for (int layer = 0; layer < DEPTH; ++layer) {
        if (G0 > 65535) cg::this_grid().sync();
        GRID_BAR();
        {
            PHASE_BEGIN();
            pg8::Gemm g{(const bf16_t*)(ws + WS_XB), (const bf16_t*)(ws + WB_W1), 1024, nullptr}; pg8::StaticOrder S; S.init(NT, 2816, G, bid);
            Epi1 E{ws, layer};
            pg8::gemm_phase<Epi1, pg8::StaticOrder, true, true>(lds, g, S, E, tid);
        }
#ifdef P1_PROBE_REPS
        if (layer == 1) {
#pragma unroll 1
            for (int rep_ = 0; rep_ < P1_PROBE_REPS; ++rep_) {
                PHASE_BEGIN();
                pg8::Gemm g{(const bf16_t*)(ws + WS_XB), (const bf16_t*)(ws + WB_W1), 1024, nullptr}; pg8::StaticOrder S; S.init(NT, 2816, G, bid);
                Epi1 E{ws, 0};
                pg8::gemm_phase<Epi1, pg8::StaticOrder, true, true>(lds, g, S, E, tid);
            }
        }
#endif
        GRID_BAR();
        {
#if P2_SPLIT
            { PHASE_BEGIN(); pg8::Gemm g{(const bf16_t*)(ws + R_KVLAT), (const bf16_t*)(ws + WB_WUKV), 256, nullptr}; SchedSub S; S.on = (G == 256) && bid < 128; S.S.init(NT, 1024, 128, bid & 127); EpiUKV E{ws, layer};
              if (G != 256) { S.on = true; S.S.init(NT, 1024, G, bid); }
              pg8::gemm_phase<EpiUKV, SchedSub, true, true>(lds, g, S, E, tid); }
            { PHASE_BEGIN(); pg8::Gemm g{(const bf16_t*)(ws + R_QLAT), (const bf16_t*)(ws + WB_WUQ), 384, nullptr}; SchedSub S; S.on = (G == 256) && bid >= 128 && bid < 224; S.S.init(NT, 768, 96, (bid - 128) & 127); EpiUQ E{ws, layer};
              if (G != 256) { S.on = true; S.S.init(NT, 768, G, bid); }
              pg8::gemm_phase<EpiUQ, SchedSub, true, true>(lds, g, S, E, tid); }
#else
            { PHASE_BEGIN(); pg8::Gemm g{(const bf16_t*)(ws + R_KVLAT), (const bf16_t*)(ws + WB_WUKV), 256, nullptr}; pg8::StaticOrder S; S.init(NT, 1024, G, bid); EpiUKV E{ws, layer};
              pg8::gemm_phase<EpiUKV, pg8::StaticOrder, true, true>(lds, g, S, E, tid); }
            { PHASE_BEGIN(); pg8::Gemm g{(const bf16_t*)(ws + R_QLAT), (const bf16_t*)(ws + WB_WUQ), 384, nullptr}; pg8::StaticOrder S; S.init(NT, 768, G, (bid + 64) % G); EpiUQ E{ws, layer};
              pg8::gemm_phase<EpiUQ, pg8::StaticOrder, true, true>(lds, g, S, E, tid); }
#endif
        }
        { PHASE_BEGIN(); __syncthreads(); indexer_phase(ws, lds, G, bid, wave, lane, tid); }
#ifdef IDX_PROBE_REPS
#pragma unroll 1
        for (int rep_ = 0; rep_ < IDX_PROBE_REPS; ++rep_) { PHASE_BEGIN(); __syncthreads(); indexer_phase(ws, lds, G, bid, wave, lane, tid); }
#endif
        GRID_BAR();
        { PHASE_BEGIN(); attention_phase2(ws, lds, P->c_sinks + layer * 8, G, bid, tid, wave, lane); }
#ifdef A5_PROBE_WHICH
#ifndef A5_PROBE_REPS
#define A5_PROBE_REPS 1
#endif
#pragma unroll 1
        for (int rep_ = 0; rep_ < A5_PROBE_REPS; ++rep_) { PHASE_BEGIN(); attention_phase2(ws, lds, P->c_sinks + layer * 8, G, bid, tid, wave, lane, A5_PROBE_WHICH, true); }
#endif
        GRID_BAR();
        {
            PHASE_BEGIN();
#if GATE_F8
            pg8::Gemm g{(const bf16_t*)(ws + R_XB8), (const bf16_t*)(ws + WB_WG), 512, nullptr}; SchedGate S; S.S.init(NT, 1024, G, bid);
            EpiGate E{(bf16_t*)(ws + R_GATES), 1.0f / 32.0f};
            pg8::gemm_phase<EpiGate, SchedGate, true, true, false, GATE_F8MMA>(lds, g, S, E, tid);
#else
            pg8::Gemm g{(const bf16_t*)(ws + WS_XB), (const bf16_t*)(ws + WB_WG), 1024, nullptr}; SchedGate S; S.S.init(NT, 1024, G, bid);
            EpiGate E{(bf16_t*)(ws + R_GATES)};
            pg8::gemm_phase<EpiGate, SchedGate, true, true>(lds, g, S, E, tid);
#endif
        }
#ifdef P5_PROBE_REPS
#pragma unroll 1
        for (int rep_ = 0; rep_ < P5_PROBE_REPS; ++rep_) {
            PHASE_BEGIN();
            pg8::Gemm g{(const bf16_t*)(ws + WS_XB), (const bf16_t*)(ws + WB_WG), 1024, nullptr}; SchedGate S; S.S.init(NT, 1024, G, bid);
            EpiGate E{(bf16_t*)(ws + R_GATES)};
            pg8::gemm_phase<EpiGate, SchedGate, true, true>(lds, g, S, E, tid);
        }
#endif
        {
            PHASE_BEGIN();
#if BR_F8
            pg8::Gemm g{(const bf16_t*)(ws + WS_OABC), (const bf16_t*)(ws + WB_WBR), 256, nullptr}; SchedBr S; S.S.init(NT, 1024, G, bid);
            EpiBr E{(const bf16_t*)(ws + R_GATES), (bf16_t*)(ws + R_MERGED), 1.0f / 512.0f, OUT_F8 != 0};
            pg8::gemm_phase<EpiBr, SchedBr, true, true, false, true>(lds, g, S, E, tid);
#else
            pg8::Gemm g{(const bf16_t*)(ws + WS_OABC), (const bf16_t*)(ws + WB_WBR), 512, nullptr}; SchedBr S; S.S.init(NT, 1024, G, bid);
            EpiBr E{(const bf16_t*)(ws + R_GATES), (bf16_t*)(ws + R_MERGED)};
            pg8::gemm_phase<EpiBr, SchedBr, true, true>(lds, g, S, E, tid);
#endif
        }
#ifdef P6_PROBE_REPS
#pragma unroll 1
        for (int rep_ = 0; rep_ < P6_PROBE_REPS; ++rep_)
        {
            PHASE_BEGIN();
            pg8::Gemm g{(const bf16_t*)(ws + WS_OABC), (const bf16_t*)(ws + WB_WBR), 512, nullptr}; SchedBr S; S.S.init(NT, 1024, G, bid);
            EpiBr E{(const bf16_t*)(ws + R_GATES), (bf16_t*)(ws + R_MERGED)};
            pg8::gemm_phase<EpiBr, SchedBr, true, true>(lds, g, S, E, tid);
        }
#endif
        GRID_BAR();
        {
            PHASE_BEGIN();
            pg8::Gemm g{(const bf16_t*)(ws + R_MERGED), (const bf16_t*)(ws + WB_WOUT), OUT_F8 ? 512 : 1024, nullptr}; pg8::StaticOrder S; S.init(NT, 1024, G, bid);
            PanelStats st{(u64*)(ws + WS_XBUF), (unsigned*)(ws + WS_PCNT) + layer * 4096, LN_EPS};
            EpiOutLn E{P->out, (bf16_t*)(ws + WS_XB), P->ln1_g + layer * DM, P->ln1_b + layer * DM, st, MOE_F8 ? (unsigned char*)(ws + R_XB8) : nullptr, OUT_F8 ? 1.0f / 512.0f : 1.0f};
            pg8::gemm_phase<EpiOutLn, pg8::StaticOrder, false, true, false, OUT_F8 != 0>(lds, g, S, E, tid);
        }
        GRID_BAR();
        { PHASE_BEGIN(); ln1_router_phase(P, ws, layer, lds, gw, NGW, lane, tid, bid); }
        GRID_BAR();
        { PHASE_BEGIN(); gather_phase(ws, layer, lds, gw, NGW, lane, tid, bid, G); }
        GRID_BAR();
        {
            PHASE_BEGIN();
            SchedMoE S; int cn[16]; moe_tiles((const unsigned*)(ws + WS_CNT) + layer * 16, S.ts, cn, S.ntiles); S.G = G; S.c = (G == 256) ? ((bid & 7) * 32 + (bid >> 3)) : bid; S.hrdy = (unsigned*)(ws + WS_HRDY) + layer * 144 * 64;
#if MOE_F8
            pg8::Gemm g{(const bf16_t*)(ws + R_XB8), (const bf16_t*)(ws + WB_WGU), 512, (const int*)(ws + WS_ROWTOK)}; EpiGU E{(const float*)(ws + WS_ROWW), (bf16_t*)(ws + WS_H), 1.0f / 32.0f, true};
            pg8::gemm_phase<EpiGU, SchedMoE, true, true, true, true>(lds, g, S, E, tid);
#else
            pg8::Gemm g{(const bf16_t*)(ws + WS_XB), (const bf16_t*)(ws + WB_WGU), 1024, (const int*)(ws + WS_ROWTOK)}; EpiGU E{(const float*)(ws + WS_ROWW), (bf16_t*)(ws + WS_H)};
            pg8::gemm_phase<EpiGU, SchedMoE, true, true, true>(lds, g, S, E, tid);
#endif
        }
        {
            PHASE_BEGIN();
            SchedMoEDown S; int cn[16]; moe_tiles((const unsigned*)(ws + WS_CNT) + layer * 16, S.ts, cn, S.ntiles); S.G = G; S.c = (G == 256) ? ((bid & 7) * 32 + (bid >> 3)) : bid; S.hrdy = (unsigned*)(ws + WS_HRDY) + layer * 144 * 64;
            { const int rem = (4 * S.ntiles) % G; S.nheavy = (rem > 0 && 4 * rem <= G) ? rem : 0; }
#if MOE_F8
            pg8::Gemm g{(const bf16_t*)(ws + WS_H), (const bf16_t*)(ws + WB_WDN), 256, nullptr}; EpiDN E{(const int*)(ws + WS_ROWTOK), (bf16_t*)(ws + R_Y2), 1.0f / 256.0f};
            pg8::gemm_phase<EpiDN, SchedMoEDown, true, true, false, true>(lds, g, S, E, tid);
#else
            pg8::Gemm g{(const bf16_t*)(ws + WS_H), (const bf16_t*)(ws + WB_WDN), 512, nullptr}; EpiDN E{(const int*)(ws + WS_ROWTOK), (bf16_t*)(ws + R_Y2)};
            pg8::gemm_phase<EpiDN, SchedMoEDown, true, true>(lds, g, S, E, tid);
#endif
        }
#ifdef MOE_PROBE_REPS
#pragma unroll 1
        for (int rep_ = 0; rep_ < MOE_PROBE_REPS; ++rep_) {
        {
            PHASE_BEGIN();
            SchedMoE S; int cn[16]; moe_tiles((const unsigned*)(ws + WS_CNT) + layer * 16, S.ts, cn, S.ntiles); S.G = G; S.c = (G == 256) ? ((bid & 7) * 32 + (bid >> 3)) : bid; S.hrdy = (unsigned*)(ws + WS_HRDY) + layer * 144 * 64;
            pg8::Gemm g{(const bf16_t*)(ws + WS_XB), (const bf16_t*)(ws + WB_WGU), 1024, (const int*)(ws + WS_ROWTOK)}; EpiGU E{(const float*)(ws + WS_ROWW), (bf16_t*)(ws + WS_H)};
            pg8::gemm_phase<EpiGU, SchedMoE, true, true, true>(lds, g, S, E, tid);
        }
        {
            PHASE_BEGIN();
            SchedMoEDown S; int cn[16]; moe_tiles((const unsigned*)(ws + WS_CNT) + layer * 16, S.ts, cn, S.ntiles); S.G = G; S.c = (G == 256) ? ((bid & 7) * 32 + (bid >> 3)) : bid; S.hrdy = (unsigned*)(ws + WS_HRDY) + layer * 144 * 64;
            { const int rem = (4 * S.ntiles) % G; S.nheavy = (rem > 0 && 4 * rem <= G) ? rem : 0; }
            pg8::Gemm g{(const bf16_t*)(ws + WS_H), (const bf16_t*)(ws + WB_WDN), 512, nullptr}; EpiDN E{(const int*)(ws + WS_ROWTOK), (bf16_t*)(ws + R_Y2)};
            pg8::gemm_phase<EpiDN, SchedMoEDown, true, true>(lds, g, S, E, tid);
        }
        }
#endif
        GRID_BAR();
        { PHASE_BEGIN(); ln2_phase(P, ws, layer, gw, NGW, lane, (layer + 1 == DEPTH) ? P->out : nullptr, (layer + 1 == DEPTH) ? nullptr : (bf16_t*)(ws + WS_XB)); }
        if (layer + 1 < DEPTH) { PHASE_BEGIN(); __syncthreads(); convert_phase(P, ws, layer + 1, lds, gw, NGW, wave, lane); }
    }
}

extern "C" void kernel_launch(void* const* d_in, const int* in_sizes, int n_in, void* d_out, int out_size, void* d_ws, size_t ws_size, hipStream_t stream) {
    static int grid_blocks = 0;
    if (grid_blocks == 0) {
        if (n_in != 22 || out_size != NT * DM || ws_size < WS_END) { fprintf(stderr, "kernel_launch: unexpected problem (n_in %d, out %d, ws %zu < %zu)\n", n_in, out_size, ws_size, (size_t)WS_END); grid_blocks = -1; return; }
        int dev = 0, cus = 0, per_cu = 0;
        (void)hipGetDevice(&dev);
        (void)hipDeviceGetAttribute(&cus, hipDeviceAttributeMultiprocessorCount, dev);
        (void)hipFuncSetAttribute((const void*)mk_forward, hipFuncAttributeMaxDynamicSharedMemorySize, LDS_BYTES);
        if (hipOccupancyMaxActiveBlocksPerMultiprocessor(&per_cu, (const void*)mk_forward, 512, LDS_BYTES) != hipSuccess || per_cu < 1) { fprintf(stderr, "kernel_launch: occupancy query says %d blocks per CU\n", per_cu); grid_blocks = -1; return; }
        grid_blocks = 256; if (cus < 256) { fprintf(stderr, "kernel_launch: needs 256 CUs (fused LayerNorm epilogue: one 256x256 unit per workgroup)\n"); grid_blocks = -1; return; }
    }
    if (grid_blocks < 0) return;
    if (hipMemsetAsync((char*)d_ws + WS_BAR, 0, WS_SSQ - WS_BAR, stream) != hipSuccess) { fprintf(stderr, "kernel_launch: memset of the barrier words failed\n"); return; }
    Params p{};
    p.x = (const float*)d_in[0]; p.ln_in_g = (const float*)d_in[1]; p.ln_in_b = (const float*)d_in[2]; p.w_in = (const float*)d_in[3];
    p.a_q_ln_g = (const float*)d_in[4]; p.a_kv_ln_g = (const float*)d_in[5]; p.a_w_uq = (const float*)d_in[6]; p.a_w_ukv = (const float*)d_in[7];
    p.c_sinks = (const float*)d_in[8]; p.w_br_a = (const float*)d_in[9]; p.w_br_b = (const float*)d_in[10]; p.w_br_c = (const float*)d_in[11];
    p.w_out = (const float*)d_in[12]; p.ln1_g = (const float*)d_in[13]; p.ln1_b = (const float*)d_in[14]; p.w_router = (const float*)d_in[15];
    p.router_bias = (const float*)d_in[16]; p.w_exp_gate = (const float*)d_in[17]; p.w_exp_up = (const float*)d_in[18]; p.w_exp_down = (const float*)d_in[19];
    p.ln2_g = (const float*)d_in[20]; p.ln2_b = (const float*)d_in[21];
    p.out = (float*)d_out; p.ws = (unsigned char*)d_ws;
    void* args[] = {&p};
    hipError_t e = hipLaunchCooperativeKernel((void*)mk_forward, dim3(grid_blocks), dim3(512), args, LDS_BYTES, stream);
    if (e != hipSuccess) fprintf(stderr, "kernel_launch: cooperative launch failed: %s (grid %d)\n", hipGetErrorString(e), grid_blocks);
}
```

```cpp
#include <hip/hip_runtime.h>
#include <hip/hip_cooperative_groups.h>
#include <cstdio>
#include <cstdint>
namespace cg = cooperative_groups;

#define LAS __attribute__((address_space(3)))
typedef unsigned short bf16_t;
typedef short bf16x8 __attribute__((ext_vector_type(8)));
typedef short s16x4 __attribute__((ext_vector_type(4)));
typedef float f32x2 __attribute__((ext_vector_type(2)));
typedef float f32x4 __attribute__((ext_vector_type(4)));
typedef float f32x16 __attribute__((ext_vector_type(16)));
typedef unsigned u32x2 __attribute__((ext_vector_type(2)));
typedef unsigned u32x4 __attribute__((ext_vector_type(4)));
typedef __bf16 bf2_t __attribute__((ext_vector_type(2)));
typedef unsigned long long u64;

constexpr int NT = 16384, SEQ = 2048, NB = 8, DM = 1024, INC = 5604, DEPTH = 2;
constexpr int NEXP = 16, DEXP = 512;
constexpr float ALPHA = 1.4142135623730951f;
constexpr float LN_EPS = 1e-5f, RMS_EPS = 1e-6f;
constexpr float LOG2E = 1.4426950408889634f;
constexpr float QS64 = 0.125f * LOG2E;
constexpr float QS96 = 0.10206207261596575f * LOG2E;
constexpr float SSQ_SCALE = 16777216.0f;
constexpr int XS_ROWS = 36864;

constexpr size_t al256(size_t x) { return (x + 255) & ~(size_t)255; }
constexpr size_t WS_CNT   = 0;
constexpr size_t WS_WGCNT = 1024;
constexpr size_t WS_BAR   = 17408;
constexpr size_t WS_PCNT  = 32768;
constexpr size_t WS_HRDY  = 65536;
constexpr size_t WS_CVQ   = 139264;
constexpr size_t WS_SSQ   = 147456;
constexpr size_t WS_CS64  = WS_SSQ + (size_t)DEPTH * 2 * NT * 8;
constexpr size_t WS_CS32  = WS_CS64 + (size_t)SEQ * 32 * 8;
constexpr size_t WS_ROUTE = WS_CS32 + (size_t)SEQ * 16 * 8;
constexpr size_t WS_ROWTOK = WS_ROUTE + (size_t)NT * 24;
constexpr size_t WS_ROWW  = WS_ROWTOK + (size_t)XS_ROWS * 4;
constexpr size_t WS_XBUF  = al256(WS_ROWW + (size_t)XS_ROWS * 4);
constexpr size_t WS_WB    = al256(WS_XBUF + (size_t)NT * 4 * 8);
constexpr size_t WB_W1   = WS_WB;
constexpr size_t WB_WG   = WB_W1 + (size_t)2816 * 1024 * 2;
constexpr size_t WB_WUQ  = WB_WG + (size_t)3072 * 1024 * 2;
constexpr size_t WB_WUKV = WB_WUQ + (size_t)768 * 384 * 2;
constexpr size_t WB_WBR  = WB_WUKV + (size_t)1024 * 256 * 2;
constexpr size_t WB_WOUT = WB_WBR + (size_t)3 * 1024 * 512 * 2;
constexpr size_t WB_WGU  = WB_WOUT + (size_t)1024 * 1024 * 2;
constexpr size_t WB_WDN  = WB_WGU + (size_t)16 * 1024 * 1024 * 2;
constexpr size_t WS_XB   = WB_WDN + (size_t)16 * 1024 * 512 * 2;
constexpr size_t WS_OABC = WS_XB + (size_t)NT * 1024 * 2;
constexpr size_t WS_R    = WS_OABC + (size_t)3 * NT * 512 * 2;
constexpr size_t R_QLAT  = WS_R;
constexpr size_t R_KVLAT = R_QLAT + (size_t)NT * 384 * 2;
constexpr size_t R_KPE   = R_KVLAT + (size_t)NT * 256 * 2;
constexpr size_t R_BQ    = R_KPE + (size_t)NT * 32 * 2;
constexpr size_t R_BK    = R_BQ + (size_t)NT * 512 * 2;
constexpr size_t R_BVT   = R_BK + (size_t)NT * 128 * 2;
constexpr size_t R_BQI   = R_BVT + (size_t)NT * 128 * 2;
constexpr size_t R_BKI   = R_BQI + (size_t)NT * 256 * 2;
constexpr size_t R_WIDX  = R_BKI + (size_t)NT * 64 * 2;
constexpr size_t R_CQ    = R_WIDX + (size_t)NT * 4 * 4;
constexpr size_t R_CK    = R_CQ + (size_t)NT * 512 * 2;
constexpr size_t R_CVT   = R_CK + (size_t)NT * 128 * 2;
constexpr size_t R_AQ    = R_CVT + (size_t)NT * 128 * 2;
constexpr size_t R_AKN   = R_AQ + (size_t)NT * 768 * 2;
constexpr size_t R_AVT   = R_AKN + (size_t)NT * 512 * 2;
constexpr size_t R_MASK  = R_AVT + (size_t)NT * 512 * 2;
constexpr size_t R_BV    = R_MASK + (size_t)NT * 64 * 4;
constexpr size_t R_CV    = R_BV + (size_t)NT * 128 * 2;
constexpr size_t R_AV    = R_CV + (size_t)NT * 128 * 2;
constexpr size_t R_XB8   = R_BV;
constexpr size_t R_END1  = R_AV + (size_t)NT * 512 * 2;
constexpr size_t R_GATES = WS_R;
constexpr size_t R_MERGED = R_GATES + (size_t)NT * 3072 * 2;
constexpr size_t R_END2  = R_MERGED + (size_t)NT * 1024 * 2;
constexpr size_t R_Y2    = WS_R;
constexpr size_t R_END3  = R_Y2 + (size_t)NT * 2 * 1024 * 2;
constexpr size_t WS_H    = WS_OABC;
constexpr size_t cmax(size_t a, size_t b) { return a > b ? a : b; }
constexpr size_t WS_END  = cmax(R_END1, cmax(R_END2, R_END3));
static_assert((size_t)XS_ROWS * 512 * 2 <= (size_t)3 * NT * 512 * 2, "H fits in OABC");
static_assert(WS_END <= (size_t)332 * 1024 * 1024, "workspace budget");
static_assert(R_XB8 >= R_END2 && R_XB8 >= R_END3 && R_XB8 + (size_t)NT * 1024 <= R_END1, "fp8 x copy placement");

constexpr int LDS_BYTES = 147456;
constexpr int LDS_MISC = 147456 - 64;

struct Params {
    const float* x; const float* ln_in_g; const float* ln_in_b; const float* w_in; const float* a_q_ln_g; const float* a_kv_ln_g;
    const float* a_w_uq; const float* a_w_ukv; const float* c_sinks; const float* w_br_a; const float* w_br_b; const float* w_br_c; const float* w_out;
    const float* ln1_g; const float* ln1_b; const float* w_router; const float* router_bias; const float* w_exp_gate; const float* w_exp_up; const float* w_exp_down;
    const float* ln2_g; const float* ln2_b;
    float* out; unsigned char* ws;
};

typedef const __attribute__((address_space(4))) Params* KernArgP;
__device__ __forceinline__ unsigned pk2(float lo, float hi) { f32x2 v = {lo, hi}; return __builtin_bit_cast(unsigned, __builtin_convertvector(v, bf2_t)); }
__device__ __forceinline__ float bf_lo(unsigned w) { return __uint_as_float(w << 16); }
__device__ __forceinline__ float bf_hi(unsigned w) { return __uint_as_float(w & 0xffff0000u); }
__device__ __forceinline__ float shx(float v, int mask, int lane) { return __int_as_float(__builtin_amdgcn_ds_bpermute((lane ^ mask) << 2, __float_as_int(v))); }
__device__ __forceinline__ unsigned shxu(unsigned v, int mask, int lane) { return (unsigned)__builtin_amdgcn_ds_bpermute((lane ^ mask) << 2, (int)v); }
__device__ __forceinline__ float wave_sum(float v, int lane) {
#pragma unroll
    for (int o = 1; o < 64; o <<= 1) v += shx(v, o, lane);
    return v;
}
template <class T> __device__ __forceinline__ T* uniform_ptr(T* p) {
    const unsigned long long v = (unsigned long long)p; const unsigned lo = __builtin_amdgcn_readfirstlane((unsigned)v), hi = __builtin_amdgcn_readfirstlane((unsigned)(v >> 32));
    return (T*)(((unsigned long long)hi << 32) | lo); }
__device__ __forceinline__ int f8x4(float a, float b, float c, float d) {
    a = __builtin_amdgcn_fmed3f(a, -440.0f, 440.0f); b = __builtin_amdgcn_fmed3f(b, -440.0f, 440.0f); c = __builtin_amdgcn_fmed3f(c, -440.0f, 440.0f); d = __builtin_amdgcn_fmed3f(d, -440.0f, 440.0f);
    int p = 0; p = __builtin_amdgcn_cvt_pk_fp8_f32(a, b, p, false); p = __builtin_amdgcn_cvt_pk_fp8_f32(c, d, p, true); return p; }
__device__ __forceinline__ float fast_sigmoid(float v) { return __builtin_amdgcn_rcpf(1.0f + __builtin_amdgcn_exp2f(-v * LOG2E)); }
namespace pg8 {
#ifndef PG8_PIN
#define PG8_PIN 1
#endif
#define PG8_LAS __attribute__((address_space(3)))
constexpr int BM = 256, BK = 64, HALF = 128, HTB = HALF * BK * 2, STAGE_BYTES = 8 * HTB, NXCD = 8, WGM = 8;
__host__ __device__ __forceinline__ int lds_byte(int r, int c) { const int st = (r >> 4) * 2 + (c >> 5), rr = r & 15, cc = c & 31, ob = rr * 64 + cc * 2; return st * 1024 + (ob ^ (((ob >> 9) & 1) << 5)); }
__host__ __device__ __forceinline__ void stage_rc(int b, int& R, int& C) { const int st = b / 1024, sb = b % 1024, swz = sb ^ (((sb >> 9) & 1) << 5); R = (st >> 1) * 16 + swz / 64; C = (st & 1) * 32 + (swz % 64) / 2; }
__host__ __device__ __forceinline__ int perm32(int rho) { const int n = rho >> 4, i = rho & 15; return 8 * (i >> 2) + 4 * n + (i & 3); }
struct Unit { int pm, pn; };
struct Gemm { const bf16_t* A; const bf16_t* Bt; int K; const int* rowmap; };
struct StaticOrder {
    int nM, nN, nwg, G, c;
    __device__ void init(int M, int N, int G_, int c_) { nM = M / BM; nN = N / BM; nwg = nM * nN; G = G_; c = c_; }
    __device__ bool next(int i, Unit& u) const {
        const long L = (long)i * G + c; if (L >= nwg) return false;
        int wgid = (int)L; { const int q = nwg / NXCD, r = nwg % NXCD, xcd = wgid % NXCD, off = wgid / NXCD; wgid = (xcd < r ? xcd * (q + 1) : r * (q + 1) + (xcd - r) * q) + off; }
        const int nig = WGM * nN, gid = wgid / nig, fm = gid * WGM, gsz = (nM - fm) < WGM ? (nM - fm) : WGM;
        u.pm = fm + ((wgid % nig) % gsz); u.pn = (wgid % nig) / gsz; return true;
    }
    __device__ __forceinline__ void a_ready(const Unit&, int) const {}
    __device__ __forceinline__ void done(const Unit&, int) const {}
};
template <class Epi, class Sched, bool ALIGN_EPI, bool SP2, bool GATHER = false, bool F8 = false, bool CONTIG = false>
__device__ __forceinline__ void gemm_phase(PG8_LAS unsigned char* lds, const Gemm g, const Sched& S, const Epi& E, const int tid) {
    const int wid = __builtin_amdgcn_readfirstlane(tid >> 6), lane = tid & 63, wr = wid >> 2, wc = wid & 3, fr = lane & 15, fq = lane >> 4;
    const int K = g.K, nt = K / BK;
    unsigned voffA[2], voffB[2];
#pragma unroll
    for (int i = 0; i < 2; ++i) { int R, C; stage_rc(tid * 16 + i * 8192, R, C); const int Rb = (CONTIG ? 64 * (R >> 5) : (R & ~31)) + perm32(R & 31);
        voffA[i] = (unsigned)(R * K + C) * 2u; voffB[i] = (unsigned)(Rb * K + C) * 2u; }
    unsigned cOff[2][2];
    PG8_LAS u32x4* nslot = (PG8_LAS u32x4*)(lds + STAGE_BYTES) + tid;
#define PG8_GOFF(U, OFF) do { const int* rm_ = g.rowmap + (U).pm * 256; _Pragma("unroll") for (int _h = 0; _h < 2; ++_h) _Pragma("unroll") for (int _i = 0; _i < 2; ++_i) { int R_, C_; stage_rc(tid * 16 + _i * 8192, R_, C_); \
        const int tk_ = rm_[128 * _h + R_]; const int tok_ = tk_ < 0 ? 0 : (tk_ >> 1); OFF[_h][_i] = (unsigned)(tok_ * K + C_) * 2u; } } while (0)
    const size_t kstep = (size_t)(BK * 2);
    const size_t hstep = (size_t)HALF * K * 2;
    const size_t tstep = 2 * hstep;
    const size_t hstepB = CONTIG ? (size_t)32 * K * 2 : hstep;
    const unsigned ldsw = (unsigned)wid * 1024u;
    const int aoff = lds_byte(wr * 64 + fr, fq * 8), boff = lds_byte(wc * 32 + fr, fq * 8);
#define PG8_SA(b, h) (((b) * 2 + (h)) * HTB)
#define PG8_SB(b, h) ((4 + (b) * 2 + (h)) * HTB)
#define PG8_STAGE(bufoff, gbase, voff) do { _Pragma("unroll") for (int _i = 0; _i < 2; ++_i) { unsigned vo_ = (voff)[_i]; if (F8 || PG8_PIN) asm volatile("" : "+v"(vo_));     \
        __builtin_amdgcn_global_load_lds((const unsigned*)(((F8 || PG8_PIN) ? uniform_ptr((const char*)(gbase)) : (const char*)(gbase)) + vo_), (PG8_LAS unsigned*)(lds + (bufoff) + ldsw + _i * 8192), 16, 0, 0); } } while (0)
#define PG8_LD8(p) __builtin_shufflevector(*(const PG8_LAS v4i32*)(p), *(const PG8_LAS v4i32*)((p) + 1024), 0, 1, 2, 3, 4, 5, 6, 7)
#define PG8_LDA(dst, b, h) do { if constexpr (F8) { _Pragma("unroll") for (int m = 0; m < 4; ++m) dst##8[m] = PG8_LD8(lds + PG8_SA(b, h) + aoff + m * 2048); } \
        else { _Pragma("unroll") for (int m = 0; m < 4; ++m) _Pragma("unroll") for (int k = 0; k < 2; ++k) dst[m][k] = *(const PG8_LAS bf16x8*)(lds + PG8_SA(b, h) + aoff + m * 2048 + k * 1024); } } while (0)
#define PG8_LDB(dst, b, h) do { if constexpr (F8) { _Pragma("unroll") for (int n = 0; n < 2; ++n) dst##8[n] = PG8_LD8(lds + PG8_SB(b, h) + boff + n * 2048); } \
        else { _Pragma("unroll") for (int n = 0; n < 2; ++n) _Pragma("unroll") for (int k = 0; k < 2; ++k) dst[n][k] = *(const PG8_LAS bf16x8*)(lds + PG8_SB(b, h) + boff + n * 2048 + k * 1024); } } while (0)
#define PG8_MMA(ai, bj, At, Bt) do { __builtin_amdgcn_s_setprio(1); _Pragma("unroll") for (int m = 0; m < 4; ++m) _Pragma("unroll") for (int n = 0; n < 2; ++n) { \
        if constexpr (F8) acc[ai][bj][m][n] = __builtin_amdgcn_mfma_scale_f32_16x16x128_f8f6f4(Bt##8[n], At##8[m], acc[ai][bj][m][n], 0, 0, 0, 0x7F7F7F7F, 0, 0x7F7F7F7F); \
        else { _Pragma("unroll") for (int k = 0; k < 2; ++k) acc[ai][bj][m][n] = __builtin_amdgcn_mfma_f32_16x16x32_bf16(Bt[n][k], At[m][k], acc[ai][bj][m][n], 0, 0, 0); } } \
        __builtin_amdgcn_s_setprio(0); } while (0)
#define PG8_WAIT_V(n) asm volatile("s_waitcnt vmcnt(" #n ")" ::: "memory")
#define PG8_WAIT_L(n) asm volatile("s_waitcnt lgkmcnt(" #n ")" ::: "memory")
#define PG8_BAR __builtin_amdgcn_s_barrier()
#define PG8_SCHED __builtin_amdgcn_sched_barrier(0)
    Unit cur, nxt; int ui = 0;
    if (!S.next(0, cur)) return;
    if constexpr (F8 || PG8_PIN) { cur.pm = __builtin_amdgcn_readfirstlane(cur.pm); cur.pn = __builtin_amdgcn_readfirstlane(cur.pn); }
    S.a_ready(cur, tid);
    f32x4 acc[2][2][4][2];
#pragma unroll
    for (int a = 0; a < 2; ++a)
#pragma unroll
        for (int b = 0; b < 2; ++b)
#pragma unroll
            for (int m = 0; m < 4; ++m)
#pragma unroll
                for (int n = 0; n < 2; ++n) {
                    if constexpr (F8) { float z0_, z1_, z2_, z3_; asm volatile("v_mov_b32 %0, 0\n\tv_mov_b32 %1, 0\n\tv_mov_b32 %2, 0\n\tv_mov_b32 %3, 0" : "=v"(z0_), "=v"(z1_), "=v"(z2_), "=v"(z3_)); acc[a][b][m][n] = (f32x4){z0_, z1_, z2_, z3_}; }
                    else acc[a][b][m][n] = (f32x4){0.f, 0.f, 0.f, 0.f}; }
    typedef int v8i32 __attribute__((ext_vector_type(8))); typedef int v4i32 __attribute__((ext_vector_type(4)));
    bf16x8 At[4][2], B0[2][2], B1[2][2]; v8i32 At8[4], B08[2], B18[2];
    const char* cA = GATHER ? (const char*)g.A : (const char*)g.A + (size_t)cur.pm * tstep; const char* cB = (const char*)g.Bt + (size_t)cur.pn * tstep;
    if constexpr (GATHER) { PG8_GOFF(cur, cOff); asm volatile("s_waitcnt vmcnt(0)" ::: "memory"); }
    if constexpr (SP2) {
        PG8_STAGE(PG8_SB(0, 0), cB, voffB); PG8_STAGE(PG8_SB(0, 1), cB + hstepB, voffB);
        if constexpr (GATHER) { PG8_STAGE(PG8_SA(0, 0), cA, cOff[0]); PG8_STAGE(PG8_SA(0, 1), cA, cOff[1]); } else { PG8_STAGE(PG8_SA(0, 0), cA, voffA); PG8_STAGE(PG8_SA(0, 1), cA + hstep, voffA); }
        if (wr == 1) PG8_BAR;
        PG8_WAIT_V(2); PG8_BAR;
        PG8_STAGE(PG8_SB(1, 0), cB + kstep, voffB); if constexpr (GATHER) PG8_STAGE(PG8_SA(1, 0), cA + kstep, cOff[0]); else PG8_STAGE(PG8_SA(1, 0), cA + kstep, voffA); PG8_STAGE(PG8_SB(1, 1), cB + hstepB + kstep, voffB);
        PG8_WAIT_V(6); PG8_BAR;
    } else {
        PG8_STAGE(PG8_SB(0, 0), cB, voffB); PG8_STAGE(PG8_SA(0, 0), cA, voffA); PG8_STAGE(PG8_SB(0, 1), cB + hstepB, voffB); PG8_STAGE(PG8_SA(0, 1), cA + hstep, voffA);
        if (wr == 1) PG8_BAR;
        PG8_WAIT_V(4); PG8_BAR;
        PG8_STAGE(PG8_SB(1, 0), cB + kstep, voffB); PG8_STAGE(PG8_SA(1, 0), cA + kstep, voffA); PG8_STAGE(PG8_SB(1, 1), cB + hstepB + kstep, voffB);
        PG8_WAIT_V(6); PG8_BAR;
    }
    for (;;) {
        const bool has_next = S.next(ui + 1, nxt);
        if constexpr (F8 || PG8_PIN) { nxt.pm = __builtin_amdgcn_readfirstlane(nxt.pm); nxt.pn = __builtin_amdgcn_readfirstlane(nxt.pn); }
        const char* nA = GATHER ? cA : (has_next ? (const char*)g.A + (size_t)nxt.pm * tstep : cA); const char* nB = has_next ? (const char*)g.Bt + (size_t)nxt.pn * tstep : cB;
        if constexpr (GATHER) { unsigned t_[2][2]; if (has_next) PG8_GOFF(nxt, t_); else { _Pragma("unroll") for (int _h = 0; _h < 2; ++_h) _Pragma("unroll") for (int _i = 0; _i < 2; ++_i) t_[_h][_i] = cOff[_h][_i]; }
            u32x4 pk_; pk_.x = t_[0][0]; pk_.y = t_[0][1]; pk_.z = t_[1][0]; pk_.w = t_[1][1]; *nslot = pk_; }
#pragma unroll 1
        for (int t = 0; t < nt; t += 2) {
            const bool last = (t == nt - 2);
            const char* a1 = cA + (size_t)(t + 1) * kstep;
            const char* a2 = last ? nA : cA + (size_t)(t + 2) * kstep; const char* b2 = last ? nB : cB + (size_t)(t + 2) * kstep;
            const char* a3 = a2 + kstep; const char* b3 = b2 + kstep;
            if (last && has_next) S.a_ready(nxt, tid);
            if constexpr (SP2 && GATHER) {
#define PG8_STAGE_SEL(bufoff, gbase, H) PG8_STAGE(bufoff, gbase, cOff[H])
            const char* g2 = last ? cA : cA + (size_t)(t + 2) * kstep; const char* g3 = g2 + kstep;
            PG8_LDB(B0, 0, 0); PG8_LDB(B1, 0, 1); PG8_SCHED; PG8_LDA(At, 0, 0); PG8_STAGE(PG8_SA(1, 1), a1, cOff[1]);
            if (last) { const u32x4 nf_ = *nslot; cOff[0][0] = nf_.x; cOff[0][1] = nf_.y; cOff[1][0] = nf_.z; cOff[1][1] = nf_.w; }
            PG8_WAIT_V(8); PG8_WAIT_L(0); PG8_BAR; PG8_MMA(0, 0, At, B0); PG8_MMA(0, 1, At, B1); PG8_BAR; PG8_SCHED;
            PG8_LDA(At, 0, 1); PG8_STAGE(PG8_SB(0, 0), b2, voffB); PG8_STAGE(PG8_SB(0, 1), b2 + hstepB, voffB); PG8_STAGE_SEL(PG8_SA(0, 0), g2, 0);
            PG8_WAIT_V(8); PG8_WAIT_L(0); PG8_BAR; PG8_MMA(1, 0, At, B0); PG8_MMA(1, 1, At, B1); PG8_BAR; PG8_SCHED;
            PG8_LDB(B0, 1, 0); PG8_LDB(B1, 1, 1); PG8_SCHED; PG8_LDA(At, 1, 0); PG8_STAGE_SEL(PG8_SA(0, 1), g2, 1);
            PG8_WAIT_V(8); PG8_WAIT_L(0); PG8_BAR; PG8_MMA(0, 0, At, B0); PG8_MMA(0, 1, At, B1); PG8_BAR; PG8_SCHED;
            PG8_LDA(At, 1, 1); PG8_STAGE(PG8_SB(1, 0), b3, voffB); PG8_STAGE(PG8_SB(1, 1), b3 + hstepB, voffB); PG8_STAGE_SEL(PG8_SA(1, 0), g3, 0);
            PG8_WAIT_V(8); PG8_WAIT_L(0); PG8_BAR; PG8_MMA(1, 0, At, B0); PG8_MMA(1, 1, At, B1); PG8_BAR; PG8_SCHED;
            } else             if constexpr (SP2) {
            PG8_LDB(B0, 0, 0); PG8_LDB(B1, 0, 1); PG8_SCHED; PG8_LDA(At, 0, 0); PG8_STAGE(PG8_SA(1, 1), a1 + hstep, voffA);
            PG8_WAIT_V(8); PG8_WAIT_L(0); PG8_BAR; PG8_MMA(0, 0, At, B0); PG8_MMA(0, 1, At, B1); PG8_BAR; PG8_SCHED;
            PG8_LDA(At, 0, 1); PG8_STAGE(PG8_SB(0, 0), b2, voffB); PG8_STAGE(PG8_SB(0, 1), b2 + hstepB, voffB); PG8_STAGE(PG8_SA(0, 0), a2, voffA);
            PG8_WAIT_V(8); PG8_WAIT_L(0); PG8_BAR; PG8_MMA(1, 0, At, B0); PG8_MMA(1, 1, At, B1); PG8_BAR; PG8_SCHED;
            PG8_LDB(B0, 1, 0); PG8_LDB(B1, 1, 1); PG8_SCHED; PG8_LDA(At, 1, 0); PG8_STAGE(PG8_SA(0, 1), a2 + hstep, voffA);
            PG8_WAIT_V(8); PG8_WAIT_L(0); PG8_BAR; PG8_MMA(0, 0, At, B0); PG8_MMA(0, 1, At, B1); PG8_BAR; PG8_SCHED;
            PG8_LDA(At, 1, 1); PG8_STAGE(PG8_SB(1, 0), b3, voffB); PG8_STAGE(PG8_SB(1, 1), b3 + hstepB, voffB); PG8_STAGE(PG8_SA(1, 0), a3, voffA);
            PG8_WAIT_V(8); PG8_WAIT_L(0); PG8_BAR; PG8_MMA(1, 0, At, B0); PG8_MMA(1, 1, At, B1); PG8_BAR; PG8_SCHED;
            } else {
            PG8_LDB(B0, 0, 0); PG8_SCHED; PG8_LDA(At, 0, 0); PG8_STAGE(PG8_SA(1, 1), a1 + hstep, voffA);
            PG8_WAIT_L(8); PG8_BAR; PG8_WAIT_L(0); PG8_MMA(0, 0, At, B0); PG8_BAR; PG8_SCHED;
            PG8_LDB(B1, 0, 1); PG8_STAGE(PG8_SB(0, 0), b2, voffB);
            PG8_BAR; PG8_WAIT_L(0); PG8_MMA(0, 1, At, B1); PG8_BAR;
            PG8_LDA(At, 0, 1); PG8_STAGE(PG8_SA(0, 0), a2, voffA);
            PG8_BAR; PG8_WAIT_L(0); PG8_MMA(1, 0, At, B0); PG8_BAR; PG8_SCHED;
            PG8_STAGE(PG8_SB(0, 1), b2 + hstepB, voffB);
            PG8_WAIT_V(6); PG8_BAR; PG8_MMA(1, 1, At, B1); PG8_BAR;
            PG8_LDB(B0, 1, 0); PG8_SCHED; PG8_LDA(At, 1, 0); PG8_STAGE(PG8_SA(0, 1), a2 + hstep, voffA);
            PG8_WAIT_L(8); PG8_BAR; PG8_WAIT_L(0); PG8_MMA(0, 0, At, B0); PG8_BAR; PG8_SCHED;
            PG8_LDB(B1, 1, 1); PG8_STAGE(PG8_SB(1, 0), b3, voffB);
            PG8_BAR; PG8_WAIT_L(0); PG8_MMA(0, 1, At, B1); PG8_BAR;
            PG8_LDA(At, 1, 1); PG8_STAGE(PG8_SA(1, 0), a3, voffA);
            PG8_BAR; PG8_WAIT_L(0); PG8_MMA(1, 0, At, B0); PG8_BAR; PG8_SCHED;
            PG8_STAGE(PG8_SB(1, 1), b3 + hstepB, voffB);
            PG8_WAIT_V(6); PG8_BAR; PG8_MMA(1, 1, At, B1); PG8_BAR;
            }
        }
        if constexpr (ALIGN_EPI) { if (wr == 0) PG8_BAR; }
        bool keep = false;
        if constexpr (!Epi::AFTER_DRAIN) { keep = E(acc, cur, wr, wc, fr, fq); S.done(cur, tid); }
        if (!has_next) break;
        if (!keep) {
#pragma unroll
        for (int a = 0; a < 2; ++a)
#pragma unroll
            for (int b = 0; b < 2; ++b)
#pragma unroll
                for (int m = 0; m < 4; ++m)
#pragma unroll
                    for (int n = 0; n < 2; ++n) {
                        if constexpr (F8) { float z0_, z1_, z2_, z3_; asm volatile("v_mov_b32 %0, 0\n\tv_mov_b32 %1, 0\n\tv_mov_b32 %2, 0\n\tv_mov_b32 %3, 0" : "=v"(z0_), "=v"(z1_), "=v"(z2_), "=v"(z3_));
                            acc[a][b][m][n] = (f32x4){z0_, z1_, z2_, z3_}; }
                        else acc[a][b][m][n] = (f32x4){0.f, 0.f, 0.f, 0.f}; }
        }
        cur = nxt; cA = nA; cB = nB; ++ui;
        if constexpr (ALIGN_EPI) { if (wr == 1) PG8_BAR; }
    }
    PG8_WAIT_V(0);
    if constexpr (!ALIGN_EPI) { if (wr == 0) PG8_BAR; }
    PG8_BAR;
    if constexpr (Epi::AFTER_DRAIN) E.fused(acc, cur, wr, wc, fr, fq, lds, wid, lane);
#undef PG8_GOFF
#undef PG8_STAGE_SEL
#undef PG8_SA
#undef PG8_SB
#undef PG8_STAGE
#undef PG8_LDA
#undef PG8_LD8
#undef PG8_LDB
#undef PG8_MMA
#undef PG8_WAIT_V
#undef PG8_WAIT_L
#undef PG8_BAR
#undef PG8_SCHED
}
}
using pg8::Unit;
#define EPI_ROWS(ai, m) (row0 + 128 * (ai) + 16 * (m))
#ifndef EPI_WT
#define EPI_WT 0
#endif
__device__ __forceinline__ void store8_bf16(bf16_t* p, const f32x4& a, const f32x4& b) {
    u32x4 w; w.x = pk2(a[0], a[1]); w.y = pk2(a[2], a[3]); w.z = pk2(b[0], b[1]); w.w = pk2(b[2], b[3]);
    if (EPI_WT) asm volatile("global_store_dwordx4 %0, %1, off sc1\n\ts_nop 1" :: "v"(p), "v"(w) : "memory"); else *(u32x4*)p = w;
}
__device__ __forceinline__ void rope8_store(const f32x4& a0, const f32x4& a1, const f32x4& b0, const f32x4& b1, const f32x4* cs, float sc, bf16_t* p1, bf16_t* p2) {
    const f32x4 c0 = cs[0], c1 = cs[1], c2 = cs[2], c3 = cs[3];
    f32x4 o1a, o1b, o2a, o2b;
    o1a[0] = (a0[0] * c0[0] - b0[0] * c0[1]) * sc; o2a[0] = (b0[0] * c0[0] + a0[0] * c0[1]) * sc;
    o1a[1] = (a0[1] * c0[2] - b0[1] * c0[3]) * sc; o2a[1] = (b0[1] * c0[2] + a0[1] * c0[3]) * sc;
    o1a[2] = (a0[2] * c1[0] - b0[2] * c1[1]) * sc; o2a[2] = (b0[2] * c1[0] + a0[2] * c1[1]) * sc;
    o1a[3] = (a0[3] * c1[2] - b0[3] * c1[3]) * sc; o2a[3] = (b0[3] * c1[2] + a0[3] * c1[3]) * sc;
    o1b[0] = (a1[0] * c2[0] - b1[0] * c2[1]) * sc; o2b[0] = (b1[0] * c2[0] + a1[0] * c2[1]) * sc;
    o1b[1] = (a1[1] * c2[2] - b1[1] * c2[3]) * sc; o2b[1] = (b1[1] * c2[2] + a1[1] * c2[3]) * sc;
    o1b[2] = (a1[2] * c3[0] - b1[2] * c3[1]) * sc; o2b[2] = (b1[2] * c3[0] + a1[2] * c3[1]) * sc;
    o1b[3] = (a1[3] * c3[2] - b1[3] * c3[3]) * sc; o2b[3] = (b1[3] * c3[2] + a1[3] * c3[3]) * sc;
    store8_bf16(p1, o1a, o1b); store8_bf16(p2, o2a, o2b);
}
__device__ __forceinline__ float sumsq8(const f32x4& a, const f32x4& b) { return (a[0] * a[0] + a[1] * a[1]) + (a[2] * a[2] + a[3] * a[3]) + (b[0] * b[0] + b[1] * b[1]) + (b[2] * b[2] + b[3] * b[3]); }
__device__ __forceinline__ void vt_store8(bf16_t* p  , const f32x4& a, const f32x4& b) {
    const unsigned w0 = pk2(a[0], a[1]), w1 = pk2(a[2], a[3]), w2 = pk2(b[0], b[1]), w3 = pk2(b[2], b[3]);
    p[0 * 64] = (bf16_t)w0; p[1 * 64] = (bf16_t)(w0 >> 16); p[2 * 64] = (bf16_t)w1; p[3 * 64] = (bf16_t)(w1 >> 16);
    p[4 * 64] = (bf16_t)w2; p[5 * 64] = (bf16_t)(w2 >> 16); p[6 * 64] = (bf16_t)w3; p[7 * 64] = (bf16_t)(w3 >> 16);
}

struct EpiNull {
    static constexpr bool AFTER_DRAIN = false;
    float* sink;
    __device__ __forceinline__ bool operator()(f32x4 (&acc)[2][2][4][2], const Unit&, int, int, int, int) const {
        f32x4 s = {0.f, 0.f, 0.f, 0.f};
#pragma unroll
        for (int a = 0; a < 2; ++a)
#pragma unroll
            for (int b = 0; b < 2; ++b)
#pragma unroll
                for (int m = 0; m < 4; ++m) { s = s + acc[a][b][m][0]; s = s + acc[a][b][m][1]; }
        if (s[0] + s[1] + s[2] + s[3] == 12345.678f) sink[0] = s[0];
        return false;
    }
};
struct Epi1 {
    static constexpr bool AFTER_DRAIN = false;
    unsigned char* ws; int layer; float asc = 1.0f;
    __device__ __forceinline__ bool operator()(f32x4 (&acc)[2][2][4][2], const Unit& u, int wr, int wc, int fr_in, int fq_in) const {
        (void)fr_in; (void)fq_in;
        int ln_; asm volatile("v_mbcnt_lo_u32_b32 %0, -1, 0\n\tv_mbcnt_hi_u32_b32 %0, -1, %0" : "=v"(ln_));
        const int fr = ln_ & 15, fq = ln_ >> 4;
        const int pn = u.pn, row0 = u.pm * 256 + wr * 64 + fr;
        if (pn <= 6) {
            bf16_t* dst; int ld, hc, half = 32; float sc = 1.f; bool valid = true;
            if (pn == 0)      { dst = (bf16_t*)(ws + R_BQ);  ld = 512; hc = 64 * wc;       sc = QS64; }
            else if (pn == 1) { dst = (bf16_t*)(ws + R_BQ);  ld = 512; hc = 64 * (4 + wc); sc = QS64; }
            else if (pn == 2) { dst = (bf16_t*)(ws + R_CQ);  ld = 512; hc = 64 * wc;       sc = QS64; }
            else if (pn == 3) { dst = (bf16_t*)(ws + R_CQ);  ld = 512; hc = 64 * (4 + wc); sc = QS64; }
            else if (pn == 4) { dst = (bf16_t*)(ws + R_BQI); ld = 256; hc = 64 * wc; }
            else if (pn == 5) { if (wc < 2) { dst = (bf16_t*)(ws + R_BK); ld = 128; hc = 64 * wc; } else { dst = (bf16_t*)(ws + R_CK); ld = 128; hc = 64 * (wc - 2); } }
            else { if (wc == 0) { dst = (bf16_t*)(ws + R_BKI); ld = 64; hc = 0; } else { dst = (bf16_t*)(ws + R_KPE); ld = 32; hc = 0; half = 16; valid = (wc == 1) && (fq < 2); } }
            sc *= asc;
            const f32x2* tab = (const f32x2*)(ws + (half == 32 ? WS_CS64 : WS_CS32));
            const int ci = (half == 32) ? 8 * fq : 8 * (fq & 1);
            if (valid) {
#pragma unroll
                for (int ai = 0; ai < 2; ++ai) {
                    f32x4 csv[4][4];
#pragma unroll
                    for (int m = 0; m < 4; ++m) { const int t = EPI_ROWS(ai, m) & (SEQ - 1); const f32x4* cs = (const f32x4*)(tab + (size_t)t * half + ci);
#pragma unroll
                        for (int q = 0; q < 4; ++q) csv[m][q] = cs[q]; }
                    __builtin_amdgcn_sched_barrier(0);
#pragma unroll
                    for (int m = 0; m < 4; ++m) {
                        const int r = EPI_ROWS(ai, m);
                        bf16_t* p = dst + (size_t)r * ld + hc + ci;
                        rope8_store(acc[ai][0][m][0], acc[ai][0][m][1], acc[ai][1][m][0], acc[ai][1][m][1], csv[m], sc, p, p + half);
                        asm volatile("" ::: "memory");
                    }
                }
            }
            return false;
        }
        u64* ssq = (u64*)(ws + WS_SSQ) + (size_t)layer * 2 * NT;
        bf16_t* QLAT = (bf16_t*)(ws + R_QLAT); bf16_t* KVLAT = (bf16_t*)(ws + R_KVLAT);
        const int c8 = 32 * wc + 8 * fq;
#pragma unroll
        for (int ai = 0; ai < 2; ++ai)
#pragma unroll
            for (int m = 0; m < 4; ++m) {
                const int r = EPI_ROWS(ai, m);
                const f32x4 v00 = acc[ai][0][m][0] * asc, v01 = acc[ai][0][m][1] * asc, v10 = acc[ai][1][m][0] * asc, v11 = acc[ai][1][m][1] * asc;
                if (pn == 7) {
                    store8_bf16(QLAT + (size_t)r * 384 + c8, v00, v01); store8_bf16(QLAT + (size_t)r * 384 + 128 + c8, v10, v11);
                    float ss = sumsq8(v00, v01) + sumsq8(v10, v11); ss += shx(ss, 16, fr + 16 * fq); ss += shx(ss, 32, fr + 16 * fq);
                    if (fq == 0) atomicAdd(ssq + r, (u64)(ss * SSQ_SCALE));
                } else if (pn == 8) {
                    store8_bf16(QLAT + (size_t)r * 384 + 256 + c8, v00, v01);
                    float ss = sumsq8(v00, v01); ss += shx(ss, 16, fr + 16 * fq); ss += shx(ss, 32, fr + 16 * fq);
                    if (fq == 0) atomicAdd(ssq + r, (u64)(ss * SSQ_SCALE));
                    vt_store8((bf16_t*)(ws + R_BVT) + ((size_t)(((r >> 11) * 2 + (c8 >> 6)) * 32 + ((r & 2047) >> 6)) * 64 + (c8 & 63)) * 64 + (r & 63), v10, v11);
                } else if (pn == 9) {
                    store8_bf16(KVLAT + (size_t)r * 256 + c8, v00, v01); store8_bf16(KVLAT + (size_t)r * 256 + 128 + c8, v10, v11);
                    float ss = sumsq8(v00, v01) + sumsq8(v10, v11); ss += shx(ss, 16, fr + 16 * fq); ss += shx(ss, 32, fr + 16 * fq);
                    if (fq == 0) atomicAdd(ssq + NT + r, (u64)(ss * SSQ_SCALE));
                } else {
                    vt_store8((bf16_t*)(ws + R_CVT) + ((size_t)(((r >> 11) * 2 + (c8 >> 6)) * 32 + ((r & 2047) >> 6)) * 64 + (c8 & 63)) * 64 + (r & 63), v00, v01);
                    if (wc == 0 && fq == 0) *(f32x4*)((float*)(ws + R_WIDX) + (size_t)r * 4) = v10 * 0.0625f;
                }
            }
        return false;
    }
};
#ifndef GATES_F8
#define GATES_F8 1
#endif
#ifndef GATES_EFORM
#define GATES_EFORM 1
#endif
#define F8DEC(w, i) __builtin_amdgcn_cvt_f32_fp8((int)(w), i)
#define F8DEC4(dst, w) f32x4 dst; { const f32x2 lo_ = __builtin_amdgcn_cvt_pk_f32_fp8((int)(w), false), hi_ = __builtin_amdgcn_cvt_pk_f32_fp8((int)(w), true); dst[0] = lo_.x; dst[1] = lo_.y; dst[2] = hi_.x; dst[3] = hi_.y; }
struct EpiGate {
    static constexpr bool AFTER_DRAIN = false;
    bf16_t* G; float osc = 1.0f;
    __device__ __forceinline__ bool operator()(f32x4 (&acc)[2][2][4][2], const Unit& u, int wr, int wc, int fr_in, int fq_in) const {
        (void)fr_in; (void)fq_in;
        int ln_; asm volatile("v_mbcnt_lo_u32_b32 %0, -1, 0\n\tv_mbcnt_hi_u32_b32 %0, -1, %0" : "=v"(ln_));
#if GATES_F8
        unsigned char* gb_ = (unsigned char*)G + (size_t)(((u.pm * 12 + u.pn) * 8 + wr * 4 + wc) * 8) * 1024 + ln_ * 16;
#pragma unroll
        for (int ai = 0; ai < 2; ++ai)
#pragma unroll
            for (int m = 0; m < 4; ++m) { u32x4 q;
#pragma unroll
                for (int bj = 0; bj < 2; ++bj) { f32x4 a = acc[ai][bj][m][0], b = acc[ai][bj][m][1];
                    const float ks = -LOG2E * osc;
#pragma unroll
#if GATES_EFORM
                    for (int e = 0; e < 4; ++e) { a[e] = fminf(0.015625f + __builtin_amdgcn_exp2f(__builtin_fmaf(a[e], ks, -6.0f)), 440.0f); b[e] = fminf(0.015625f + __builtin_amdgcn_exp2f(__builtin_fmaf(b[e], ks, -6.0f)), 440.0f); }
#else
                    for (int e = 0; e < 4; ++e) { a[e] = fmaxf(__builtin_amdgcn_rcpf(0.00390625f + __builtin_amdgcn_exp2f(__builtin_fmaf(a[e], ks, -8.0f))), 0.015625f); b[e] = fmaxf(__builtin_amdgcn_rcpf(0.00390625f + __builtin_amdgcn_exp2f(__builtin_fmaf(b[e], ks, -8.0f))), 0.015625f); }
#endif
                    int w0 = 0, w1 = 0; w0 = __builtin_amdgcn_cvt_pk_fp8_f32(a[0], a[1], w0, false); w0 = __builtin_amdgcn_cvt_pk_fp8_f32(a[2], a[3], w0, true); w1 = __builtin_amdgcn_cvt_pk_fp8_f32(b[0], b[1], w1, false); w1 = __builtin_amdgcn_cvt_pk_fp8_f32(b[2], b[3], w1, true);
                    if (bj == 0) { q.x = (unsigned)w0; q.y = (unsigned)w1; } else { q.z = (unsigned)w0; q.w = (unsigned)w1; } }
                *(u32x4*)(gb_ + (ai * 4 + m) * 1024) = q; __builtin_amdgcn_sched_barrier(0); }
#else
        const int fr = ln_ & 15, fq = ln_ >> 4;
        const int row0 = u.pm * 256 + wr * 64 + fr, col0 = u.pn * 256 + 32 * wc + 8 * fq;
#pragma unroll
        for (int ai = 0; ai < 2; ++ai)
#pragma unroll
            for (int m = 0; m < 4; ++m) { bf16_t* rp = G + (size_t)EPI_ROWS(ai, m) * 3072 + col0;
#pragma unroll
                for (int bj = 0; bj < 2; ++bj) { f32x4 a = acc[ai][bj][m][0], b = acc[ai][bj][m][1];
#pragma unroll
                    for (int e = 0; e < 4; ++e) { a[e] = fast_sigmoid(a[e] * osc); b[e] = fast_sigmoid(b[e] * osc); }
                    store8_bf16(rp + 128 * bj, a, b); } }
#endif
        return false;
    }
};
struct SchedSub {
    pg8::StaticOrder S; bool on;
    __device__ bool next(int i, Unit& u) const { return on && S.next(i, u); }
    __device__ __forceinline__ void a_ready(const Unit&, int) const {}
    __device__ __forceinline__ void done(const Unit&, int) const {}
};
struct EpiUQ {
    static constexpr bool AFTER_DRAIN = false;
    unsigned char* ws; int layer;
    __device__ __forceinline__ bool operator()(f32x4 (&acc)[2][2][4][2], const Unit& u, int wr, int wc, int fr, int fq) const {
        const int pn = u.pn, row0 = u.pm * 256 + wr * 64 + fr;
        const u64* ssq = (const u64*)(ws + WS_SSQ) + (size_t)layer * 2 * NT;
        bf16_t* AQ = (bf16_t*)(ws + R_AQ);
        u64 sv[2][4];
#pragma unroll
        for (int ai = 0; ai < 2; ++ai)
#pragma unroll
            for (int m = 0; m < 4; ++m) sv[ai][m] = ssq[EPI_ROWS(ai, m)];
        __builtin_amdgcn_sched_barrier(0);
        if (pn < 2) {
            const int d0 = 32 * (wc & 1) + 8 * fq, h0 = 4 * pn + (wc >> 1);
#pragma unroll
            for (int ai = 0; ai < 2; ++ai)
#pragma unroll
                for (int m = 0; m < 4; ++m) {
                    const int r = EPI_ROWS(ai, m);
                    const float rs = __builtin_amdgcn_rsqf((float)(unsigned)(sv[ai][m] >> 12) * (4096.0f / (SSQ_SCALE * 384.0f)) + RMS_EPS) * QS96;
                    bf16_t* p = AQ + (size_t)r * 768 + h0 * 96 + d0;
                    store8_bf16(p, acc[ai][0][m][0] * rs, acc[ai][0][m][1] * rs);
                    store8_bf16(p + 2 * 96, acc[ai][1][m][0] * rs, acc[ai][1][m][1] * rs);
                    asm volatile("" ::: "memory");
                }
        } else {
            const int head = 2 * wc + (fq >> 1), i0 = 8 * (fq & 1);
#pragma unroll
            for (int ai = 0; ai < 2; ++ai) {
                f32x4 csv[4][4];
#pragma unroll
                for (int m = 0; m < 4; ++m) { const int t = EPI_ROWS(ai, m) & (SEQ - 1); const f32x4* cs = (const f32x4*)((const f32x2*)(ws + WS_CS32) + (size_t)t * 16 + i0);
#pragma unroll
                    for (int q = 0; q < 4; ++q) csv[m][q] = cs[q]; }
                __builtin_amdgcn_sched_barrier(0);
#pragma unroll
                for (int m = 0; m < 4; ++m) {
                    const int r = EPI_ROWS(ai, m);
                    const float rs = __builtin_amdgcn_rsqf((float)(unsigned)(sv[ai][m] >> 12) * (4096.0f / (SSQ_SCALE * 384.0f)) + RMS_EPS) * QS96;
                    bf16_t* p = AQ + (size_t)r * 768 + head * 96 + 64 + i0;
                    rope8_store(acc[ai][0][m][0], acc[ai][0][m][1], acc[ai][1][m][0], acc[ai][1][m][1], csv[m], rs, p, p + 16);
                    asm volatile("" ::: "memory");
                }
            }
        }
        return false;
    }
};
struct EpiUKV {
    static constexpr bool AFTER_DRAIN = false;
    unsigned char* ws; int layer; bool nov = false;
    __device__ __forceinline__ bool operator()(f32x4 (&acc)[2][2][4][2], const Unit& u, int wr, int wc, int fr, int fq) const {
        const int pn = u.pn, row0 = u.pm * 256 + wr * 64 + fr, c8 = 32 * wc + 8 * fq;
        const u64* ssq = (const u64*)(ws + WS_SSQ) + (size_t)layer * 2 * NT + NT;
        u64 sv[2][4];
#pragma unroll
        for (int ai = 0; ai < 2; ++ai)
#pragma unroll
            for (int m = 0; m < 4; ++m) sv[ai][m] = ssq[EPI_ROWS(ai, m)];
        __builtin_amdgcn_sched_barrier(0);
#pragma unroll
        for (int ai = 0; ai < 2; ++ai)
#pragma unroll
            for (int m = 0; m < 4; ++m) {
                const int r = EPI_ROWS(ai, m);
                const float rs = __builtin_amdgcn_rsqf((float)(unsigned)(sv[ai][m] >> 12) * (4096.0f / (SSQ_SCALE * 256.0f)) + RMS_EPS);
#pragma unroll
                for (int bj = 0; bj < 2; ++bj) { const int tc = 128 * bj + c8;
                    if (pn < 2) store8_bf16((bf16_t*)(ws + R_AKN) + (size_t)r * 512 + 256 * pn + tc, acc[ai][bj][m][0] * rs, acc[ai][bj][m][1] * rs);
                    else if (!nov) vt_store8((bf16_t*)(ws + R_AVT) + ((size_t)(((r >> 11) * 8 + 4 * (pn - 2) + (tc >> 6)) * 32 + ((r & 2047) >> 6)) * 64 + (tc & 63)) * 64 + (r & 63), acc[ai][bj][m][0] * rs, acc[ai][bj][m][1] * rs); }
            }
        return false;
    }
};
struct EpiBr {
    static constexpr bool AFTER_DRAIN = false;
    const bf16_t* G; bf16_t* MERGED; float osc = 1.0f; bool m8 = false;
    __device__ __forceinline__ bool operator()(f32x4 (&acc)[2][2][4][2], const Unit& u, int wr, int wc, int fr_in, int fq_in) const {
        (void)fr_in; (void)fq_in;
        int ln_; asm volatile("v_mbcnt_lo_u32_b32 %0, -1, 0\n\tv_mbcnt_hi_u32_b32 %0, -1, %0" : "=v"(ln_));
        const int fr = ln_ & 15, fq = ln_ >> 4;
        int upm_ = u.pm, upn_ = u.pn; asm volatile("" : "+s"(upm_), "+s"(upn_));
        const int sub = upm_ >> 6, pm = upm_ & 63, pn = upn_ & 3;
        const int row0 = pm * 256 + wr * 64 + fr, col0 = pn * 256 + 32 * wc + 8 * fq;
#if GATES_F8
        const unsigned char* gp_ = (const unsigned char*)G + (size_t)(((pm * 12 + pn + 4 * sub) * 8 + wr * 4 + wc) * 8) * 1024 + ln_ * 16;
        u32x4 gv[2][4], hv[2][4];
#pragma unroll
        for (int ai = 0; ai < 2; ++ai)
#pragma unroll
            for (int m = 0; m < 4; ++m) { gv[ai][m] = *(const u32x4*)(gp_ + (ai * 4 + m) * 1024);
                if (sub < 2) hv[ai][m] = *(const u32x4*)(gp_ + 4 * 65536 + (ai * 4 + m) * 1024); else hv[ai][m] = gv[ai][m]; }
        __builtin_amdgcn_sched_barrier(0);
#pragma unroll
        for (int ai = 0; ai < 2; ++ai) {
#pragma unroll
            for (int m = 0; m < 4; ++m) { const int r = EPI_ROWS(ai, m);
#pragma unroll
                for (int bj = 0; bj < 2; ++bj) {
                    const unsigned g0 = bj ? gv[ai][m].z : gv[ai][m].x, g1 = bj ? gv[ai][m].w : gv[ai][m].y;
                    F8DEC4(ga, g0); F8DEC4(gb, g1);
                    if (sub < 2) {
                        const unsigned h0 = bj ? hv[ai][m].z : hv[ai][m].x, h1 = bj ? hv[ai][m].w : hv[ai][m].y;
                        F8DEC4(ha, h0); F8DEC4(hb, h1);
#pragma unroll
#if GATES_EFORM
                        for (int e = 0; e < 4; ++e) { ga[e] = ha[e] * __builtin_amdgcn_rcpf(ga[e]); gb[e] = hb[e] * __builtin_amdgcn_rcpf(gb[e]); }
#else
                        for (int e = 0; e < 4; ++e) { ga[e] = ga[e] * __builtin_amdgcn_rcpf(ha[e]); gb[e] = gb[e] * __builtin_amdgcn_rcpf(hb[e]); }
#endif
                        acc[ai][bj][m][0] = acc[ai][bj][m][0] * ga; acc[ai][bj][m][1] = acc[ai][bj][m][1] * gb;
                    } else {
#if GATES_EFORM
#pragma unroll
                        for (int e = 0; e < 4; ++e) { ga[e] = __builtin_amdgcn_rcpf(ga[e]); gb[e] = __builtin_amdgcn_rcpf(gb[e]); }
                        const float fs = m8 ? osc * (16.0f / 64.0f) : osc * (1.0f / 64.0f);
#else
                        const float fs = m8 ? osc * (16.0f / 256.0f) : osc * (1.0f / 256.0f);
#endif
                        if (m8) { const f32x4 ya = acc[ai][bj][m][0] * (ga * fs), yb = acc[ai][bj][m][1] * (gb * fs); u32x2 q8; q8.x = (unsigned)f8x4(ya[0], ya[1], ya[2], ya[3]); q8.y = (unsigned)f8x4(yb[0], yb[1], yb[2], yb[3]);
                            *(u32x2*)((unsigned char*)MERGED + (size_t)r * 1024 + col0 + 128 * bj) = q8; }
                        else store8_bf16(MERGED + (size_t)r * 1024 + col0 + 128 * bj, acc[ai][bj][m][0] * (ga * fs), acc[ai][bj][m][1] * (gb * fs));
                    }
                } }
            __builtin_amdgcn_sched_barrier(0);
        }
#else
#pragma unroll
        for (int ai = 0; ai < 2; ++ai) {
            u32x4 gv[4][2], hv[4][2];
#pragma unroll
            for (int m = 0; m < 4; ++m) { const int r = EPI_ROWS(ai, m);
#pragma unroll
                for (int bj = 0; bj < 2; ++bj) { gv[m][bj] = *(const u32x4*)(G + (size_t)r * 3072 + 1024 * sub + col0 + 128 * bj);
                    if (sub < 2) hv[m][bj] = *(const u32x4*)(G + (size_t)r * 3072 + 1024 * (sub + 1) + col0 + 128 * bj); else hv[m][bj] = gv[m][bj]; } }
            __builtin_amdgcn_sched_barrier(0);
#pragma unroll
            for (int m = 0; m < 4; ++m) { const int r = EPI_ROWS(ai, m);
#pragma unroll
                for (int bj = 0; bj < 2; ++bj) {
                    const u32x4 g = gv[m][bj];
                    f32x4 ga = {bf_lo(g.x), bf_hi(g.x), bf_lo(g.y), bf_hi(g.y)}, gb = {bf_lo(g.z), bf_hi(g.z), bf_lo(g.w), bf_hi(g.w)};
                    if (sub < 2) {
                        const u32x4 h = hv[m][bj];
                        const f32x4 ha = {bf_lo(h.x), bf_hi(h.x), bf_lo(h.y), bf_hi(h.y)}, hb = {bf_lo(h.z), bf_hi(h.z), bf_lo(h.w), bf_hi(h.w)};
#pragma unroll
                        for (int e = 0; e < 4; ++e) { ga[e] = ga[e] * __builtin_amdgcn_rcpf(ha[e]); gb[e] = gb[e] * __builtin_amdgcn_rcpf(hb[e]); }
                        acc[ai][bj][m][0] = acc[ai][bj][m][0] * ga; acc[ai][bj][m][1] = acc[ai][bj][m][1] * gb;
                    } else {
                        if (m8) { const f32x4 ya = acc[ai][bj][m][0] * (ga * (osc * 16.0f)), yb = acc[ai][bj][m][1] * (gb * (osc * 16.0f)); u32x2 q8; q8.x = (unsigned)f8x4(ya[0], ya[1], ya[2], ya[3]); q8.y = (unsigned)f8x4(yb[0], yb[1], yb[2], yb[3]);
                            *(u32x2*)((unsigned char*)MERGED + (size_t)r * 1024 + col0 + 128 * bj) = q8; }
                        else store8_bf16(MERGED + (size_t)r * 1024 + col0 + 128 * bj, acc[ai][bj][m][0] * (ga * osc), acc[ai][bj][m][1] * (gb * osc));
                    }
                } }
            __builtin_amdgcn_sched_barrier(0);
        }
#endif
        return sub < 2;
    }
};
struct SchedGate {
    pg8::StaticOrder S;
    __device__ bool next(int i, Unit& u) const { const int q = (i * 43) >> 7, sub = i - 3 * q; if (!S.next(q, u)) return false; u.pn += 4 * sub; return true; }
    __device__ __forceinline__ void a_ready(const Unit&, int) const {}
    __device__ __forceinline__ void done(const Unit&, int) const {}
};
struct SchedBr {
    pg8::StaticOrder S;
    __device__ bool next(int i, Unit& u) const { const int q = i / 3, sub = i - 3 * q; if (!S.next(q, u)) return false; u.pm += 64 * sub; u.pn += 4 * sub; return true; }
    __device__ __forceinline__ void a_ready(const Unit&, int) const {}
    __device__ __forceinline__ void done(const Unit&, int) const {}
};
struct EpiOut {
    static constexpr bool AFTER_DRAIN = false;
    const float* X; float* Z;
    __device__ __forceinline__ bool operator()(f32x4 (&acc)[2][2][4][2], const Unit& u, int wr, int wc, int fr, int fq) const {
        const int row0 = u.pm * 256 + wr * 64 + fr, col0 = u.pn * 256 + 32 * wc + 8 * fq;
#pragma unroll
        for (int ai = 0; ai < 2; ++ai)
#pragma unroll
            for (int m = 0; m < 4; ++m) { const size_t o = (size_t)EPI_ROWS(ai, m) * 1024 + col0;
#pragma unroll
                for (int bj = 0; bj < 2; ++bj) {
                    const f32x4 x0 = *(const f32x4*)(X + o + 128 * bj), x1 = *(const f32x4*)(X + o + 128 * bj + 4);
                    *(f32x4*)(Z + o + 128 * bj) = x0 * ALPHA + acc[ai][bj][m][0]; *(f32x4*)(Z + o + 128 * bj + 4) = x1 * ALPHA + acc[ai][bj][m][1]; }
                asm volatile("" ::: "memory"); }
        return false;
    }
};
struct PanelStats {
    u64* xbuf; unsigned* cnt; float eps;
    __device__ __forceinline__ void run(const f32x4 (&v)[2][2][4][2], const Unit& u, int wr, int wc, int fr, int fq, LAS unsigned char* lds, int wid, int lane) const {
        LAS f32x2* Pt = (LAS f32x2*)lds;
        LAS f32x2* St = (LAS f32x2*)(lds + 8192);
#pragma unroll
        for (int ai = 0; ai < 2; ++ai)
#pragma unroll
            for (int m = 0; m < 4; ++m) {
                float s = 0.f;
#pragma unroll
                for (int bj = 0; bj < 2; ++bj)
#pragma unroll
                    for (int n = 0; n < 2; ++n) { const f32x4 x = v[ai][bj][m][n]; s += (x[0] + x[1]) + (x[2] + x[3]); }
                s += shx(s, 16, lane); s += shx(s, 32, lane);
                const float mw = s * (1.0f / 64.0f); float q = 0.f;
#pragma unroll
                for (int bj = 0; bj < 2; ++bj)
#pragma unroll
                    for (int n = 0; n < 2; ++n) { const f32x4 d = v[ai][bj][m][n] - mw; q += (d[0] * d[0] + d[1] * d[1]) + (d[2] * d[2] + d[3] * d[3]); }
                q += shx(q, 16, lane); q += shx(q, 32, lane);
                if (fq == 0) Pt[(ai * 128 + wr * 64 + m * 16 + fr) * 4 + wc] = (f32x2){mw, q};
            }
        asm volatile("s_waitcnt lgkmcnt(0)" ::: "memory"); __builtin_amdgcn_s_barrier(); asm volatile("" ::: "memory");
        const int row = wid * 32 + (lane & 31);
        if (lane < 32) {
            const f32x2 a = Pt[row * 4 + 0], b = Pt[row * 4 + 1], c = Pt[row * 4 + 2], d = Pt[row * 4 + 3];
            const float mt = (a.x + b.x + c.x + d.x) * 0.25f;
            const float da = a.x - mt, db = b.x - mt, dc = c.x - mt, dd = d.x - mt;
            const float m2 = (a.y + b.y) + (c.y + d.y) + 64.0f * ((da * da + db * db) + (dc * dc + dd * dd));
            __hip_atomic_store(xbuf + ((size_t)(u.pm * 256 + row) * 4 + u.pn), ((u64)__float_as_uint(m2) << 32) | __float_as_uint(mt), __ATOMIC_RELAXED, __HIP_MEMORY_SCOPE_AGENT);
        }
        asm volatile("s_waitcnt vmcnt(0)" ::: "memory");
        if (lane == 0) __hip_atomic_fetch_add(cnt + 64 * u.pm, 1u, __ATOMIC_RELAXED, __HIP_MEMORY_SCOPE_AGENT);
        if (wid == 0) {
            unsigned spins = 0u;
            while ((unsigned)__builtin_amdgcn_readfirstlane(__hip_atomic_load(cnt + 64 * u.pm, __ATOMIC_RELAXED, __HIP_MEMORY_SCOPE_AGENT)) < 32u) { __builtin_amdgcn_s_sleep(2); if (++spins > (1u << 22)) break; }
            __builtin_amdgcn_fence(__ATOMIC_ACQUIRE, "agent");
        }
        asm volatile("s_waitcnt vmcnt(0) lgkmcnt(0)" ::: "memory"); __builtin_amdgcn_s_barrier(); asm volatile("" ::: "memory");
        if (lane < 32) {
            const u64* slot = xbuf + (size_t)(u.pm * 256 + row) * 4; float mt[4], m2[4]; float ms = 0.f;
#pragma unroll
            for (int t = 0; t < 4; ++t) { const u64 w = __hip_atomic_load(slot + t, __ATOMIC_RELAXED, __HIP_MEMORY_SCOPE_AGENT); mt[t] = __uint_as_float((unsigned)w); m2[t] = __uint_as_float((unsigned)(w >> 32)); ms += mt[t]; }
            const float mean = ms * 0.25f; float q = 0.f;
#pragma unroll
            for (int t = 0; t < 4; ++t) { const float dm = mt[t] - mean; q += m2[t] + 256.0f * dm * dm; }
            St[row] = (f32x2){mean, 1.0f / sqrtf(q * (1.0f / 1024.0f) + eps)};
        }
        asm volatile("s_waitcnt lgkmcnt(0)" ::: "memory"); __builtin_amdgcn_s_barrier(); asm volatile("" ::: "memory");
    }
};
#ifndef OUT_CONTIG
#define OUT_CONTIG 0
#endif
#ifndef X_HILO
#define X_HILO 1
#endif
struct EpiOutLn {
    static constexpr bool AFTER_DRAIN = true;
    float* X; bf16_t* XB; const float* g; const float* b; PanelStats st; unsigned char* XB8 = nullptr; float asc = 1.0f;
    __device__ __forceinline__ bool operator()(f32x4 (&)[2][2][4][2], const Unit&, int, int, int, int) const { return false; }
    __device__ __forceinline__ void fused(f32x4 (&acc)[2][2][4][2], const Unit& u, int wr, int wc, int fr_in, int fq_in, LAS unsigned char* lds, int wid, int lane_in) const {
        (void)fr_in; (void)fq_in; (void)lane_in;
        int lane; asm volatile("v_mbcnt_lo_u32_b32 %0, -1, 0\n\tv_mbcnt_hi_u32_b32 %0, -1, %0" : "=v"(lane));
        const int fr = lane & 15, fq = lane >> 4;
        constexpr int BJS = OUT_CONTIG ? 32 : 128;
        const int row0 = u.pm * 256 + wr * 64 + fr, col0 = u.pn * 256 + (OUT_CONTIG ? 64 : 32) * wc + 8 * fq;
        u32x4 xv[2][4][2];
#pragma unroll
        for (int ai = 0; ai < 2; ++ai)
#pragma unroll
            for (int m = 0; m < 4; ++m) { const size_t o = (size_t)EPI_ROWS(ai, m) * 1024 + col0;
#pragma unroll
                for (int bj = 0; bj < 2; ++bj) xv[ai][m][bj] = *(const u32x4*)(XB + o + BJS * bj); }
        __builtin_amdgcn_sched_barrier(0);
#pragma unroll
        for (int ai = 0; ai < 2; ++ai)
#pragma unroll
            for (int m = 0; m < 4; ++m) {
#pragma unroll
                for (int bj = 0; bj < 2; ++bj) { const u32x4 xw = xv[ai][m][bj];
                    const f32x4 xa = {bf_lo(xw.x), bf_hi(xw.x), bf_lo(xw.y), bf_hi(xw.y)}, xb2 = {bf_lo(xw.z), bf_hi(xw.z), bf_lo(xw.w), bf_hi(xw.w)};
                    acc[ai][bj][m][0] = xa * ALPHA + acc[ai][bj][m][0] * asc; acc[ai][bj][m][1] = xb2 * ALPHA + acc[ai][bj][m][1] * asc; }
                asm volatile("" : "+v"(acc[ai][0][m][0]), "+v"(acc[ai][0][m][1]), "+v"(acc[ai][1][m][0]), "+v"(acc[ai][1][m][1]));
                if (m & 1) asm volatile("" ::: "memory"); }
        f32x4 gg[2][2], bb[2][2];
#pragma unroll
        for (int bj = 0; bj < 2; ++bj)
#pragma unroll
            for (int n = 0; n < 2; ++n) { gg[bj][n] = *(const f32x4*)(g + col0 + BJS * bj + 4 * n); bb[bj][n] = *(const f32x4*)(b + col0 + BJS * bj + 4 * n); }
        __builtin_amdgcn_sched_barrier(0);
        st.run(acc, u, wr, wc, fr, fq, lds, wid, lane);
        const LAS f32x2* St = (const LAS f32x2*)(lds + 8192);
#pragma unroll
        for (int ai = 0; ai < 2; ++ai)
#pragma unroll
            for (int m = 0; m < 4; ++m) { const int rl = ai * 128 + wr * 64 + m * 16 + fr; const f32x2 sr = St[rl]; const size_t o = (size_t)(u.pm * 256 + rl) * 1024 + col0;
#pragma unroll
                for (int bj = 0; bj < 2; ++bj) { const f32x4 y0 = (acc[ai][bj][m][0] - sr.x) * sr.y * gg[bj][0] + bb[bj][0], y1 = (acc[ai][bj][m][1] - sr.x) * sr.y * gg[bj][1] + bb[bj][1];
#if X_HILO
                    { u32x4 hw; hw.x = pk2(y0[0], y0[1]); hw.y = pk2(y0[2], y0[3]); hw.z = pk2(y1[0], y1[1]); hw.w = pk2(y1[2], y1[3]);
                      u32x4 lw; lw.x = pk2(y0[0] - bf_lo(hw.x), y0[1] - bf_hi(hw.x)); lw.y = pk2(y0[2] - bf_lo(hw.y), y0[3] - bf_hi(hw.y)); lw.z = pk2(y1[0] - bf_lo(hw.z), y1[1] - bf_hi(hw.z)); lw.w = pk2(y1[2] - bf_lo(hw.w), y1[3] - bf_hi(hw.w));
                      *(u32x4*)(XB + o + BJS * bj) = hw; *(u32x4*)((bf16_t*)X + o + BJS * bj) = lw; }
#else
                    *(f32x4*)(X + o + BJS * bj) = y0; *(f32x4*)(X + o + BJS * bj + 4) = y1; store8_bf16(XB + o + BJS * bj, y0, y1);
#endif
                    if (XB8) { u32x2 q8; q8.x = (unsigned)f8x4(y0[0], y0[1], y0[2], y0[3]); q8.y = (unsigned)f8x4(y1[0], y1[1], y1[2], y1[3]); *(u32x2*)(XB8 + o + BJS * bj) = q8; } }
                asm volatile("" ::: "memory"); }
    }
};
struct SchedMoE {
    int ts[16]; int ntiles, G, c; unsigned* hrdy;
    __device__ bool next(int i, Unit& u) const {
        const int L = i * G + c; if (L >= 4 * ntiles) return false;
        const int tile = L >> 2, j = L & 3; int e = 0;
#pragma unroll
        for (int k = 1; k < 16; ++k) e += (tile >= ts[k]) ? 1 : 0;
        u.pm = tile; u.pn = 4 * e + j; return true;
    }
    __device__ __forceinline__ void a_ready(const Unit&, int) const {}
    __device__ __forceinline__ void done(const Unit& u, int tid) const {
        asm volatile("s_waitcnt vmcnt(0)" ::: "memory"); __builtin_amdgcn_s_barrier(); asm volatile("" ::: "memory");
        if (tid == 0) __hip_atomic_fetch_add(hrdy + 64 * u.pm, 1u, __ATOMIC_RELAXED, __HIP_MEMORY_SCOPE_AGENT);
    }
};
struct SchedMoEDown {
    int ts[16]; int ntiles, G, c, nheavy; unsigned* hrdy;
    __device__ bool next(int i, Unit& u) const {
        const int cc = c - nheavy; if (cc < 0) return false;
        const int L = i * (G - nheavy) + cc; if (L >= 4 * ntiles) return false;
        const int tile = L >> 2, j = L & 3; int e = 0;
#pragma unroll
        for (int k = 1; k < 16; ++k) e += (tile >= ts[k]) ? 1 : 0;
        u.pm = tile; u.pn = 4 * e + j; return true;
    }
    __device__ __forceinline__ void a_ready(const Unit& u, int tid) const {
        if (tid < 64) {
            unsigned spins = 0u;
            while ((unsigned)__builtin_amdgcn_readfirstlane(__hip_atomic_load(hrdy + 64 * u.pm, __ATOMIC_RELAXED, __HIP_MEMORY_SCOPE_AGENT)) < 4u) { __builtin_amdgcn_s_sleep(2); if (++spins > (1u << 22)) break; }
            __builtin_amdgcn_fence(__ATOMIC_ACQUIRE, "agent");
            asm volatile("s_waitcnt vmcnt(0)" ::: "memory");
        }
        asm volatile("" ::: "memory"); __builtin_amdgcn_s_barrier(); asm volatile("" ::: "memory");
    }
    __device__ __forceinline__ void done(const Unit&, int) const {}
};
__device__ __forceinline__ void store16_wt(void* p, const u32x4& v) {
    asm volatile("global_store_dwordx4 %0, %1, off sc1\n\ts_nop 1" :: "v"(p), "v"(v) : "memory");
}
struct EpiGU {
    static constexpr bool AFTER_DRAIN = false;
    const float* ROWW; bf16_t* H; float isc = 1.0f; bool f8 = false;
    __device__ __forceinline__ bool operator()(f32x4 (&acc)[2][2][4][2], const Unit& u, int wr, int wc, int fr_in, int fq_in) const {
        (void)fr_in; (void)fq_in;
        int ln_; asm volatile("v_mbcnt_lo_u32_b32 %0, -1, 0\n\tv_mbcnt_hi_u32_b32 %0, -1, %0" : "=v"(ln_));
        const int fr = ln_ & 15, fq = ln_ >> 4;
        const int row0 = u.pm * 256 + wr * 64 + fr, col0 = (u.pn & 3) * 128 + 32 * wc + 8 * fq;
        float wv[2][4];
#pragma unroll
        for (int ai = 0; ai < 2; ++ai)
#pragma unroll
            for (int m = 0; m < 4; ++m) wv[ai][m] = ROWW[EPI_ROWS(ai, m)];
        __builtin_amdgcn_sched_barrier(0);
#pragma unroll
        for (int ai = 0; ai < 2; ++ai)
#pragma unroll
            for (int m = 0; m < 4; ++m) { const int r = EPI_ROWS(ai, m); const float c2_ = wv[ai][m] * (f8 ? isc * isc * 8.0f : isc * isc), kx_ = -LOG2E * isc;
                f32x4 a = acc[ai][0][m][0], b = acc[ai][0][m][1]; const f32x4 ua = acc[ai][1][m][0], ub = acc[ai][1][m][1];
#pragma unroll
                for (int e = 0; e < 4; ++e) {
                    const float ra_ = __builtin_amdgcn_rcpf(1.0f + __builtin_amdgcn_exp2f(a[e] * kx_)), rb_ = __builtin_amdgcn_rcpf(1.0f + __builtin_amdgcn_exp2f(b[e] * kx_));
                    a[e] = (a[e] * ra_) * (ua[e] * c2_); b[e] = (b[e] * rb_) * (ub[e] * c2_); }
                if (f8) { u32x2 q8; q8.x = (unsigned)f8x4(a[0], a[1], a[2], a[3]); q8.y = (unsigned)f8x4(b[0], b[1], b[2], b[3]); asm volatile("global_store_dwordx2 %0, %1, off sc1\n\ts_nop 1" :: "v"((unsigned char*)H + (size_t)r * 512 + col0), "v"(q8) : "memory"); }
                else { u32x4 pk_; pk_.x = pk2(a[0], a[1]); pk_.y = pk2(a[2], a[3]); pk_.z = pk2(b[0], b[1]); pk_.w = pk2(b[2], b[3]); store16_wt(H + (size_t)r * 512 + col0, pk_); } }
        return false;
    }
};
#ifndef DN_CONTIG
#define DN_CONTIG 0
#endif
#ifndef Y2_F8
#define Y2_F8 1
#endif
#define Y2_SCALE 64.0f
struct EpiDN {
    static constexpr bool AFTER_DRAIN = false;
    const int* ROWTOK; bf16_t* Y2; float osc = 1.0f;
    __device__ __forceinline__ bool operator()(f32x4 (&acc)[2][2][4][2], const Unit& u, int wr, int wc, int fr_in, int fq_in) const {
        (void)fr_in; (void)fq_in;
        int ln_; asm volatile("v_mbcnt_lo_u32_b32 %0, -1, 0\n\tv_mbcnt_hi_u32_b32 %0, -1, %0" : "=v"(ln_));
        const int fr = ln_ & 15, fq = ln_ >> 4;
        constexpr int BJS = DN_CONTIG ? 32 : 128;
        const int row0 = u.pm * 256 + wr * 64 + fr, col0 = (u.pn & 3) * 256 + (DN_CONTIG ? 64 : 32) * wc + 8 * fq;
        int tkv[2][4];
#pragma unroll
        for (int ai = 0; ai < 2; ++ai)
#pragma unroll
            for (int m = 0; m < 4; ++m) tkv[ai][m] = ROWTOK[EPI_ROWS(ai, m)];
        __builtin_amdgcn_sched_barrier(0);
#pragma unroll
        for (int ai = 0; ai < 2; ++ai)
#pragma unroll
            for (int m = 0; m < 4; ++m) { const int tk = tkv[ai][m];
                if (tk >= 0) {
#pragma unroll
                    for (int bj = 0; bj < 2; ++bj) {
#if Y2_F8
                        const f32x4 ya = acc[ai][bj][m][0] * (osc * Y2_SCALE), yb = acc[ai][bj][m][1] * (osc * Y2_SCALE);
                        u32x2 q8; q8.x = (unsigned)f8x4(ya[0], ya[1], ya[2], ya[3]); q8.y = (unsigned)f8x4(yb[0], yb[1], yb[2], yb[3]);
                        *(u32x2*)((unsigned char*)Y2 + (size_t)tk * 1024 + col0 + BJS * bj) = q8;
#else
                        store8_bf16(Y2 + (size_t)tk * 1024 + col0 + BJS * bj, acc[ai][bj][m][0] * osc, acc[ai][bj][m][1] * osc);
#endif
                    } } }
        return false;
    }
};
#ifndef IDX_HEAD_FENCE
#define IDX_HEAD_FENCE 1
#endif
#define MFMA32(a, b, c) __builtin_amdgcn_mfma_f32_32x32x16_bf16((a), (b), (c), 0, 0, 0)
__device__ __forceinline__ constexpr int crow(int t, int h) { return (t & 3) + 8 * (t >> 2) + 4 * h; }
__device__ __forceinline__ bf16x8 pack8(const f32x16& x, int s) {
    u32x4 p; p.x = pk2(x[8 * s + 0], x[8 * s + 1]); p.y = pk2(x[8 * s + 2], x[8 * s + 3]); p.z = pk2(x[8 * s + 4], x[8 * s + 5]); p.w = pk2(x[8 * s + 6], x[8 * s + 7]);
    return __builtin_bit_cast(bf16x8, p);
}
template <int NKS, int MODE>
__device__ __forceinline__ void attn_item(const bf16_t* qrow, const bf16_t* k1, int ldk1, const bf16_t* k2, int ldk2, const bf16_t* vt,
                                          int kbeg, int kend, const unsigned* maskrow, float sink_l2, bf16_t* orow, int lane) {
    const int r = lane & 31, h = lane >> 5;
    bf16x8 qf[NKS];
#pragma unroll
    for (int ks = 0; ks < NKS; ++ks) qf[ks] = *(const bf16x8*)(qrow + 16 * ks + 8 * h);
    f32x16 o0, o1;
#pragma unroll
    for (int t = 0; t < 16; ++t) { o0[t] = 0.f; o1[t] = 0.f; }
    float m = -1e30f, l = 0.f;
    for (int kt = kbeg; kt < kend; kt += 64) {
        f32x16 s0, s1;
#pragma unroll
        for (int t = 0; t < 16; ++t) { s0[t] = 0.f; s1[t] = 0.f; }
#pragma unroll
        for (int ks = 0; ks < NKS; ++ks) {
            const bf16_t* kp = (ks < 4) ? (k1 + (size_t)(kt + r) * ldk1 + 16 * ks + 8 * h) : (k2 + (size_t)(kt + r) * ldk2 + 16 * (ks - 4) + 8 * h);
            const int ld = (ks < 4) ? ldk1 : ldk2;
            const bf16x8 a0 = *(const bf16x8*)kp, a1 = *(const bf16x8*)(kp + 32 * ld);
            s0 = MFMA32(a0, qf[ks], s0); s1 = MFMA32(a1, qf[ks], s1);
        }
        if (MODE == 1) {
            const unsigned w0 = maskrow[kt >> 5], w1 = maskrow[(kt >> 5) + 1];
#pragma unroll
            for (int t = 0; t < 16; ++t) { if (!((w0 >> crow(t, h)) & 1u)) s0[t] = -INFINITY; if (!((w1 >> crow(t, h)) & 1u)) s1[t] = -INFINITY; }
        }
        float mx = fmaxf(s0[0], s1[0]);
#pragma unroll
        for (int t = 1; t < 16; ++t) mx = fmaxf(mx, fmaxf(s0[t], s1[t]));
        mx = fmaxf(mx, shx(mx, 32, lane));
        const float mn = fmaxf(m, mx), alpha = __builtin_amdgcn_exp2f(m - mn); m = mn;
        float ps = 0.f;
#pragma unroll
        for (int t = 0; t < 16; ++t) { s0[t] = __builtin_amdgcn_exp2f(s0[t] - mn); s1[t] = __builtin_amdgcn_exp2f(s1[t] - mn); ps += s0[t] + s1[t]; }
        l = l * alpha + ps;
#pragma unroll
        for (int t = 0; t < 16; ++t) { o0[t] *= alpha; o1[t] *= alpha; }
        bf16x8 pb[4]; pb[0] = pack8(s0, 0); pb[1] = pack8(s0, 1); pb[2] = pack8(s1, 0); pb[3] = pack8(s1, 1);
#pragma unroll
        for (int s4 = 0; s4 < 4; ++s4) {
            const bf16_t* vp = vt + (size_t)r * SEQ + kt + 16 * s4 + 4 * h;
            const s16x4 lo0 = *(const s16x4*)vp, hi0 = *(const s16x4*)(vp + 8);
            const s16x4 lo1 = *(const s16x4*)(vp + 32 * SEQ), hi1 = *(const s16x4*)(vp + 32 * SEQ + 8);
            o0 = MFMA32(__builtin_shufflevector(lo0, hi0, 0, 1, 2, 3, 4, 5, 6, 7), pb[s4], o0);
            o1 = MFMA32(__builtin_shufflevector(lo1, hi1, 0, 1, 2, 3, 4, 5, 6, 7), pb[s4], o1);
        }
    }
    float lt = l + shx(l, 32, lane);
    if (MODE == 2) lt += __builtin_amdgcn_exp2f(sink_l2 - m);
    const float inv = 1.0f / lt;
#pragma unroll
    for (int g = 0; g < 4; ++g) {
        u32x2 w0, w1;
        w0.x = pk2(o0[4 * g] * inv, o0[4 * g + 1] * inv); w0.y = pk2(o0[4 * g + 2] * inv, o0[4 * g + 3] * inv);
        w1.x = pk2(o1[4 * g] * inv, o1[4 * g + 1] * inv); w1.y = pk2(o1[4 * g + 2] * inv, o1[4 * g + 3] * inv);
        *(u32x2*)(orow + 8 * g + 4 * h) = w0; *(u32x2*)(orow + 32 + 8 * g + 4 * h) = w1;
    }
}

__device__ __forceinline__ void attention_phase(unsigned char* ws, const float* sinks  , int G, int bid, int wave, int lane) {
    const int r = lane & 31;
    const bf16_t* AQ = (const bf16_t*)(ws + R_AQ); const bf16_t* AKN = (const bf16_t*)(ws + R_AKN); const bf16_t* KPE = (const bf16_t*)(ws + R_KPE); const bf16_t* AVT = (const bf16_t*)(ws + R_AVT);
    const bf16_t* BQ = (const bf16_t*)(ws + R_BQ); const bf16_t* BK = (const bf16_t*)(ws + R_BK); const bf16_t* BVT = (const bf16_t*)(ws + R_BVT); const unsigned* MASK = (const unsigned*)(ws + R_MASK);
    const bf16_t* CQ = (const bf16_t*)(ws + R_CQ); const bf16_t* CK = (const bf16_t*)(ws + R_CK); const bf16_t* CVT = (const bf16_t*)(ws + R_CVT);
    bf16_t* OA = (bf16_t*)(ws + WS_OABC); bf16_t* OB = OA + (size_t)NT * 512; bf16_t* OC = OB + (size_t)NT * 512;
    for (int j = bid; j < 256; j += G) {
        const int bh = j >> 2, b = bh >> 3, head = bh & 7, g = head >> 2, p = 8 * (j & 3) + wave;
        const size_t tb = (size_t)b * SEQ;
        for (int z = 0; z < 2; ++z) {
            const int qt = z ? 63 - p : p, c = qt >> 1, q0 = 32 * qt; const size_t qr = tb + q0 + r;
            attn_item<6, 0>(AQ + qr * 768 + head * 96, AKN + tb * 512 + head * 64, 512, KPE + tb * 32, 32, AVT + (size_t)(b * 8 + head) * 64 * SEQ,
                            0, 64 * (c + 1), nullptr, 0.f, OA + qr * 512 + head * 64, lane);
        }
        for (int z = 0; z < 2; ++z) {
            const int qt = z ? 63 - p : p, c = qt >> 1, q0 = 32 * qt; const size_t qr = tb + q0 + r;
            attn_item<4, 1>(BQ + qr * 512 + head * 64, BK + tb * 128 + g * 64, 128, nullptr, 0, BVT + (size_t)(b * 2 + g) * 64 * SEQ,
                            0, 64 * (c + 1), MASK + qr * 64, 0.f, OB + qr * 512 + head * 64, lane);
        }
        const float sink = sinks[head] * LOG2E;
        for (int z = 0; z < 2; ++z) {
            const int qt = z ? 63 - p : p, c = qt >> 1, q0 = 32 * qt; const size_t qr = tb + q0 + r;
            attn_item<4, 2>(CQ + qr * 512 + head * 64, CK + tb * 128 + g * 64, 128, nullptr, 0, CVT + (size_t)(b * 2 + g) * 64 * SEQ,
                            (c >= 2) ? 64 * (c - 2) : 0, 64 * (c + 1), nullptr, sink, OC + qr * 512 + head * 64, lane);
        }
    }
}

__device__ __forceinline__ void vt_item(const bf16_t* src  , int ld, bf16_t* dst  , LAS unsigned short* tile  , int lane) {
    const u32x4* sp = (const u32x4*)(src + (size_t)lane * ld);
#pragma unroll
    for (int c = 0; c < 8; ++c) { const u32x4 v = sp[c];
        tile[(8 * c + 0) * 72 + lane] = (unsigned short)v.x; tile[(8 * c + 1) * 72 + lane] = (unsigned short)(v.x >> 16);
        tile[(8 * c + 2) * 72 + lane] = (unsigned short)v.y; tile[(8 * c + 3) * 72 + lane] = (unsigned short)(v.y >> 16);
        tile[(8 * c + 4) * 72 + lane] = (unsigned short)v.z; tile[(8 * c + 5) * 72 + lane] = (unsigned short)(v.z >> 16);
        tile[(8 * c + 6) * 72 + lane] = (unsigned short)v.w; tile[(8 * c + 7) * 72 + lane] = (unsigned short)(v.w >> 16); }
    asm volatile("s_waitcnt lgkmcnt(0)" ::: "memory");
    u32x4* dp = (u32x4*)(dst + (size_t)lane * 64);
#pragma unroll
    for (int c = 0; c < 8; ++c) dp[c] = *(const LAS u32x4*)(tile + lane * 72 + 8 * c);
    asm volatile("s_waitcnt lgkmcnt(0)" ::: "memory");
}
__device__ __forceinline__ void vtranspose_phase(unsigned char* ws, LAS unsigned char* lds, int gw, int NGW, int wave, int lane) {
    LAS unsigned short* tile = (LAS unsigned short*)(lds + 4096 + wave * 9216);
    for (int it = gw; it < 3072; it += NGW) {
        if (it < 2048) { const int tt = it & 31, head = (it >> 5) & 7, b = it >> 8;
            vt_item((const bf16_t*)(ws + R_AV) + ((size_t)b * SEQ + 64 * tt) * 512 + 64 * head, 512, (bf16_t*)(ws + R_AVT) + (size_t)(b * 8 + head) * 64 * SEQ + 4096 * tt, tile, lane); }
        else { const int q = it - 2048, which = q >> 9, qq = q & 511, tt = qq & 31, g = (qq >> 5) & 1, b = qq >> 6;
            vt_item((const bf16_t*)(ws + (which ? R_CV : R_BV)) + ((size_t)b * SEQ + 64 * tt) * 128 + 64 * g, 128, (bf16_t*)(ws + (which ? R_CVT : R_BVT)) + (size_t)(b * 2 + g) * 64 * SEQ + 4096 * tt, tile, lane); }
    }
}

__device__ __forceinline__ unsigned sortable(float x) { const unsigned u = __float_as_uint(x + 0.0f); return (u & 0x80000000u) ? ~u : (u | 0x80000000u); }
__device__ __forceinline__ void indexer_phase(unsigned char* ws, LAS unsigned char* lds, int G, int bid, int w, int lane_in, int tid_in) {
    LAS unsigned* cntbuf = (LAS unsigned*)lds;
    LAS unsigned* runb = cntbuf + 512;
    const bf16_t* BQI = (const bf16_t*)(ws + R_BQI); const bf16_t* BKI = (const bf16_t*)(ws + R_BKI); const float* WIDX = (const float*)(ws + R_WIDX);
    unsigned* MASK = (unsigned*)(ws + R_MASK);
    for (int item = bid; item < 256; item += G) {
#pragma unroll 1
        for (int z = 0; z < 2; ++z) {
            int lane = lane_in; asm volatile("" : "+v"(lane));
            const int r = lane & 31, h = lane >> 5, tid = w * 64 + lane;
            const int b = item >> 5, qt = z ? 63 - (item & 31) : (item & 31), c = qt >> 1, q0 = 32 * qt, nsub = 2 * (c + 1);
            const size_t qr = (size_t)b * SEQ + q0 + r;
            unsigned* maskrow = MASK + qr * 64;
            if (c <= 3) {
                for (int st = w; st < nsub; st += 8) if (h == 0) maskrow[st] = 0xFFFFFFFFu;
                continue;
            }
            LAS unsigned char* QL = lds + 40960;
            const char* kbase = (const char*)(BKI + (size_t)b * SEQ * 64);
            const unsigned klane = ((unsigned)(32 * w + r) * 64u + 8u * h) * 2u;
            bf16x8 afn[4];
            f32x4 wq;
            { const int qq = tid >> 4, pc = tid & 15; const u32x4* src = (const u32x4*)(BQI + ((size_t)b * SEQ + q0 + qq) * 256 + 16 * pc);
              const u32x4 v0 = src[0], v1 = src[1];
              wq = *(const f32x4*)(WIDX + qr * 4);
              if (w < nsub) {
#pragma unroll
                  for (int ks = 0; ks < 4; ++ks) afn[ks] = *(const bf16x8*)(kbase + klane + 32 * ks);
              }
              *(LAS u32x4*)(QL + pc * 1024 + qq * 32) = v0; *(LAS u32x4*)(QL + pc * 1024 + qq * 32 + 16) = v1; }
            __syncthreads();
            unsigned key[8][16];
            const LAS unsigned char* qlr = QL + r * 32 + h * 16;
#pragma unroll
            for (int jj = 0; jj < 8; ++jj) {
                const int st = w + 8 * jj;
                if (st < nsub) {
                    bf16x8 af[4];
#pragma unroll
                    for (int ks = 0; ks < 4; ++ks) af[ks] = afn[ks];
                    if (jj < 7 && st + 8 < nsub) { const char* kp = kbase + (klane + (unsigned)(jj + 1) * 32768u);
#pragma unroll
                        for (int ks = 0; ks < 4; ++ks) afn[ks] = *(const bf16x8*)(kp + 32 * ks); }
                    f32x16 sc;
#pragma unroll
                    for (int t = 0; t < 16; ++t) sc[t] = 0.f;
#pragma unroll
                    for (int hh = 0; hh < 4; ++hh) {
                        f32x16 acc;
#pragma unroll
                        for (int t = 0; t < 16; ++t) acc[t] = 0.f;
#pragma unroll
                        for (int ks = 0; ks < 4; ++ks) acc = MFMA32(af[ks], *(const LAS bf16x8*)(qlr + (4 * hh + ks) * 1024), acc);
                        const float wh = wq[hh];
#pragma unroll
                        for (int t = 0; t < 16; ++t) sc[t] += wh * fmaxf(acc[t], 0.f);
                        if (IDX_HEAD_FENCE) asm volatile("" ::: "memory");
                    }
#pragma unroll
                    for (int t = 0; t < 16; ++t) key[jj][t] = sortable(sc[t]);
                } else {
#pragma unroll
                    for (int t = 0; t < 16; ++t) key[jj][t] = 0u;
                }
                asm volatile("" ::: "memory");
            }
            unsigned T = 0u, ge = 0u, gt = 0u;
            int par = 0;
            const int njj = (nsub - w + 7) >> 3;
#ifndef IDX_PACKED16
#define IDX_PACKED16 0
#endif
#ifndef IDX_EXTRA_SYNC
#define IDX_EXTRA_SYNC
#endif
#define IDX_COUNT_GE(CAND, TOT) do { unsigned cnt_ = 0u; \
                _Pragma("unroll") for (int jj = 0; jj < 8; ++jj) { if (jj < njj) { _Pragma("unroll") for (int t = 0; t < 16; ++t) cnt_ += (key[jj][t] >= (CAND)) ? 1u : 0u; } } \
                cnt_ += shxu(cnt_, 32, lane); LAS unsigned* buf_ = cntbuf + par * 256; par ^= 1; if (h == 0) buf_[w * 32 + r] = cnt_; __syncthreads(); \
                TOT = 0u; _Pragma("unroll") for (int ww = 0; ww < 8; ++ww) TOT += buf_[ww * 32 + r]; IDX_EXTRA_SYNC; } while (0)
            unsigned G = 0u;
#if IDX_PACKED16
            typedef short s16x2_t __attribute__((ext_vector_type(2))); typedef unsigned short u16x2_t __attribute__((ext_vector_type(2)));
            unsigned pk16[8][8];
#pragma unroll
            for (int jj = 0; jj < 8; ++jj)
#pragma unroll
                for (int p = 0; p < 8; ++p) pk16[jj][p] = (key[jj][2 * p] >> 17) | ((key[jj][2 * p + 1] >> 1) & 0x7FFF0000u);
#pragma unroll 1
            for (int bit = 31; bit >= 20; --bit) {
                const unsigned cand = T | (1u << bit); unsigned tot;
                const unsigned b1_ = cand >> 17, b2_ = b1_ | (b1_ << 16);
                u16x2_t lt_ = {0, 0};
#pragma unroll
                for (int jj = 0; jj < 8; ++jj) { if (jj < njj) {
#pragma unroll
                    for (int p = 0; p < 8; ++p) { const s16x2_t d_ = __builtin_bit_cast(s16x2_t, pk16[jj][p]) - __builtin_bit_cast(s16x2_t, b2_); lt_ += __builtin_bit_cast(u16x2_t, d_) >> (unsigned short)15; } } }
                const unsigned ltw_ = __builtin_bit_cast(unsigned, lt_);
                unsigned cnt_ = (unsigned)(16 * (njj > 0 ? njj : 0)) - ((ltw_ & 0xFFFFu) + (ltw_ >> 16));
                cnt_ += shxu(cnt_, 32, lane); LAS unsigned* buf_ = cntbuf + par * 256; par ^= 1; if (h == 0) buf_[w * 32 + r] = cnt_; __syncthreads();
                tot = 0u;
#pragma unroll
                for (int ww = 0; ww < 8; ++ww) tot += buf_[ww * 32 + r];
                if (tot >= 256u) { T = cand; ge = tot; } else G = tot;
            }
#else
#pragma unroll 1
            for (int bit = 31; bit >= 20; --bit) {
                const unsigned cand = T | (1u << bit); unsigned tot;
                IDX_COUNT_GE(cand, tot);
                if (tot >= 256u) { T = cand; ge = tot; } else G = tot;
            }
#endif
            const unsigned ncand = ge - G;
            const bool overflow = __builtin_amdgcn_ballot_w64(ncand > 256u) != 0ull;
            if (overflow) {
#pragma unroll 1
                for (int bit = 19; bit >= 0; --bit) {
                    const unsigned cand = T | (1u << bit); unsigned tot;
                    IDX_COUNT_GE(cand, tot);
                    if (tot >= 256u) { T = cand; ge = tot; }
                }
                unsigned tot; IDX_COUNT_GE(T + 1u, tot); gt = (T == 0xFFFFFFFFu) ? 0u : tot;
                __syncthreads();
            } else {
                LAS unsigned* clist = cntbuf + 1024;
                LAS unsigned* ccnt = clist + 8192;
                LAS unsigned* cres = ccnt + 32;
                __syncthreads();
                if (tid < 32) ccnt[tid] = 0u;
                if (w == 0 && h == 0) { cres[r * 4 + 0] = T; cres[r * 4 + 1] = G; }
                __syncthreads();
                {
#pragma unroll
                  for (int jj = 0; jj < 8; ++jj) { if (jj >= njj) continue;
                    unsigned pre = T >> 20; asm volatile("" : "+v"(pre));
#pragma unroll
                    for (int t = 0; t < 16; ++t) { const unsigned kv = key[jj][t];
                        if ((kv >> 20) == pre && kv != 0u) { const unsigned pos = __hip_atomic_fetch_add(ccnt + r, 1u, __ATOMIC_RELAXED, __HIP_MEMORY_SCOPE_WORKGROUP); clist[r * 256 + (pos & 255u)] = kv; } } } }
                __syncthreads();
                {
                    const int q = tid >> 4, s16 = tid & 15; const unsigned nq = ccnt[q]; unsigned Tq = cres[q * 4 + 0]; const unsigned Gq = cres[q * 4 + 1];
                    unsigned c[16];
#pragma unroll
                    for (int i = 0; i < 16; ++i) c[i] = ((unsigned)(16 * i + s16) < nq) ? clist[q * 256 + 16 * i + s16] : 0u;
#define IDX_ROW16_SUM(X) do { X += (unsigned)__builtin_amdgcn_update_dpp(0, (int)X, 0x128, 0xf, 0xf, false); X += (unsigned)__builtin_amdgcn_update_dpp(0, (int)X, 0x124, 0xf, 0xf, false); \
                        X += (unsigned)__builtin_amdgcn_update_dpp(0, (int)X, 0x122, 0xf, 0xf, false); X += (unsigned)__builtin_amdgcn_update_dpp(0, (int)X, 0x121, 0xf, 0xf, false); } while (0)
                    const unsigned nmax = max(max((unsigned)__builtin_amdgcn_readlane((int)nq, 0), (unsigned)__builtin_amdgcn_readlane((int)nq, 16)), max((unsigned)__builtin_amdgcn_readlane((int)nq, 32), (unsigned)__builtin_amdgcn_readlane((int)nq, 48)));
#define IDX_S2_ROUNDS(NI) do { _Pragma("unroll 1") for (int bit = 19; bit >= 0; --bit) { \
                        const unsigned cand = Tq | (1u << bit); unsigned cnt = 0u; \
                        _Pragma("unroll") for (int i = 0; i < (NI); ++i) cnt += (c[i] >= cand) ? 1u : 0u; \
                        IDX_ROW16_SUM(cnt); \
                        if (Gq + cnt >= 256u) Tq = cand; } } while (0)
                    if (nmax <= 64u) IDX_S2_ROUNDS(4); else if (nmax <= 128u) IDX_S2_ROUNDS(8); else IDX_S2_ROUNDS(16);
#undef IDX_S2_ROUNDS
                    unsigned cge = 0u, cgt = 0u;
#pragma unroll
                    for (int i = 0; i < 16; ++i) { cge += (c[i] >= Tq) ? 1u : 0u; cgt += (c[i] > Tq) ? 1u : 0u; }
                    IDX_ROW16_SUM(cge); IDX_ROW16_SUM(cgt);
                    if (s16 == 0) { cres[q * 4 + 0] = Tq; cres[q * 4 + 1] = Gq + cgt; cres[q * 4 + 2] = Gq + cge; }
                }
                __syncthreads();
                T = cres[r * 4 + 0]; gt = cres[r * 4 + 1]; ge = cres[r * 4 + 2];
                __syncthreads();
            }
            if (tid < 32) runb[tid] = 0u;
            __syncthreads();
#undef IDX_COUNT_GE
            const unsigned need = 256u - gt;
            asm volatile("" : "+v"(T));
            const bool anytie = __any(ge > 256u) != 0;
            unsigned idxT = 0xFFFFu; bool slow_ties = false;
            if (anytie) {
                LAS unsigned* clist = cntbuf + 1024; LAS unsigned* ccnt = clist + 8192; LAS unsigned* cres = ccnt + 32;
                __syncthreads();
                if (tid < 32) ccnt[tid] = 0u;
                if (w == 0 && h == 0) { cres[r * 4 + 1] = need; cres[r * 4 + 2] = ge; }
                __syncthreads();
#pragma unroll
                for (int jj = 0; jj < 8; ++jj) { if (jj >= njj) continue;
                    unsigned Tj = T; asm volatile("" : "+v"(Tj));
#pragma unroll
                    for (int t = 0; t < 16; ++t) { const unsigned kv = key[jj][t];
                        if (kv == Tj && kv != 0u) { const unsigned pos = __hip_atomic_fetch_add(ccnt + r, 1u, __ATOMIC_RELAXED, __HIP_MEMORY_SCOPE_WORKGROUP); if (pos < 256u) clist[r * 256 + pos] = (unsigned)(32 * (w + 8 * jj) + crow(t, h)); } } }
                __syncthreads();
                slow_ties = __builtin_amdgcn_ballot_w64(ge > 256u && ccnt[r] > 256u) != 0ull;
                if (!slow_ties) {
                    const int q = tid >> 4, s16 = tid & 15; const unsigned nq = ccnt[q], needq = cres[q * 4 + 1], geq = cres[q * 4 + 2];
                    unsigned c[16];
#pragma unroll
                    for (int i = 0; i < 16; ++i) c[i] = ((unsigned)(16 * i + s16) < nq) ? clist[q * 256 + 16 * i + s16] : 0xFFFFFFFFu;
                    unsigned cur = 0u;
#pragma unroll 1
                    for (int bit = 10; bit >= 0; --bit) {
                        const unsigned cand = cur | (1u << bit); unsigned cnt = 0u;
#pragma unroll
                        for (int i = 0; i < 16; ++i) cnt += (c[i] < cand) ? 1u : 0u;
                        IDX_ROW16_SUM(cnt);
                        if (cnt < needq) cur = cand;
                    }
                    if (s16 == 0) cres[q * 4 + 3] = (geq > 256u) ? cur : 0xFFFFu;
                    __syncthreads();
                    idxT = cres[r * 4 + 3];
                }
            }
#undef IDX_ROW16_SUM
            if (!slow_ties) {
#pragma unroll
                for (int jj = 0; jj < 8; ++jj) {
                    const int st = w + 8 * jj;
                    if (st < nsub) {
                        unsigned word = 0u;
#pragma unroll
                        for (int t = 0; t < 16; ++t) { const unsigned kv = key[jj][t]; const bool sel = (kv > T) || (kv == T && (unsigned)(32 * st + crow(t, h)) <= idxT);
                            word |= sel ? (1u << crow(t, h)) : 0u; }
                        word |= shxu(word, 32, lane);
                        if (h == 0) maskrow[st] = word;
                    }
                }
            } else {
#pragma unroll
                for (int jj = 0; jj < 8; ++jj) {
#pragma unroll 1
                    for (int ww = 0; ww < 8; ++ww) {
                        const int st = ww + 8 * jj;
                        if (st < nsub) {
                            if (w == ww) {
                                unsigned cg[4], pg[4];
#pragma unroll
                                for (int g4 = 0; g4 < 4; ++g4) { cg[g4] = 0u;
#pragma unroll
                                    for (int e = 0; e < 4; ++e) cg[g4] += (key[jj][4 * g4 + e] == T) ? 1u : 0u;
                                    pg[g4] = shxu(cg[g4], 32, lane); }
                                unsigned before = runb[r], word = 0u;
#pragma unroll
                                for (int g4 = 0; g4 < 4; ++g4) {
                                    unsigned rank = before + (h ? pg[g4] : 0u);
#pragma unroll
                                    for (int e = 0; e < 4; ++e) { const unsigned kv = key[jj][4 * g4 + e]; const bool eq = (kv == T);
                                        const bool sel = (kv > T) || (eq && rank < need); rank += eq ? 1u : 0u;
                                        word |= sel ? (1u << crow(4 * g4 + e, h)) : 0u; }
                                    before += cg[g4] + pg[g4];
                                }
                                word |= shxu(word, 32, lane);
                                if (h == 0) { maskrow[st] = word; runb[r] = before; }
                            }
                            __syncthreads();
                        }
                    }
                }
            }
            __syncthreads();
        }
    }
}
__device__ __forceinline__ float max3f(float a, float b, float c) { float r; asm("v_max3_f32 %0, %1, %2, %3" : "=v"(r) : "v"(a), "v"(b), "v"(c)); return r; }
__device__ __forceinline__ int pi32(int r) { return (r & ~12) | ((r & 4) << 1) | ((r & 8) >> 1); }
constexpr int AT_KPE = 8192, AT_VSLOT = 8192;
template <int MODE> struct AtMap { static constexpr int KSLOT = (MODE == 0) ? 12288 : 8192, VR = 4 * KSLOT, MASK = VR + 5 * AT_VSLOT; };
static_assert(AtMap<1>::MASK + 8 * 32 * 65 * 4 <= 147456 - 64 && AtMap<0>::MASK <= 147456 - 64, "attention LDS map");
template <int MODE>
__device__ __forceinline__ void attn_stage(LAS unsigned char* lds, int ks_, int vs_, const bf16_t* k1, int ldk1, const bf16_t* k2, const bf16_t* vt, int kt, unsigned voK, unsigned voV, unsigned voP, int wave) {
    const char* kb = (const char*)(k1 + (size_t)kt * ldk1); const char* vb = (const char*)(vt + (size_t)kt * 64);
    __builtin_amdgcn_global_load_lds((const unsigned*)(kb + voK), (LAS unsigned*)(lds + ks_ * AtMap<MODE>::KSLOT + wave * 1024), 16, 0, 0);
    __builtin_amdgcn_global_load_lds((const unsigned*)(vb + voV), (LAS unsigned*)(lds + AtMap<MODE>::VR + vs_ * AT_VSLOT + wave * 1024), 16, 0, 0);
    if (MODE == 0) { if (wave < 4) { const char* pb = (const char*)(k2 + (size_t)kt * 32);
        __builtin_amdgcn_global_load_lds((const unsigned*)(pb + voP), (LAS unsigned*)(lds + ks_ * AtMap<MODE>::KSLOT + AT_KPE + wave * 1024), 16, 0, 0); } }
}
template <int NKS, int MODE>
__device__ __forceinline__ void attn_wg_item(LAS unsigned char* lds, const bf16_t* qrow, const bf16_t* k1, int ldk1, const bf16_t* k2, const bf16_t* vt,
                                             int kt_begin, int kt_end, int my_end, const unsigned* maskrow, float sink_l2, bf16_t* orow, int tid, int wave, int lane) {
    const int r = lane & 31, h = lane >> 5, pr = pi32(r);
    bf16x8 qf[NKS];
#pragma unroll
    for (int ks = 0; ks < NKS; ++ks) qf[ks] = *(const bf16x8*)(qrow + 16 * ks + 8 * h);
#pragma unroll
    for (int ks = 0; ks < NKS; ++ks) asm volatile("" :: "v"(qf[ks]));
    f32x16 o0, o1, s0, s1;
#pragma unroll
    for (int t = 0; t < 16; ++t) { o0[t] = 0.f; o1[t] = 0.f; s0[t] = 0.f; s1[t] = 0.f; }
    float mref = 0.f, l = 0.f; bool init = false;
    const int kx0 = pr * 128, kx1 = (32 + pr) * 128, ksw = (pr >> 1) & 7;
    const int px0 = AT_KPE + pr * 64, px1 = AT_KPE + (32 + pr) * 64, psw = (pr >> 2) & 3;
    const int vx0 = AtMap<MODE>::VR + r * 128, vx1 = AtMap<MODE>::VR + (32 + r) * 128, vsw = (r >> 1) & 7;
    const bool skew = wave >= 4;
    __syncthreads();
    LAS unsigned* mrow = (LAS unsigned*)(lds + AtMap<MODE>::MASK) + (wave * 32 + r) * 65;
    if (MODE == 1) {
        LAS unsigned* mw = (LAS unsigned*)(lds + AtMap<MODE>::MASK) + (wave * 32) * 65;
        const unsigned* mg = maskrow;
        const int nw = my_end >> 5;
        const unsigned lo4 = (unsigned)lane * 4u;
        for (int q = 0; q < 32; ++q) { const char* mq = (const char*)(mg + (size_t)q * 64); if (lane < nw) mw[q * 65 + lane] = *(const unsigned*)(mq + lo4); }
        asm volatile("s_waitcnt vmcnt(0)" ::: "memory");
    }
    const int ntile = (kt_end - kt_begin) >> 6;
    unsigned voK, voV, voP;
    { const int row = tid >> 3, cp = tid & 7, c = cp ^ ((row >> 1) & 7); voK = (unsigned)(row * ldk1 + 8 * c) * 2u; voV = (unsigned)(row * 64 + 8 * c) * 2u;
      const int key = (tid & 255) >> 2, cq = tid & 3, cc = cq ^ ((key >> 2) & 3); voP = (unsigned)(key * 32 + 8 * cc) * 2u; }
    attn_stage<MODE>(lds, 0, 0, k1, ldk1, k2, vt, kt_begin, voK, voV, voP, wave);
    if (ntile > 1) attn_stage<MODE>(lds, 1, 1, k1, ldk1, k2, vt, kt_begin + 64, voK, voV, voP, wave);
    if (ntile > 2) attn_stage<MODE>(lds, 2, 2, k1, ldk1, k2, vt, kt_begin + 128, voK, voV, voP, wave);
#define AT_QK(KSL) do { const LAS unsigned char* B_ = lds + (KSL) * AtMap<MODE>::KSLOT; bf16x8 ka_[NKS], kb_[NKS]; \
        _Pragma("unroll") for (int ks = 0; ks < NKS; ++ks) { \
            if (ks < 4) { const int sw = ((2 * ks + h) ^ ksw) << 4; ka_[ks] = *(const LAS bf16x8*)(B_ + kx0 + sw); kb_[ks] = *(const LAS bf16x8*)(B_ + kx1 + sw); } \
            else { const int sw = ((2 * (ks - 4) + h) ^ psw) << 4; ka_[ks] = *(const LAS bf16x8*)(B_ + px0 + sw); kb_[ks] = *(const LAS bf16x8*)(B_ + px1 + sw); } } \
        __builtin_amdgcn_sched_barrier(0); \
        _Pragma("unroll") for (int t = 0; t < 16; ++t) { s0[t] = 0.f; s1[t] = 0.f; } \
        _Pragma("unroll") for (int ks = 0; ks < NKS; ++ks) { s0 = MFMA32(ka_[ks], qf[ks], s0); s1 = MFMA32(kb_[ks], qf[ks], s1); } \
        __builtin_amdgcn_sched_barrier(0); } while (0)
#define AT_SMPV(KT, VSL) do { const LAS unsigned char* V_ = lds + (VSL) * AT_VSLOT; \
        unsigned w0 = 0u, w1 = 0u; if (MODE == 1) { w0 = mrow[(KT) >> 5] >> (8 * h); w1 = mrow[((KT) >> 5) + 1] >> (8 * h); } \
        float mxl = fmaxf(s0[0], s1[0]); _Pragma("unroll") for (int t = 1; t < 16; ++t) mxl = max3f(mxl, s0[t], s1[t]); \
        if (__builtin_amdgcn_ballot_w64((mxl - mref > 8.0f) || !init) != 0ull) { \
            if (MODE == 1) { _Pragma("unroll") for (int t = 0; t < 16; ++t) { const int bit = (t & 3) + 4 * ((t >> 2) & 1) + 16 * (t >> 3); \
                if (!((w0 >> bit) & 1u)) s0[t] = -INFINITY; if (!((w1 >> bit) & 1u)) s1[t] = -INFINITY; } } \
            float mx = fmaxf(s0[0], s1[0]); _Pragma("unroll") for (int t = 1; t < 16; ++t) mx = max3f(mx, s0[t], s1[t]); \
            mx = fmaxf(mx, shx(mx, 32, lane)); const bool seen = mx > -INFINITY; \
            const float mnew = init ? fmaxf(mx, mref) : (seen ? mx : 0.f); const float alpha = init ? __builtin_amdgcn_exp2f(mref - mnew) : 1.0f; \
            init = init || seen; mref = mnew; l *= alpha; \
            _Pragma("unroll") for (int t = 0; t < 16; ++t) { o0[t] *= alpha; o1[t] *= alpha; } } \
        float ps0 = 0.f, ps1 = 0.f; \
        _Pragma("unroll") for (int t = 0; t < 16; ++t) { float p0 = __builtin_amdgcn_exp2f(s0[t] - mref), p1 = __builtin_amdgcn_exp2f(s1[t] - mref); \
            if (MODE == 1) { const int bit = (t & 3) + 4 * ((t >> 2) & 1) + 16 * (t >> 3); \
                p0 = __uint_as_float(__float_as_uint(p0) & (unsigned)__builtin_amdgcn_sbfe((int)w0, bit, 1)); p1 = __uint_as_float(__float_as_uint(p1) & (unsigned)__builtin_amdgcn_sbfe((int)w1, bit, 1)); } \
            s0[t] = p0; s1[t] = p1; ps0 += p0; ps1 += p1; } \
        l += ps0 + ps1; \
        bf16x8 va_[4], vb_[4]; \
        _Pragma("unroll") for (int s4 = 0; s4 < 4; ++s4) { const int sw = ((2 * s4 + h) ^ vsw) << 4; va_[s4] = *(const LAS bf16x8*)(V_ + vx0 + sw); vb_[s4] = *(const LAS bf16x8*)(V_ + vx1 + sw); } \
        bf16x8 pb[4]; pb[0] = pack8(s0, 0); pb[1] = pack8(s0, 1); pb[2] = pack8(s1, 0); pb[3] = pack8(s1, 1); \
        __builtin_amdgcn_sched_barrier(0); \
        _Pragma("unroll") for (int s4 = 0; s4 < 4; ++s4) { o0 = MFMA32(va_[s4], pb[s4], o0); o1 = MFMA32(vb_[s4], pb[s4], o1); } \
        __builtin_amdgcn_sched_barrier(0); } while (0)
    int ksl = 0, vsl = 0;
#pragma unroll 1
    for (int ti = 0; ti <= ntile; ++ti) {
        const int kt = kt_begin + 64 * ti;
        if (ti + 2 < ntile) { if (MODE == 0 && wave < 4) asm volatile("s_waitcnt vmcnt(6)" ::: "memory"); else asm volatile("s_waitcnt vmcnt(4)" ::: "memory"); }
        else if (ti + 1 < ntile) { if (MODE == 0 && wave < 4) asm volatile("s_waitcnt vmcnt(3)" ::: "memory"); else asm volatile("s_waitcnt vmcnt(2)" ::: "memory"); }
        else asm volatile("s_waitcnt vmcnt(0)" ::: "memory");
        __builtin_amdgcn_s_barrier();
        asm volatile("" ::: "memory");
        if (ti + 3 < ntile) attn_stage<MODE>(lds, (ksl + 3) & 3, (vsl + 3 >= 5) ? vsl - 2 : vsl + 3, k1, ldk1, k2, vt, kt + 192, voK, voV, voP, wave);
        const bool cur_ok = (ti < ntile) && (kt < my_end);
        if (!skew && cur_ok) AT_QK(ksl);
        { const int xt = skew ? kt - 64 : kt, xv = skew ? ((vsl == 0) ? 4 : vsl - 1) : vsl;
          if (xt >= kt_begin && xt < kt_end && xt < my_end) AT_SMPV(xt, xv); }
        if (skew && cur_ok) AT_QK(ksl);
        ksl = (ksl + 1) & 3; vsl = (vsl == 4) ? 0 : vsl + 1;
    }
#undef AT_QK
#undef AT_SMPV
    float lt = l + shx(l, 32, lane);
    if (MODE == 2) lt += __builtin_amdgcn_exp2f(sink_l2 - mref);
    const float inv = 1.0f / lt;
#pragma unroll
    for (int g = 0; g < 4; ++g) {
        u32x2 w0, w1;
        w0.x = pk2(o0[4 * g] * inv, o0[4 * g + 1] * inv); w0.y = pk2(o0[4 * g + 2] * inv, o0[4 * g + 3] * inv);
        w1.x = pk2(o1[4 * g] * inv, o1[4 * g + 1] * inv); w1.y = pk2(o1[4 * g + 2] * inv, o1[4 * g + 3] * inv);
        *(u32x2*)(orow + 8 * g + 4 * h) = w0; *(u32x2*)(orow + 32 + 8 * g + 4 * h) = w1;
    }
}

#define A5_SB() __builtin_amdgcn_sched_barrier(0)
#ifndef A5_NEGM
#define A5_NEGM 1
#endif
#ifndef A5_GV
#define A5_GV 2
#endif
#ifndef A5_GK
#define A5_GK 5
#endif
#ifndef A5_TRIG
#define A5_TRIG 256.0f
#endif
#ifndef A5_RISE
#define A5_RISE 8.0f
#endif
#ifndef A5_LSUM
#define A5_LSUM 0
#endif
#ifndef A5_WIDE_STORE
#define A5_WIDE_STORE 1
#endif
#ifndef A5_MASK_DMA
#define A5_MASK_DMA 1
#endif
#ifndef BR_F8
#define BR_F8 1
#endif
#if BR_F8
#define A5_OPTR(base, off) ((bf16_t*)((unsigned char*)(base) + (off)))
#else
#define A5_OPTR(base, off) ((base) + (off))
#endif
#ifndef A5_VLATE
#define A5_VLATE 1
#endif
template <int MODE> struct A5Map { static constexpr int KSLOT = (MODE == 0) ? 12288 : 8192, NKR = (MODE == 0) ? 5 : 4, VR = NKR * KSLOT, MASK = VR + 5 * AT_VSLOT; };
static_assert(A5Map<1>::MASK + 8 * 32 * 65 * 4 <= 147456 - 64 && A5Map<0>::MASK <= 147456 - 64, "attention v5 LDS map");
template <int MODE> __device__ __forceinline__ void a5_stage_k(LAS unsigned char* lds, int slot, const bf16_t* k1, int ldk1, const bf16_t* k2, int kt, unsigned voK, unsigned voP, int wave) {
    const char* kb = (const char*)(k1 + (size_t)kt * ldk1);
    __builtin_amdgcn_global_load_lds((const unsigned*)(kb + voK), (LAS unsigned*)(lds + slot * A5Map<MODE>::KSLOT + wave * 1024), 16, 0, 0);
    if (MODE == 0) { if (wave < 4) { const char* pb = (const char*)(k2 + (size_t)kt * 32);
        __builtin_amdgcn_global_load_lds((const unsigned*)(pb + voP), (LAS unsigned*)(lds + slot * A5Map<MODE>::KSLOT + AT_KPE + wave * 1024), 16, 0, 0); } }
}
template <int MODE> __device__ __forceinline__ void a5_stage_v(LAS unsigned char* lds, int slot, const bf16_t* vt, int kt, unsigned voV, int wave) {
    const char* vb = (const char*)(vt + (size_t)kt * 64);
    __builtin_amdgcn_global_load_lds((const unsigned*)(vb + voV), (LAS unsigned*)(lds + A5Map<MODE>::VR + slot * AT_VSLOT + wave * 1024), 16, 0, 0);
}
__device__ __forceinline__ void a5_wait_bar(int allowed) {
    if (allowed >= 6) asm volatile("s_waitcnt vmcnt(6) lgkmcnt(0)\n\ts_barrier" ::: "memory");
    else if (allowed >= 4) asm volatile("s_waitcnt vmcnt(4) lgkmcnt(0)\n\ts_barrier" ::: "memory");
    else if (allowed == 3) asm volatile("s_waitcnt vmcnt(3) lgkmcnt(0)\n\ts_barrier" ::: "memory");
    else if (allowed == 2) asm volatile("s_waitcnt vmcnt(2) lgkmcnt(0)\n\ts_barrier" ::: "memory");
    else if (allowed == 1) asm volatile("s_waitcnt vmcnt(1) lgkmcnt(0)\n\ts_barrier" ::: "memory");
    else asm volatile("s_waitcnt vmcnt(0) lgkmcnt(0)\n\ts_barrier" ::: "memory");
}
template <int NKS, int MODE, int PV = 0>
__device__ __forceinline__ void attn5_item(LAS unsigned char* lds, const bf16_t* qrow, const bf16_t* k1, int ldk1, const bf16_t* k2, const bf16_t* vt,
                                           int kt_begin, int nt, int ntm, const unsigned* maskrow, float sink_l2, bf16_t* orow, int tid, int wave, int lane) {
    constexpr int KSLOT = A5Map<MODE>::KSLOT, VR = A5Map<MODE>::VR, NKR = A5Map<MODE>::NKR;
    const int r = lane & 31, h = lane >> 5, pr = pi32(r);
    const unsigned ko0 = (unsigned)(pr * 128 + ((h ^ ((pr >> 1) & 7)) << 4)), kp0 = (unsigned)(AT_KPE + pr * 64 + ((h ^ ((pr >> 2) & 3)) << 4)), vo0 = (unsigned)(r * 128 + ((h ^ ((r >> 1) & 7)) << 4));
    unsigned voK, voV, voP;
    { const int row = tid >> 3, cp = tid & 7, c = cp ^ ((row >> 1) & 7); voK = (unsigned)(row * ldk1 + 8 * c) * 2u; voV = (unsigned)(row * 64 + 8 * c) * 2u;
      const int key = (tid & 255) >> 2, cq = tid & 3, cc = cq ^ ((key >> 2) & 3); voP = (unsigned)(key * 32 + 8 * cc) * 2u; }
    const int KP = (MODE == 0 && wave < 4) ? 2 : 1;
    asm volatile("s_waitcnt lgkmcnt(0)\n\ts_barrier" ::: "memory");
    LAS unsigned* mrow = (LAS unsigned*)(lds + A5Map<MODE>::MASK) + (wave * 32 + r) * 65;
    a5_stage_k<MODE>(lds, 0, k1, ldk1, k2, kt_begin, voK, voP, wave);
    a5_stage_v<MODE>(lds, 0, vt, kt_begin, voV, wave);
    if (nt > 1) { a5_stage_k<MODE>(lds, 1, k1, ldk1, k2, kt_begin + 64, voK, voP, wave); a5_stage_v<MODE>(lds, 1, vt, kt_begin + 64, voV, wave); }
    if (nt > 2) { a5_stage_k<MODE>(lds, 2, k1, ldk1, k2, kt_begin + 128, voK, voP, wave); a5_stage_v<MODE>(lds, 2, vt, kt_begin + 128, voV, wave); }
    if (nt > 3) a5_stage_k<MODE>(lds, 3, k1, ldk1, k2, kt_begin + 192, voK, voP, wave);
    bf16x8 qf[NKS];
#pragma unroll
    for (int ks = 0; ks < NKS; ++ks) qf[ks] = *(const bf16x8*)(qrow + 16 * ks + 8 * h);
    if (MODE == 1) {
        LAS unsigned* mw = (LAS unsigned*)(lds + A5Map<MODE>::MASK) + (wave * 32) * 65;
        const unsigned lo4 = (unsigned)lane * 4u;
#if A5_MASK_DMA
#pragma unroll 4
        for (int q = 0; q < 32; ++q) { const char* mq = (const char*)(maskrow + (size_t)q * 64);
            __builtin_amdgcn_global_load_lds((const unsigned*)(mq + lo4), (LAS unsigned*)(mw + q * 65), 4, 0, 0); }
#else
#pragma unroll 8
        for (int q = 0; q < 32; ++q) { const char* mq = (const char*)(maskrow + (size_t)q * 64); mw[q * 65 + lane] = *(const unsigned*)(mq + lo4); }
#endif
    }
#pragma unroll
    for (int ks = 0; ks < NKS; ++ks) asm volatile("" :: "v"(qf[ks]));
    asm volatile("s_waitcnt vmcnt(0) lgkmcnt(0)\n\ts_barrier" ::: "memory");
    f32x16 C[2], o0, o1; float P[32];
    bf16x8 kf[2 * NKS], vf[8]; u32x4 pw[4];
#pragma unroll
    for (int t = 0; t < 16; ++t) { o0[t] = 0.f; o1[t] = 0.f; }
    constexpr bool NEGM = A5_NEGM != 0;
    constexpr bool LSUM = (MODE == 1) && (A5_LSUM != 0);
    float mref = 0.f, l = 0.f, al_pend = 1.f, al_a = 1.f; bool pend = false, pend_a = false; f32x16 negm, lacc;
    bf16x8 ones_;
#pragma unroll
    for (int t = 0; t < 16; ++t) lacc[t] = 0.f;
#pragma unroll
    for (int t = 0; t < 8; ++t) ones_[t] = (short)0x3F80;
    if (PV != 0) { _Pragma("unroll") for (int i_ = 0; i_ < 4; ++i_) { pw[i_].x = 0x3c003c00u; pw[i_].y = 0x3c003c00u; pw[i_].z = 0x3c003c00u; pw[i_].w = 0x3c003c00u; }
                   _Pragma("unroll") for (int i_ = 0; i_ < 8; ++i_) vf[i_] = qf[i_ % NKS]; _Pragma("unroll") for (int i_ = 8; i_ < 2 * NKS; ++i_) kf[i_] = qf[i_ % NKS]; }
#define A5_DSRD(dst, addr, OFF) asm volatile("ds_read_b128 %0, %1 offset:%2" : "=&v"(dst) : "v"(addr), "i"(OFF))
#define A5_KRD(i, KA) do { if (((i) >> 1) < 4) A5_DSRD(kf[i], ((KA) + ko0) ^ (unsigned)(((i) >> 1) << 5), ((i) & 1) ? 4096 : 0); \
                           else A5_DSRD(kf[i], ((KA) + kp0) ^ (unsigned)((((i) >> 1) - 4) << 5), ((i) & 1) ? 2048 : 0); } while (0)
#define A5_VRD(i, VA) A5_DSRD(vf[i], ((VA) + vo0) ^ (unsigned)(((i) >> 1) << 5), ((i) & 1) ? 4096 : 0)
#define A5_LGKM(N, x) asm volatile("s_waitcnt lgkmcnt(%1)" : "+v"(x) : "n"(N))
#define A5_SUMPK(g) do { const int b_ = 4 * (g); \
        if (!LSUM) { sacc += P[b_]; sacc += P[b_ + 1]; sacc += P[b_ + 2]; sacc += P[b_ + 3]; asm volatile("" : "+v"(sacc)); } \
        pw[(g) >> 1][((g) & 1) * 2] = pk2(P[b_], P[b_ + 1]); pw[(g) >> 1][((g) & 1) * 2 + 1] = pk2(P[b_ + 2], P[b_ + 3]); \
        if ((g) & 1) asm volatile("" : "+v"(pw[(g) >> 1])); } while (0)
#define A5_EXP(j) do { _Pragma("unroll") for (int e_ = 4 * (j); e_ < 4 * (j) + 4; ++e_) { const int a_ = e_ >> 4, t_ = e_ & 15; \
        float p_ = __builtin_amdgcn_exp2f(NEGM ? C[a_][t_] : C[a_][t_] - mref); \
        if (MODE == 1) { const int bit_ = (t_ & 3) + 4 * ((t_ >> 2) & 1) + 16 * (t_ >> 3); p_ = __uint_as_float(__float_as_uint(p_) & (unsigned)__builtin_amdgcn_sbfe((int)(a_ ? w1 : w0), bit_, 1)); } \
        P[e_] = p_; } \
        asm volatile("" : "+v"(P[4 * (j)]), "+v"(P[4 * (j) + 1]), "+v"(P[4 * (j) + 2]), "+v"(P[4 * (j) + 3])); } while (0)
    {
        const unsigned KB0 = (unsigned)(size_t)lds;
#pragma unroll
        for (int i = 0; i < 8; ++i) A5_KRD(i, KB0);
        asm volatile("s_waitcnt lgkmcnt(0)\n\ts_barrier" ::: "memory");
#pragma unroll
        for (int i = 0; i < 8; ++i) asm volatile("" : "+v"(kf[i]));
    }
    int vprev = 4, kcur = 0;
#define A5_ISSUE_V(t) do { if (PV != 1 && (t) + 3 < nt) a5_stage_v<MODE>(lds, (vprev + 4 >= 5) ? vprev - 1 : vprev + 4, vt, kt_begin + 64 * (t) + 192, voV, wave); } while (0)
#define A5_ISSUE_K(t) do { if (PV != 1 && (t) + 4 < nt) a5_stage_k<MODE>(lds, (NKR == 4) ? kcur : ((kcur == 0) ? 4 : kcur - 1), k1, ldk1, k2, kt_begin + 64 * (t) + 256, voK, voP, wave); } while (0)
#define A5_SLOTS() \
        const int knext = (kcur == NKR - 1) ? 0 : kcur + 1; \
        const unsigned KBn = (unsigned)(size_t)lds + knext * KSLOT, KBc = (unsigned)(size_t)lds + kcur * KSLOT, VBp = (unsigned)(size_t)lds + VR + vprev * AT_VSLOT; (void)KBn; (void)KBc; (void)VBp;
#define A5_ISSUE(t) A5_ISSUE_V(t); A5_ISSUE_K(t); A5_SLOTS()
#define A5_CLOSE(t) do { int allowed_; \
        if ((t) + 2 < nt) allowed_ = 1 + (((t) + 3 < nt) ? KP + 1 : 0) + (((t) + 4 < nt) ? KP : 0); \
        else allowed_ = ((t) + 1 < nt) ? KP + 1 : 0; \
        a5_wait_bar(allowed_); vprev = (vprev == 4) ? 0 : vprev + 1; kcur = knext; \
        _Pragma("unroll") for (int i_ = 0; i_ < 8; ++i_) asm volatile("" : "+v"(kf[i_])); } while (0)
    {
        A5_ISSUE(0);
        unsigned w0 = 0u, w1 = 0u; if (MODE == 1) { w0 = mrow[0] >> (8 * h); w1 = mrow[1] >> (8 * h); }
#pragma unroll
        for (int i = 8; i < 2 * NKS; ++i) A5_KRD(i, KBc);
#pragma unroll
        for (int i = 8; i < 2 * NKS; ++i) A5_LGKM(0, kf[i]);
#pragma unroll
        for (int i = 0; i < 2 * NKS; ++i) {
            if (i < 2) { f32x16 z_; _Pragma("unroll") for (int t_ = 0; t_ < 16; ++t_) z_[t_] = 0.f; C[i & 1] = MFMA32(kf[i], qf[i >> 1], z_); }
            else C[i & 1] = MFMA32(kf[i], qf[i >> 1], C[i & 1]);
        }
        A5_SB();
        {
            asm volatile("s_nop 15\n\ts_nop 3" : "+v"(C[0]), "+v"(C[1]) :: "memory");
            float ma_ = max3f(C[0][0], C[0][1], C[0][2]), mb_ = max3f(C[1][0], C[1][1], C[1][2]);
            _Pragma("unroll") for (int t_ = 3; t_ < 15; t_ += 2) { ma_ = max3f(ma_, C[0][t_], C[0][t_ + 1]); mb_ = max3f(mb_, C[1][t_], C[1][t_ + 1]); }
            float mx_ = max3f(ma_, mb_, C[0][15]); mx_ = max3f(mx_, C[1][15], C[1][15]);
            mref = fmaxf(mx_, shx(mx_, 32, lane));
            if (NEGM) { _Pragma("unroll") for (int t_ = 0; t_ < 16; ++t_) { C[0][t_] -= mref; C[1][t_] -= mref; negm[t_] = -mref; } }
        }
#pragma unroll
        for (int i = 0; i < 8; ++i) A5_KRD(i, KBn);
#pragma unroll
        for (int j = 0; j < 8; ++j) A5_EXP(j);
        A5_SB();
        A5_CLOSE(0);
    }
#pragma unroll 1
    for (int t = 1; t < ntm; ++t) {
        if (A5_GV < 0) A5_ISSUE_V(t);
        if (A5_GK < 0) A5_ISSUE_K(t);
        A5_SLOTS();
        unsigned w0 = 0u, w1 = 0u;
        if (MODE == 1) { const unsigned ma_ = (unsigned)(size_t)mrow + 8u * (unsigned)t;
            asm volatile("ds_read_b32 %0, %1" : "=&v"(w0) : "v"(ma_)); asm volatile("ds_read_b32 %0, %1 offset:4" : "=&v"(w1) : "v"(ma_)); }
        float sacc = 0.f;
        A5_SB();
#pragma unroll
        for (int i = 0; i < 2 * NKS; ++i) {
            if (PV != 4) { if (A5_VLATE ? (i >= 2 * NKS - 3) : (i >= 2 * NKS - 8)) A5_VRD(i - (A5_VLATE ? 2 * NKS - 3 : 2 * NKS - 8), VBp); }
            if (PV != 4) { if (NKS > 4 && i < 2 * NKS - 8) A5_KRD(8 + i, KBc); }
            if (NKS > 4 && i >= 8) A5_LGKM(A5_VLATE ? 3 : 8, kf[i]);
            if (PV != 3) { if (i < 2 && !NEGM) { f32x16 z_; _Pragma("unroll") for (int t_ = 0; t_ < 16; ++t_) z_[t_] = 0.f; C[i & 1] = MFMA32(kf[i], qf[i >> 1], z_); }
                           else C[i & 1] = MFMA32(kf[i], qf[i >> 1], (i < 2) ? negm : C[i & 1]); }
            if (PV != 2) { if (i < 8) A5_SUMPK(i); }
            A5_SB();
            if (i == A5_GV) { A5_ISSUE_V(t); A5_SB(); }
            if (i == A5_GK) { A5_ISSUE_K(t); A5_SB(); }
        }
        l += sacc;
        if (LSUM) {
            if (t + 1 < ntm && __builtin_amdgcn_ballot_w64(lacc[0] > 4294967296.0f) != 0ull) {
                const float rise_ = __builtin_amdgcn_logf(fmaxf(lacc[0], 1.0f)), dl_ = (rise_ > 8.0f) ? rise_ : 0.f;
                al_a = __builtin_amdgcn_exp2f(-dl_); mref += dl_; pend_a = true;
                if (NEGM) { _Pragma("unroll") for (int t_ = 0; t_ < 16; ++t_) negm[t_] = -mref; }
            }
        } else
        if (PV != 2 && t + 1 < ntm && __builtin_amdgcn_ballot_w64(sacc > A5_TRIG) != 0ull) {
            float ma_ = max3f(P[0], P[1], P[2]), mb_ = max3f(P[3], P[4], P[5]);
#pragma unroll
            for (int e_ = 6; e_ < 30; e_ += 4) { ma_ = max3f(ma_, P[e_], P[e_ + 1]); mb_ = max3f(mb_, P[e_ + 2], P[e_ + 3]); }
            float mxp_ = max3f(ma_, mb_, P[30]); mxp_ = fmaxf(mxp_, P[31]); mxp_ = fmaxf(mxp_, shx(mxp_, 32, lane));
            const float rise_ = __builtin_amdgcn_logf(fmaxf(mxp_, 1.0f)), dl_ = (rise_ > A5_RISE) ? rise_ : 0.f;
            al_a = __builtin_amdgcn_exp2f(-dl_); mref += dl_; pend_a = true;
            if (NEGM) { _Pragma("unroll") for (int t_ = 0; t_ < 16; ++t_) negm[t_] = -mref; }
        }
#pragma unroll
        for (int j = 0; j < 8; ++j) {
            if (PV != 4) { if (j >= 2 && j < 6) { A5_KRD(2 * (j - 2), KBn); A5_KRD(2 * (j - 2) + 1, KBn); } }
            if (PV != 4 && A5_VLATE) { if (j < 5) A5_VRD(j + 3, VBp); }
            { constexpr int NW0[8] = {7, 6, 7, 8, 9, 10, 9, 8}, NW1[8] = {3, 3, 5, 7, 9, 8, 5, 2};
              if (MODE == 1 && j == 0) { asm volatile("s_waitcnt lgkmcnt(%3)" : "+v"(vf[0]), "+v"(w0), "+v"(w1) : "n"(A5_VLATE ? 3 : 7)); w0 >>= 8 * h; w1 >>= 8 * h; }
              else A5_LGKM(A5_VLATE ? NW1[j] : NW0[j], vf[j]); }
            if (PV != 3) { if (j & 1) o1 = MFMA32(vf[j], __builtin_bit_cast(bf16x8, pw[j >> 1]), o1); else o0 = MFMA32(vf[j], __builtin_bit_cast(bf16x8, pw[j >> 1]), o0); }
            if (LSUM && (j & 1)) lacc = MFMA32(ones_, __builtin_bit_cast(bf16x8, pw[j >> 1]), lacc);
            if (PV != 2) A5_EXP(j);
            A5_SB();
        }
        A5_CLOSE(t);
        if (pend) {
#pragma unroll
            for (int t_ = 0; t_ < 16; ++t_) { o0[t_] *= al_pend; o1[t_] *= al_pend; }
            l *= al_pend; pend = false;
            if (LSUM) { _Pragma("unroll") for (int t_ = 0; t_ < 16; ++t_) lacc[t_] *= al_pend; }
        }
        if (pend_a) { pend = true; al_pend = al_a; pend_a = false; }
    }
    {
        if (ntm < nt) { A5_ISSUE(ntm); (void)knext; }
        const unsigned VBl = (unsigned)(size_t)lds + VR + vprev * AT_VSLOT;
        float sacc = 0.f;
#pragma unroll
        for (int i = 0; i < 8; ++i) A5_VRD(i, VBl);
#pragma unroll
        for (int g = 0; g < 8; ++g) A5_SUMPK(g);
#pragma unroll
        for (int i = 0; i < 8; ++i) A5_LGKM(0, vf[i]);
        l += sacc;
        A5_SB();
#pragma unroll
        for (int j = 0; j < 8; ++j) { if (j & 1) o1 = MFMA32(vf[j], __builtin_bit_cast(bf16x8, pw[j >> 1]), o1); else o0 = MFMA32(vf[j], __builtin_bit_cast(bf16x8, pw[j >> 1]), o0);
            if (LSUM && (j & 1)) lacc = MFMA32(ones_, __builtin_bit_cast(bf16x8, pw[j >> 1]), lacc); }
        A5_SB();
    }
#pragma unroll 1
    for (int t = ntm; t < nt; ++t) {
        if (t > ntm) { A5_ISSUE(t); A5_CLOSE(t); }
        else { const int knext = (kcur == NKR - 1) ? 0 : kcur + 1; A5_CLOSE(t); }
    }
#undef A5_ISSUE
#undef A5_ISSUE_V
#undef A5_ISSUE_K
#undef A5_SLOTS
#undef A5_CLOSE
#undef A5_KRD
#undef A5_DSRD
#undef A5_LGKM
#undef A5_VRD
#undef A5_SUMPK
#undef A5_EXP
    float lt = LSUM ? lacc[0] : l + shx(l, 32, lane);
    if (MODE == 2) lt += __builtin_amdgcn_exp2f(sink_l2 - mref);
    const float inv = 1.0f / lt;
#if BR_F8
    { const float inv16 = inv * 16.0f;
#pragma unroll
      for (int p = 0; p < 2; ++p) { const int ge = 2 * p, go = 2 * p + 1; int xe0 = 0, xo0 = 0, xe1 = 0, xo1 = 0;
        xe0 = f8x4(o0[4 * ge] * inv16, o0[4 * ge + 1] * inv16, o0[4 * ge + 2] * inv16, o0[4 * ge + 3] * inv16); xo0 = f8x4(o0[4 * go] * inv16, o0[4 * go + 1] * inv16, o0[4 * go + 2] * inv16, o0[4 * go + 3] * inv16);
        xe1 = f8x4(o1[4 * ge] * inv16, o1[4 * ge + 1] * inv16, o1[4 * ge + 2] * inv16, o1[4 * ge + 3] * inv16); xo1 = f8x4(o1[4 * go] * inv16, o1[4 * go + 1] * inv16, o1[4 * go + 2] * inv16, o1[4 * go + 3] * inv16);
        const auto a = __builtin_amdgcn_permlane32_swap((unsigned)xe0, (unsigned)xo0, false, false), b = __builtin_amdgcn_permlane32_swap((unsigned)xe1, (unsigned)xo1, false, false);
        u32x2 c0, c1; c0.x = a[0]; c0.y = a[1]; c1.x = b[0]; c1.y = b[1];
        unsigned char* q = (unsigned char*)orow + 8 * (h ? go : ge);
        *(u32x2*)q = c0; *(u32x2*)(q + 32) = c1; } }
#elif A5_WIDE_STORE
#pragma unroll
    for (int p = 0; p < 2; ++p) {
        u32x2 we0, wo0, we1, wo1; const int ge = 2 * p, go = 2 * p + 1;
        we0.x = pk2(o0[4 * ge] * inv, o0[4 * ge + 1] * inv); we0.y = pk2(o0[4 * ge + 2] * inv, o0[4 * ge + 3] * inv);
        wo0.x = pk2(o0[4 * go] * inv, o0[4 * go + 1] * inv); wo0.y = pk2(o0[4 * go + 2] * inv, o0[4 * go + 3] * inv);
        we1.x = pk2(o1[4 * ge] * inv, o1[4 * ge + 1] * inv); we1.y = pk2(o1[4 * ge + 2] * inv, o1[4 * ge + 3] * inv);
        wo1.x = pk2(o1[4 * go] * inv, o1[4 * go + 1] * inv); wo1.y = pk2(o1[4 * go + 2] * inv, o1[4 * go + 3] * inv);
        const auto a0 = __builtin_amdgcn_permlane32_swap(we0.x, wo0.x, false, false), a1 = __builtin_amdgcn_permlane32_swap(we0.y, wo0.y, false, false);
        const auto b0 = __builtin_amdgcn_permlane32_swap(we1.x, wo1.x, false, false), b1 = __builtin_amdgcn_permlane32_swap(we1.y, wo1.y, false, false);
        u32x4 c0, c1; c0.x = a0[0]; c0.y = a1[0]; c0.z = a0[1]; c0.w = a1[1]; c1.x = b0[0]; c1.y = b1[0]; c1.z = b0[1]; c1.w = b1[1];
        bf16_t* q = orow + 8 * (h ? go : ge);
        *(u32x4*)q = c0; *(u32x4*)(q + 32) = c1;
    }
#else
#pragma unroll
    for (int g = 0; g < 4; ++g) {
        u32x2 w0, w1;
        w0.x = pk2(o0[4 * g] * inv, o0[4 * g + 1] * inv); w0.y = pk2(o0[4 * g + 2] * inv, o0[4 * g + 3] * inv);
        w1.x = pk2(o1[4 * g] * inv, o1[4 * g + 1] * inv); w1.y = pk2(o1[4 * g + 2] * inv, o1[4 * g + 3] * inv);
        *(u32x2*)(orow + 8 * g + 4 * h) = w0; *(u32x2*)(orow + 32 + 8 * g + 4 * h) = w1;
    }
#endif
}

#define AT_OPAQUE_WS() size_t zz_ = 0; asm volatile("" : "+s"(zz_)); unsigned char* ws = ws_in + zz_; int lane = lane_in; asm volatile("" : "+v"(lane)); const int r = lane & 31; const int tid = wave * 64 + lane;
__device__ __forceinline__ void attention_phase2(unsigned char* ws_in, LAS unsigned char* lds, const float* sinks, int G, int bid, int tid_in, int wave, int lane_in, int which = 7, bool dummy = false) {
    for (int j0 = bid; j0 < 256; j0 += G) {
        const int j = (G == 256) ? ((j0 & 7) * 32 + (j0 >> 3)) : j0;
        const int b = j >> 5; const size_t tb = (size_t)b * SEQ;
        if (which & 1) {
            AT_OPAQUE_WS();
            const bf16_t* AQ = (const bf16_t*)(ws + R_AQ); const bf16_t* AKN = (const bf16_t*)(ws + R_AKN); const bf16_t* KPE = (const bf16_t*)(ws + R_KPE); const bf16_t* AVT = (const bf16_t*)(ws + R_AVT);
            bf16_t* OA = (bf16_t*)(ws + (dummy ? R_AV : WS_OABC));
            const int head = (j >> 2) & 7, qp = j & 3;
#pragma unroll 1
            for (int z = 0; z < 2; ++z) {
                const int Q = z ? qp : 7 - qp, c = 4 * Q + (wave >> 1), q0 = 64 * c + 32 * (wave & 1); const size_t qr = tb + q0 + r;
#ifdef A5_PROBE_VARIANT
                if (dummy) attn5_item<6, 0, A5_PROBE_VARIANT>(lds, AQ + qr * 768 + head * 96, AKN + tb * 512 + head * 64, 512, KPE + tb * 32, AVT + (size_t)(b * 8 + head) * 64 * SEQ,
                                 0, 4 * Q + 4, c + 1, nullptr, 0.f, A5_OPTR(OA, qr * 512 + head * 64), tid, wave, lane); else
#endif
                attn5_item<6, 0>(lds, AQ + qr * 768 + head * 96, AKN + tb * 512 + head * 64, 512, KPE + tb * 32, AVT + (size_t)(b * 8 + head) * 64 * SEQ,
                                 0, 4 * Q + 4, c + 1, nullptr, 0.f, A5_OPTR(OA, qr * 512 + head * 64), tid, wave, lane);
            }
        }
        const int g = (j >> 4) & 1, cp = j & 15, head = 4 * g + (wave >> 1);
        if (which & 2) {
            AT_OPAQUE_WS();
            const bf16_t* BQ = (const bf16_t*)(ws + R_BQ); const bf16_t* BK = (const bf16_t*)(ws + R_BK); const bf16_t* BVT = (const bf16_t*)(ws + R_BVT); const unsigned* MASK = (const unsigned*)(ws + R_MASK);
            bf16_t* OB = A5_OPTR((bf16_t*)(ws + (dummy ? R_AV : WS_OABC)), (dummy ? (size_t)0 : (size_t)NT * 512));
#pragma unroll 1
            for (int z = 0; z < 2; ++z) {
                const int c = z ? cp : 31 - cp, q0 = 64 * c + 32 * (wave & 1); const size_t qr = tb + q0 + r;
                attn5_item<4, 1>(lds, BQ + qr * 512 + head * 64, BK + tb * 128 + g * 64, 128, nullptr, BVT + (size_t)(b * 2 + g) * 64 * SEQ,
                                 0, c + 1, c + 1, MASK + (tb + q0) * 64, 0.f, A5_OPTR(OB, qr * 512 + head * 64), tid, wave, lane);
            }
        }
        if (which & 4) {
            AT_OPAQUE_WS();
            const bf16_t* CQ = (const bf16_t*)(ws + R_CQ); const bf16_t* CK = (const bf16_t*)(ws + R_CK); const bf16_t* CVT = (const bf16_t*)(ws + R_CVT);
            bf16_t* OC = A5_OPTR((bf16_t*)(ws + (dummy ? R_AV : WS_OABC)), (dummy ? (size_t)0 : (size_t)2 * NT * 512));
            const float sink = sinks[head] * LOG2E;
#pragma unroll 1
            for (int z = 0; z < 2; ++z) {
                const int c = z ? cp : 31 - cp, q0 = 64 * c + 32 * (wave & 1); const size_t qr = tb + q0 + r;
                attn5_item<4, 2>(lds, CQ + qr * 512 + head * 64, CK + tb * 128 + g * 64, 128, nullptr, CVT + (size_t)(b * 2 + g) * 64 * SEQ,
                                 (c >= 2) ? 64 * (c - 2) : 0, (c >= 2) ? 3 : c + 1, (c >= 2) ? 3 : c + 1, nullptr, sink, A5_OPTR(OC, qr * 512 + head * 64), tid, wave, lane);
            }
        }
    }
}
#ifndef P1_F8
#define P1_F8 1
#endif
#ifndef GATE_F8
#define GATE_F8 1
#endif
#ifndef MOE_F8
#define MOE_F8 1
#endif
#ifndef OUT_F8
#define OUT_F8 1
#endif
__device__ __forceinline__ void ln_rows(f32x4 (&v)[4], const float* g, const float* b, int lane) {
    float s = 0.f;
#pragma unroll
    for (int j = 0; j < 4; ++j) s += (v[j][0] + v[j][1]) + (v[j][2] + v[j][3]);
    const float mean = wave_sum(s, lane) * (1.0f / DM); float s2 = 0.f;
#pragma unroll
    for (int j = 0; j < 4; ++j) { v[j] = v[j] - mean; s2 += (v[j][0] * v[j][0] + v[j][1] * v[j][1]) + (v[j][2] * v[j][2] + v[j][3] * v[j][3]); }
    const float rstd = 1.0f / sqrtf(wave_sum(s2, lane) * (1.0f / DM) + LN_EPS);
#pragma unroll
    for (int j = 0; j < 4; ++j) { const f32x4 gg = *(const f32x4*)(g + 4 * lane + 256 * j), bb = *(const f32x4*)(b + 4 * lane + 256 * j); v[j] = v[j] * rstd * gg + bb; }
}
__device__ __forceinline__ void store_row(const f32x4 (&v)[4], float* orow, bf16_t* brow, int lane, unsigned char* qrow = nullptr) {
#pragma unroll
    for (int j = 0; j < 4; ++j) {
        if (orow) *(f32x4*)(orow + 4 * lane + 256 * j) = v[j];
        if (brow) { u32x2 w; w.x = pk2(v[j][0], v[j][1]); w.y = pk2(v[j][2], v[j][3]); *(u32x2*)(brow + 4 * lane + 256 * j) = w; }
        if (qrow) *(int*)(qrow + 4 * lane + 256 * j) = f8x4(v[j][0], v[j][1], v[j][2], v[j][3]);
    }
}

__device__ __forceinline__ void conv_item(const float* srccol  , int ldw, const float* gain, bf16_t* dst  , int K, int k0, LAS float* scr, int lane, float f8s = 0.f  ) {
    const int n4 = lane & 7, kr = lane >> 3;
    f32x4 v[8];
#pragma unroll
    for (int i = 0; i < 8; ++i) v[i] = srccol ? *(const f32x4*)(srccol + (size_t)(k0 + 8 * i + kr) * ldw) : (f32x4){0.f, 0.f, 0.f, 0.f};
    if (gain) {
#pragma unroll
        for (int i = 0; i < 8; ++i) v[i] = v[i] * gain[k0 + 8 * i + kr];
    }
#pragma unroll
    for (int i = 0; i < 8; ++i) *(LAS f32x4*)(scr + (8 * i + kr) * 36 + 4 * n4) = v[i];
    asm volatile("s_waitcnt lgkmcnt(0)" ::: "memory");
    const int c = lane & 7;
#pragma unroll
    for (int j = 0; j < 4; ++j) { const int n = (lane >> 3) + 8 * j; const LAS float* s = scr + (8 * c) * 36 + n;
        if (f8s != 0.f) { const int p0 = f8x4(s[0 * 36] * f8s, s[1 * 36] * f8s, s[2 * 36] * f8s, s[3 * 36] * f8s), p1 = f8x4(s[4 * 36] * f8s, s[5 * 36] * f8s, s[6 * 36] * f8s, s[7 * 36] * f8s);
            u32x2 o8; o8.x = (unsigned)p0; o8.y = (unsigned)p1; *(u32x2*)((unsigned char*)dst + (size_t)n * K + k0 + 8 * c) = o8; }
        else {
        u32x4 o; o.x = pk2(s[0 * 36], s[1 * 36]); o.y = pk2(s[2 * 36], s[3 * 36]); o.z = pk2(s[4 * 36], s[5 * 36]); o.w = pk2(s[6 * 36], s[7 * 36]);
        *(u32x4*)(dst + (size_t)n * K + k0 + 8 * c) = o; } }
    asm volatile("s_waitcnt lgkmcnt(0)" ::: "memory");
}
__device__ __forceinline__ int w1_src(int n) {
    const int T = n >> 8, tc = n & 255, p = tc & 127, sec = tc >> 7;
    switch (T) {
        case 0: return 672 + (p >> 5) * 64 + (p & 31) + 32 * sec;
        case 1: return 672 + (4 + (p >> 5)) * 64 + (p & 31) + 32 * sec;
        case 2: return 1764 + (p >> 5) * 64 + (p & 31) + 32 * sec;
        case 3: return 1764 + (4 + (p >> 5)) * 64 + (p & 31) + 32 * sec;
        case 4: return 1440 + (p >> 5) * 64 + (p & 31) + 32 * sec;
        case 5: return (p < 64) ? 1184 + (p >> 5) * 64 + (p & 31) + 32 * sec : 2276 + ((p - 64) >> 5) * 64 + (p & 31) + 32 * sec;
        case 6: return (p < 32) ? 1696 + p + 32 * sec : ((p < 48) ? 640 + (p - 32) + 16 * sec : -1);
        case 7: return tc;
        case 8: return (tc < 128) ? 256 + tc : 1312 + (tc - 128);
        case 9: return 384 + tc;
        default: return (tc < 128) ? 2404 + tc : ((tc < 132) ? 1760 + (tc - 128) : -1);
    }
}
__device__ __forceinline__ int wuq_src(int n) { const int T = n >> 8, tc = n & 255; if (T < 2) return (4 * T + (tc >> 6)) * 96 + (tc & 63); const int p = tc & 127, sec = tc >> 7; return (p >> 4) * 96 + 64 + (p & 15) + 16 * sec; }
__device__ __forceinline__ int wukv_src(int n) { const int T = n >> 8, tc = n & 255; return (T < 2) ? (4 * T + (tc >> 6)) * 128 + (tc & 63) : (4 * (T - 2) + (tc >> 6)) * 128 + 64 + (tc & 63); }

__device__ __forceinline__ void convert_phase(KernArgP P, unsigned char* ws, int layer, LAS unsigned char* lds, int gw, int NGW, int wave, int lane, int part = -1, unsigned* qcnt = nullptr) {
    LAS float* scr = (LAS float*)(lds + wave * 16384);
    constexpr int I_W1 = 88 * 16, I_WG = 96 * 16, I_UQ = 24 * 6, I_UKV = 32 * 4, I_BR = 3 * 32 * 8, I_OUT = 32 * 16, I_GU = 16 * 32 * 16, I_DN = 16 * 32 * 8;
    constexpr int NITEMS = I_W1 + I_WG + I_UQ + I_UKV + I_BR + I_OUT + I_GU + I_DN, I_MIX = I_W1 + I_WG + I_UQ + I_UKV + I_BR + I_OUT;
    const float* w_in = P->w_in + (size_t)layer * DM * INC;
    const int ln = 4 * (lane & 7);
    const int it_lo = (part == 1) ? I_MIX : 0, it_hi = (part == 0) ? I_MIX : NITEMS;
    int it = it_lo + gw, chunk_end = 0;
    if (qcnt) { it = 0; chunk_end = 0; }
    for (;;) {
        if (qcnt) {
            if (it >= chunk_end) { unsigned b_ = 0u; if (lane == 0) b_ = __hip_atomic_fetch_add(qcnt, 8u, __ATOMIC_RELAXED, __HIP_MEMORY_SCOPE_AGENT); it = it_lo + (int)__builtin_amdgcn_readfirstlane((int)b_); chunk_end = it + 8; }
            if (it >= it_hi) break;
        } else if (it >= it_hi) break;
        const int it_cur = it; it += qcnt ? 1 : NGW;
        int q = it_cur;
        if (q < I_W1) { const int kb = q / 88, nb = q % 88, s = w1_src(32 * nb + ln);
            if (P1_F8) conv_item(s >= 0 ? w_in + s : nullptr, INC, nullptr, (bf16_t*)((unsigned char*)(ws + WB_W1) + (size_t)(32 * nb) * 1024), 1024, 64 * kb, scr, lane, 32.0f);
            else conv_item(s >= 0 ? w_in + s : nullptr, INC, nullptr, (bf16_t*)(ws + WB_W1) + (size_t)(32 * nb) * 1024, 1024, 64 * kb, scr, lane); continue; } q -= I_W1;
        if (q < I_WG) { const int kb = q / 96, nb = q % 96;
            if (GATE_F8) conv_item(w_in + 2532 + 32 * nb + ln, INC, nullptr, (bf16_t*)((unsigned char*)(ws + WB_WG) + (size_t)(32 * nb) * 1024), 1024, 64 * kb, scr, lane, 32.0f);
            else conv_item(w_in + 2532 + 32 * nb + ln, INC, nullptr, (bf16_t*)(ws + WB_WG) + (size_t)(32 * nb) * 1024, 1024, 64 * kb, scr, lane);
            continue; } q -= I_WG;
        if (q < I_UQ) { const int kb = q / 24, nb = q % 24;
            conv_item(P->a_w_uq + (size_t)layer * 384 * 768 + wuq_src(32 * nb + ln), 768, P->a_q_ln_g + layer * 384, (bf16_t*)(ws + WB_WUQ) + (size_t)(32 * nb) * 384, 384, 64 * kb, scr, lane); continue; } q -= I_UQ;
        if (q < I_UKV) { const int kb = q / 32, nb = q % 32;
            conv_item(P->a_w_ukv + (size_t)layer * 256 * 1024 + wukv_src(32 * nb + ln), 1024, P->a_kv_ln_g + layer * 256, (bf16_t*)(ws + WB_WUKV) + (size_t)(32 * nb) * 256, 256, 64 * kb, scr, lane); continue; } q -= I_UKV;
        if (q < I_BR) { const int br = q / 256, qq = q % 256, kb = qq / 32, nb = qq % 32; const float* src = (br == 0 ? P->w_br_a : (br == 1 ? P->w_br_b : P->w_br_c)) + (size_t)layer * 512 * 1024;
            if (BR_F8) conv_item(src + 32 * nb + ln, 1024, nullptr, (bf16_t*)((unsigned char*)(ws + WB_WBR) + (size_t)(br * 1024 + 32 * nb) * 512), 512, 64 * kb, scr, lane, 32.0f);
            else conv_item(src + 32 * nb + ln, 1024, nullptr, (bf16_t*)(ws + WB_WBR) + (size_t)(br * 1024 + 32 * nb) * 512, 512, 64 * kb, scr, lane);
            continue; } q -= I_BR;
        if (q < I_OUT) { const int kb = q / 32, nb = q % 32;
            if (OUT_F8) conv_item(P->w_out + (size_t)layer * 1024 * 1024 + 32 * nb + ln, 1024, nullptr, (bf16_t*)((unsigned char*)(ws + WB_WOUT) + (size_t)(32 * nb) * 1024), 1024, 64 * kb, scr, lane, 32.0f);
            else conv_item(P->w_out + (size_t)layer * 1024 * 1024 + 32 * nb + ln, 1024, nullptr, (bf16_t*)(ws + WB_WOUT) + (size_t)(32 * nb) * 1024, 1024, 64 * kb, scr, lane);
            continue; } q -= I_OUT;
        if (q < I_GU) { const int e = q / 512, qq = q % 512, kb = qq / 32, nb = qq % 32, n = 32 * nb + ln, jt = n >> 8, tc = n & 255;
            const float* src = (tc < 128 ? P->w_exp_gate : P->w_exp_up) + ((size_t)layer * NEXP + e) * 1024 * 512 + 128 * jt + (tc & 127);
            if (MOE_F8) conv_item(src, 512, nullptr, (bf16_t*)((unsigned char*)(ws + WB_WGU) + (size_t)(e * 1024 + 32 * nb) * 1024), 1024, 64 * kb, scr, lane, 32.0f);
            else conv_item(src, 512, nullptr, (bf16_t*)(ws + WB_WGU) + (size_t)(e * 1024 + 32 * nb) * 1024, 1024, 64 * kb, scr, lane);
            continue; } q -= I_GU;
        { const int e = q / 256, qq = q % 256, kb = qq / 32, nb = qq % 32;
            if (MOE_F8) conv_item(P->w_exp_down + ((size_t)layer * NEXP + e) * 512 * 1024 + 32 * nb + ln, 1024, nullptr, (bf16_t*)((unsigned char*)(ws + WB_WDN) + (size_t)(e * 1024 + 32 * nb) * 512), 512, 64 * kb, scr, lane, 32.0f);
            else conv_item(P->w_exp_down + ((size_t)layer * NEXP + e) * 512 * 1024 + 32 * nb + ln, 1024, nullptr, (bf16_t*)(ws + WB_WDN) + (size_t)(e * 1024 + 32 * nb) * 512, 512, 64 * kb, scr, lane); }
    }
}

__device__ __forceinline__ void prep_phase(KernArgP P, unsigned char* ws, LAS unsigned char* lds, int gw, int NGW, int wave, int lane) {
    const int gt = gw * 64 + lane, NGT = NGW * 64;
    for (int i = gt; i < 1024; i += NGT) ((unsigned*)(ws + WS_CNT))[i] = 0u;
    for (int i = gt; i < DEPTH * 2 * NT; i += NGT) ((u64*)(ws + WS_SSQ))[i] = 0ull;
    for (int i = gt; i < SEQ * 48; i += NGT) {
        const int t = i / 48, k = i % 48; const int half = (k < 32) ? 32 : 16, idx = (k < 32) ? k : k - 32;
        const float inv = (float)pow(10000.0, -(double)idx / (double)half); const float ang = (float)t * inv;
        f32x2 cs; cs.x = (float)cos((double)ang); cs.y = (float)sin((double)ang);
        if (k < 32) ((f32x2*)(ws + WS_CS64))[t * 32 + idx] = cs; else ((f32x2*)(ws + WS_CS32))[t * 16 + idx] = cs;
    }
    f32x4 vn[4];
    if (gw < NT) {
#pragma unroll
        for (int j = 0; j < 4; ++j) vn[j] = *(const f32x4*)(P->x + (size_t)gw * DM + 4 * lane + 256 * j);
    }
    for (int row = gw; row < NT; row += NGW) {
        f32x4 v[4];
#pragma unroll
        for (int j = 0; j < 4; ++j) v[j] = vn[j];
        if (row + NGW < NT) {
#pragma unroll
            for (int j = 0; j < 4; ++j) vn[j] = *(const f32x4*)(P->x + (size_t)(row + NGW) * DM + 4 * lane + 256 * j);
        }
        ln_rows(v, P->ln_in_g, P->ln_in_b, lane);
        store_row(v, nullptr, (bf16_t*)(ws + WS_XB) + (size_t)row * DM, lane, GATE_F8 ? (unsigned char*)(ws + R_XB8) + (size_t)row * DM : nullptr);
    }
}

__device__ __forceinline__ void ln1_router_phase(KernArgP P, unsigned char* ws, int layer, LAS unsigned char* lds, int gw, int NGW, int lane, int tid, int bid) {
    LAS float* WRT = (LAS float*)lds;
    LAS unsigned* LCNT = (LAS unsigned*)(lds + 65536);
    if (tid < 16) LCNT[tid] = 0u;
    for (int i = tid; i < 16 * 1024; i += 512) { const int d = i >> 4, e = i & 15; WRT[e * 1024 + d] = P->w_router[i]; }
    __syncthreads();
#if X_HILO
    u32x2 hn[4], ln_[4];
#define RT_LOAD(ROW) do { _Pragma("unroll") for (int j = 0; j < 4; ++j) { hn[j] = *(const u32x2*)((const bf16_t*)(ws + WS_XB) + (size_t)(ROW) * DM + 4 * lane + 256 * j); ln_[j] = *(const u32x2*)((const bf16_t*)P->out + (size_t)(ROW) * DM + 4 * lane + 256 * j); } } while (0)
    if (gw < NT) RT_LOAD(gw);
    for (int row = gw; row < NT; row += NGW) {
        f32x4 v[4];
#pragma unroll
        for (int j = 0; j < 4; ++j) { v[j][0] = bf_lo(hn[j].x) + bf_lo(ln_[j].x); v[j][1] = bf_hi(hn[j].x) + bf_hi(ln_[j].x); v[j][2] = bf_lo(hn[j].y) + bf_lo(ln_[j].y); v[j][3] = bf_hi(hn[j].y) + bf_hi(ln_[j].y); }
        if (row + NGW < NT) RT_LOAD(row + NGW);
        if (MOE_F8) {
#pragma unroll
            for (int j = 0; j < 4; ++j) *(unsigned*)((unsigned char*)(ws + R_XB8) + (size_t)row * DM + 4 * lane + 256 * j) = (unsigned)f8x4(v[j][0], v[j][1], v[j][2], v[j][3]);
        }
#else
    f32x4 vn[4];
    if (gw < NT) {
#pragma unroll
        for (int j = 0; j < 4; ++j) vn[j] = *(const f32x4*)(P->out + (size_t)gw * DM + 4 * lane + 256 * j);
    }
    for (int row = gw; row < NT; row += NGW) {
        f32x4 v[4];
#pragma unroll
        for (int j = 0; j < 4; ++j) v[j] = vn[j];
        if (row + NGW < NT) {
#pragma unroll
            for (int j = 0; j < 4; ++j) vn[j] = *(const f32x4*)(P->out + (size_t)(row + NGW) * DM + 4 * lane + 256 * j);
        }
#endif
        float pe[16];
#pragma unroll
        for (int e = 0; e < 16; ++e) { float a = 0.f;
#pragma unroll
            for (int j = 0; j < 4; ++j) { const f32x4 wv = *(const LAS f32x4*)(WRT + e * 1024 + 4 * lane + 256 * j); a += (v[j][0] * wv[0] + v[j][1] * wv[1]) + (v[j][2] * wv[2] + v[j][3] * wv[3]); }
            pe[e] = a; if ((e & 3) == 3) asm volatile("" ::: "memory"); }
        float r8[8], r4[4], r2[2], r1;
        { const bool hi = (lane & 32) != 0;
#pragma unroll
          for (int k = 0; k < 8; ++k) { const float keep = hi ? pe[k + 8] : pe[k], send = hi ? pe[k] : pe[k + 8]; r8[k] = keep + shx(send, 32, lane); } }
        { const bool hi = (lane & 16) != 0;
#pragma unroll
          for (int k = 0; k < 4; ++k) { const float keep = hi ? r8[k + 4] : r8[k], send = hi ? r8[k] : r8[k + 4]; r4[k] = keep + shx(send, 16, lane); } }
        { const bool hi = (lane & 8) != 0;
#pragma unroll
          for (int k = 0; k < 2; ++k) { const float keep = hi ? r4[k + 2] : r4[k], send = hi ? r4[k] : r4[k + 2]; r2[k] = keep + shx(send, 8, lane); } }
        { const bool hi = (lane & 4) != 0; const float keep = hi ? r2[1] : r2[0], send = hi ? r2[0] : r2[1]; r1 = keep + shx(send, 4, lane); }
        r1 += shx(r1, 2, lane); r1 += shx(r1, 1, lane);
        float lg[16];
#pragma unroll
        for (int e = 0; e < 16; ++e) lg[e] = __int_as_float(__builtin_amdgcn_readlane(__float_as_int(r1), 4 * e));
        float sco[16], bsd[16];
#pragma unroll
        for (int e = 0; e < 16; ++e) { sco[e] = __builtin_amdgcn_rcpf(1.0f + __builtin_amdgcn_exp2f(-lg[e] * 1.4426950408889634f)); bsd[e] = sco[e] + P->router_bias[e]; }
        float best_gs = -3.0e38f; int gsel = 0; int i1s = 0, i2s = 1; float w1s = 0.f, w2s = 0.f;
#pragma unroll
        for (int g = 0; g < 4; ++g) {
            int i1 = 0; float b1 = bsd[4 * g], s1 = sco[4 * g];
#pragma unroll
            for (int k = 1; k < 4; ++k) if (bsd[4 * g + k] > b1) { b1 = bsd[4 * g + k]; s1 = sco[4 * g + k]; i1 = k; }
            int i2 = -1; float b2 = -3.0e38f, s2 = 0.f;
#pragma unroll
            for (int k = 0; k < 4; ++k) if (k != i1 && bsd[4 * g + k] > b2) { b2 = bsd[4 * g + k]; s2 = sco[4 * g + k]; i2 = k; }
            const float gs = b1 + b2;
            if (gs > best_gs) { best_gs = gs; gsel = g; i1s = 4 * g + i1; i2s = 4 * g + i2; w1s = s1; w2s = s2; }
        }
        (void)gsel;
        if (lane == 0) {
            const float ws_ = w1s + w2s; const float wa = w1s / ws_, wb = w2s / ws_;
            const unsigned sl1 = __hip_atomic_fetch_add(LCNT + i1s, 1u, __ATOMIC_RELAXED, __HIP_MEMORY_SCOPE_WORKGROUP), sl2 = __hip_atomic_fetch_add(LCNT + i2s, 1u, __ATOMIC_RELAXED, __HIP_MEMORY_SCOPE_WORKGROUP);
            int* rt = (int*)(ws + WS_ROUTE) + (size_t)row * 6;
            rt[0] = i1s; rt[1] = i2s; rt[2] = (int)sl1; rt[3] = (int)sl2; ((float*)rt)[4] = wa; ((float*)rt)[5] = wb;
        }
    }
    __syncthreads();
    if (tid < 16) ((unsigned*)(ws + WS_WGCNT))[bid * 16 + tid] = LCNT[tid];
}
__device__ __forceinline__ void moe_tiles(const unsigned* CNT, int (&ts)[16], int (&cn)[16], int& ntiles) {
    int acc = 0;
#pragma unroll
    for (int e = 0; e < 16; ++e) { cn[e] = (int)__builtin_amdgcn_readfirstlane(CNT[e]); ts[e] = acc; acc += (cn[e] + 255) >> 8; }
    ntiles = acc;
}
__device__ __forceinline__ void gather_phase(unsigned char* ws, int layer, LAS unsigned char* lds, int gw, int NGW, int lane, int tid, int bid, int G) {
    LAS unsigned* RAW = (LAS unsigned*)lds;
    LAS unsigned* PART = RAW + 4096;
    LAS int* TS = (LAS int*)(PART + 1024);
    LAS int* CN = TS + 16;
    const unsigned* WGC = (const unsigned*)(ws + WS_WGCNT);
    for (int i = tid; i < 4096; i += 512) RAW[i] = (i < G * 16) ? WGC[i] : 0u;
    __syncthreads();
    { const int e = tid & 15, part = tid >> 4; unsigned tot = 0u, pre = 0u;
#pragma unroll
      for (int k = 0; k < 8; ++k) { const int b2 = part * 8 + k; const unsigned v = RAW[b2 * 16 + e]; tot += v; pre += (b2 < bid) ? v : 0u; }
      PART[part * 32 + e] = tot; PART[part * 32 + 16 + e] = pre; }
    __syncthreads();
    if (tid < 16) { unsigned tot = 0u, pre = 0u;
        for (int p2 = 0; p2 < 32; ++p2) { tot += PART[p2 * 32 + tid]; pre += PART[p2 * 32 + 16 + tid]; }
        CN[tid] = (int)tot; TS[tid] = (int)pre;
        if (bid == 0) ((unsigned*)(ws + WS_CNT))[layer * 16 + tid] = tot; }
    __syncthreads();
    int ts[16], cn[16];
    { int acc = 0;
#pragma unroll
      for (int e = 0; e < 16; ++e) { cn[e] = __builtin_amdgcn_readfirstlane(CN[e]); ts[e] = acc; acc += (cn[e] + 255) >> 8; } }
    __syncthreads();
    if (tid < 16) { int base = 0;
#pragma unroll
        for (int e = 0; e < 16; ++e) if (e == tid) base = 256 * ts[e];
        TS[tid] += base; }
    __syncthreads();
    int* ROWTOK = (int*)(ws + WS_ROWTOK); float* ROWW = (float*)(ws + WS_ROWW);
    if (NGW * 8 == NT) {
        int ev[8], sv[8]; float wv[8];
        if (lane < 2) {
#pragma unroll
            for (int k = 0; k < 8; ++k) { const int* rt = (const int*)(ws + WS_ROUTE) + (size_t)(gw + k * NGW) * 6; ev[k] = rt[lane]; sv[k] = rt[2 + lane]; wv[k] = ((const float*)rt)[4 + lane]; }
            __builtin_amdgcn_sched_barrier(0);
#pragma unroll
            for (int k = 0; k < 8; ++k) { const int row = TS[ev[k]] + sv[k]; ROWTOK[row] = 2 * (gw + k * NGW) + lane; ROWW[row] = wv[k]; }
        }
    } else
    for (int t = gw; t < NT; t += NGW) {
        if (lane < 2) { const int* rt = (const int*)(ws + WS_ROUTE) + (size_t)t * 6; const int e = rt[lane], slot = rt[2 + lane]; const int row = TS[e] + slot;
            ROWTOK[row] = 2 * t + lane; ROWW[row] = ((const float*)rt)[4 + lane]; }
    }
#pragma unroll
    for (int e = 0; e < 16; ++e) {
        const int tiles = (cn[e] + 255) >> 8;
        for (int pr = cn[e] + gw * 64 + lane; pr < 256 * tiles; pr += NGW * 64) { const int row = 256 * ts[e] + pr; ROWTOK[row] = -1; ROWW[row] = 0.f; }
    }
}
__device__ __forceinline__ void ln2_phase(KernArgP P, unsigned char* ws, int layer, int gw, int NGW, int lane, float* outp, bf16_t* xbp) { const bf16_t* Y2 = (const bf16_t*)(ws + R_Y2);
    u32x2 xa[4], y0a[4], y1a[4], xb[4], y0b[4], y1b[4];
#if Y2_F8
#define LN2_LOAD(S, ROW) do { _Pragma("unroll") for (int j = 0; j < 4; ++j) { x##S[j] = *(const u32x2*)((const bf16_t*)(ws + WS_XB) + (size_t)(ROW) * DM + 4 * lane + 256 * j); \
        y0##S[j].x = *(const unsigned*)((const unsigned char*)Y2 + (size_t)(2 * (ROW)) * DM + 4 * lane + 256 * j); y1##S[j].x = *(const unsigned*)((const unsigned char*)Y2 + (size_t)(2 * (ROW) + 1) * DM + 4 * lane + 256 * j); } } while (0)
#else
#define LN2_LOAD(S, ROW) do { _Pragma("unroll") for (int j = 0; j < 4; ++j) { x##S[j] = *(const u32x2*)((const bf16_t*)(ws + WS_XB) + (size_t)(ROW) * DM + 4 * lane + 256 * j); \
        y0##S[j] = *(const u32x2*)(Y2 + (size_t)(2 * (ROW)) * DM + 4 * lane + 256 * j); y1##S[j] = *(const u32x2*)(Y2 + (size_t)(2 * (ROW) + 1) * DM + 4 * lane + 256 * j); } } while (0)
#endif
#if Y2_F8
#define LN2_YSUM(V, X, Y0, Y1) do { const f32x2 a0_ = __builtin_amdgcn_cvt_pk_f32_fp8((int)(Y0).x, false), a1_ = __builtin_amdgcn_cvt_pk_f32_fp8((int)(Y0).x, true), b0_ = __builtin_amdgcn_cvt_pk_f32_fp8((int)(Y1).x, false), b1_ = __builtin_amdgcn_cvt_pk_f32_fp8((int)(Y1).x, true); \
        V[0] = X[0] * ALPHA + (a0_.x + b0_.x) * (1.0f / Y2_SCALE); V[1] = X[1] * ALPHA + (a0_.y + b0_.y) * (1.0f / Y2_SCALE); V[2] = X[2] * ALPHA + (a1_.x + b1_.x) * (1.0f / Y2_SCALE); V[3] = X[3] * ALPHA + (a1_.y + b1_.y) * (1.0f / Y2_SCALE); } while (0)
#else
#define LN2_YSUM(V, X, Y0, Y1) do { const u32x2 y0 = (Y0), y1 = (Y1); \
        V[0] = X[0] * ALPHA + (bf_lo(y0.x) + bf_lo(y1.x)); V[1] = X[1] * ALPHA + (bf_hi(y0.x) + bf_hi(y1.x)); V[2] = X[2] * ALPHA + (bf_lo(y0.y) + bf_lo(y1.y)); V[3] = X[3] * ALPHA + (bf_hi(y0.y) + bf_hi(y1.y)); } while (0)
#endif
#define LN2_ROW(S, ROW, NEXT) do { f32x4 v[4]; \
        _Pragma("unroll") for (int j = 0; j < 4; ++j) { \
            const u32x2 xw = x##S[j]; const f32x4 x = {bf_lo(xw.x), bf_hi(xw.x), bf_lo(xw.y), bf_hi(xw.y)}; \
            LN2_YSUM(v[j], x, y0##S[j], y1##S[j]); } \
        if ((NEXT) < NT) LN2_LOAD(S, NEXT); \
        ln_rows(v, P->ln2_g + layer * DM, P->ln2_b + layer * DM, lane); \
        store_row(v, outp ? outp + (size_t)(ROW) * DM : nullptr, xbp ? xbp + (size_t)(ROW) * DM : nullptr, lane, (GATE_F8 && xbp) ? (unsigned char*)(ws + R_XB8) + (size_t)(ROW) * DM : nullptr); } while (0)
    if (gw < NT) LN2_LOAD(a, gw);
    if (gw + NGW < NT) LN2_LOAD(b, gw + NGW);
    for (int row = gw; row < NT; row += 2 * NGW) {
        LN2_ROW(a, row, row + 2 * NGW);
        if (row + NGW < NT) LN2_ROW(b, row + NGW, row + 3 * NGW);
    }
#undef LN2_ROW
#undef LN2_YSUM
#undef LN2_LOAD
}
#ifndef XB_FLAT
#define XB_FLAT 1
#endif
#define XB_TMO      128
#define XB_XCNT(j)  (256  + 64 * (j))
#define XB_XSUB(j)  (1280 + 64 * (j))
#define XB_XGEN(j)  (2304 + 64 * (j))
#define XB_TOP      3328
#define XB_TOPGEN   3392
#define XCD_BAR_WORDS 3456
#define XB_SPIN_CAP (1u << 18)
__device__ __forceinline__ unsigned xb_ld(unsigned* p)              { return __hip_atomic_load(p, __ATOMIC_RELAXED, __HIP_MEMORY_SCOPE_AGENT); }
__device__ __forceinline__ unsigned xb_add(unsigned* p, unsigned v) { return __hip_atomic_fetch_add(p, v, __ATOMIC_RELAXED, __HIP_MEMORY_SCOPE_AGENT); }
__device__ __forceinline__ unsigned xb_xcc_id() { return (unsigned)__builtin_amdgcn_s_getreg((3 << 11) | 20) & 0xFu; }
#define XB_SPIN(cond, bar) do { unsigned _sp = 0; while (cond) { __builtin_amdgcn_s_sleep(1); \
    if ((++_sp & 255u) == 0u) { if (xb_ld(&(bar)[XB_TMO])) break; if (_sp > XB_SPIN_CAP) { atomicAdd(&(bar)[XB_TMO], 1u); break; } } } } while (0)
struct XcdBarrier { unsigned* bar; unsigned x; volatile LAS unsigned* st; };
__device__ __forceinline__ XcdBarrier xcd_barrier_post(unsigned* bar, volatile LAS unsigned* st, int tid) {
    XcdBarrier b; b.bar = bar; b.x = xb_xcc_id(); b.st = st;
    if (tid == 0) (void)xb_add(&bar[XB_XCNT(b.x)], 1u);
    return b;
}
__device__ __forceinline__ void xcd_barrier_complete(unsigned* bar, unsigned x, unsigned G, unsigned& nloc, unsigned& nx) {
    unsigned sum, cnt, mine, sp = 0u;
    for (;;) {
        sum = 0u; cnt = 0u; mine = 0u;
#pragma unroll
        for (unsigned j = 0; j < 16; ++j) { const unsigned c = xb_ld(&bar[XB_XCNT(j)]); sum += c; cnt += (c > 0u) ? 1u : 0u; mine = (j == x) ? c : mine; }
        if (sum == G) break;
        __builtin_amdgcn_s_sleep(1);
        if ((++sp & 255u) == 0u) { if (xb_ld(&bar[XB_TMO])) break; if (sp > XB_SPIN_CAP) { atomicAdd(&bar[XB_TMO], 1u); break; } }
    }
    nloc = mine > 0u ? mine : 1u; nx = cnt > 0u ? cnt : 1u;
}
__device__ __forceinline__ void xcd_barrier(const XcdBarrier& b, int tid, unsigned G) {
    asm volatile("s_waitcnt vmcnt(0)" ::: "memory");
    __syncthreads();
    if (tid == 0) {
        unsigned* bar = b.bar;
        __builtin_amdgcn_s_waitcnt(0);
        unsigned nloc = b.st[0], nx = b.st[1];
        if (nloc == 0u) { xcd_barrier_complete(bar, b.x, G, nloc, nx); b.st[0] = nloc; b.st[1] = nx; }
        const unsigned old = xb_add(&bar[XB_XSUB(b.x)], 1u);
        const unsigned gen = old / nloc;
        if (old + 1u == (gen + 1u) * nloc) {
            __builtin_amdgcn_fence(__ATOMIC_RELEASE, "agent");
            asm volatile("s_waitcnt vmcnt(0)" ::: "memory");
            const unsigned og = xb_add(&bar[XB_TOP], 1u);
            const unsigned tg = og / nx;
            if (og + 1u == (tg + 1u) * nx) xb_add(&bar[XB_TOPGEN], 1u);
            else XB_SPIN(xb_ld(&bar[XB_TOPGEN]) == tg, bar);
            __builtin_amdgcn_fence(__ATOMIC_ACQUIRE, "agent");
            if (!XB_FLAT) xb_add(&bar[XB_XGEN(b.x)], 1u);
            asm volatile("s_waitcnt vmcnt(0)" ::: "memory");
        } else {
            if (XB_FLAT) XB_SPIN(xb_ld(&bar[XB_TOPGEN]) == gen, bar);
            else XB_SPIN(xb_ld(&bar[XB_XGEN(b.x)]) == gen, bar);
            __builtin_amdgcn_fence(__ATOMIC_ACQUIRE, "agent");
            asm volatile("s_waitcnt vmcnt(0)" ::: "memory");
        }
    }
    __syncthreads();
}
#define PHASE_BEGIN() int lane; asm volatile("v_mbcnt_lo_u32_b32 %0, -1, 0\n\tv_mbcnt_hi_u32_b32 %0, -1, %0" : "=v"(lane)); int wave = wave0; asm volatile("" : "+s"(wave)); \
    const int tid = wave * 64 + lane; KernArgP kp_ = (KernArgP)__builtin_amdgcn_kernarg_segment_ptr(); asm volatile("" : "+s"(kp_)); KernArgP P = kp_;     \
    size_t z_ = 0; asm volatile("" : "+s"(z_)); unsigned char* ws = P->ws + z_; const int gw = bid * 8 + wave; int G = G0; asm volatile("" : "+s"(G)); const int NGW = G * 8; (void)tid; (void)gw; (void)NGW;
__global__ void __launch_bounds__(512, 2) mk_forward(Params Pkernarg) {
    extern __shared__ __attribute__((aligned(128))) unsigned char smem[];
    LAS unsigned char* lds = (LAS unsigned char*)smem;
    const int G0 = gridDim.x, bid = blockIdx.x, wave0 = __builtin_amdgcn_readfirstlane(threadIdx.x >> 6);
    XcdBarrier xbar;
    { PHASE_BEGIN(); volatile LAS unsigned* st = (volatile LAS unsigned*)(lds + LDS_MISC); if (tid < 2) st[tid] = 0u; __syncthreads();
      xbar = xcd_barrier_post((unsigned*)(ws + WS_BAR), st, tid); (void)xbar; }
#ifndef P2_SPLIT
#define P2_SPLIT 0
#endif
#ifndef GATE_F8MMA
#define GATE_F8MMA true
#endif
#ifndef CV_SPLIT
#define CV_SPLIT 0
#endif
#ifndef GB_ALIGN
#define GB_ALIGN 1
#endif
#define GRID_BAR() do { PHASE_BEGIN(); XcdBarrier xb_; xb_.bar = (unsigned*)(ws + WS_BAR); xb_.x = xb_xcc_id(); xb_.st = (volatile LAS unsigned*)(lds + LDS_MISC); xcd_barrier(xb_, tid, (unsigned)G); } while (0)
    { PHASE_BEGIN(); prep_phase(P, ws, lds, gw, NGW, wave, lane); }
    { PHASE_BEGIN(); convert_phase(P, ws, 0, lds, gw, NGW, wave, lane); }
    for (int layer = 0; layer < DEPTH; ++layer) {
        if (G0 > 65535) cg::this_grid().sync();
        GRID_BAR();
        {
            PHASE_BEGIN();
#if P1_F8
            pg8::Gemm g{(const bf16_t*)(ws + R_XB8), (const bf16_t*)(ws + WB_W1), 512, nullptr}; pg8::StaticOrder S; S.init(NT, 2816, G, bid);
            Epi1 E{ws, layer, 1.0f / 32.0f};
            pg8::gemm_phase<Epi1, pg8::StaticOrder, true, true, false, true>(lds, g, S, E, tid);
#else
            pg8::Gemm g{(const bf16_t*)(ws + WS_XB), (const bf16_t*)(ws + WB_W1), 1024, nullptr}; pg8::StaticOrder S; S.init(NT, 2816, G, bid);
            Epi1 E{ws, layer};
            pg8::gemm_phase<Epi1, pg8::StaticOrder, true, true>(lds, g, S, E, tid);
#endif
        }
#ifdef P1_PROBE_REPS
        if (layer == 1) {
#pragma unroll 1
            for (int rep_ = 0; rep_ < P1_PROBE_REPS; ++rep_) {
                PHASE_BEGIN();
                pg8::Gemm g{(const bf16_t*)(ws + WS_XB), (const bf16_t*)(ws + WB_W1), 1024, nullptr}; pg8::StaticOrder S; S.init(NT, 2816, G, bid);
#ifdef P1_PROBE_NOEPI
                EpiNull E{(float*)(ws + WS_CVQ)};
                pg8::gemm_phase<EpiNull, pg8::StaticOrder, true, true>(lds, g, S, E, tid);
#else
                Epi1 E{ws, 0};
                pg8::gemm_phase<Epi1, pg8::StaticOrder, true, true>(lds, g, S, E, tid);
#endif
            }
        }
#endif
        GRID_BAR();
        {
#if P2_SPLIT
            { PHASE_BEGIN(); pg8::Gemm g{(const bf16_t*)(ws + R_KVLAT), (const bf16_t*)(ws + WB_WUKV), 256, nullptr}; SchedSub S; S.on = (G == 256) && bid < 128; S.S.init(NT, 1024, 128, bid & 127); EpiUKV E{ws, layer};
              if (G != 256) { S.on = true; S.S.init(NT, 1024, G, bid); }
              pg8::gemm_phase<EpiUKV, SchedSub, true, true>(lds, g, S, E, tid); }
            { PHASE_BEGIN(); pg8::Gemm g{(const bf16_t*)(ws + R_QLAT), (const bf16_t*)(ws + WB_WUQ), 384, nullptr}; SchedSub S; S.on = (G == 256) && bid >= 128 && bid < 224; S.S.init(NT, 768, 96, (bid - 128) & 127); EpiUQ E{ws, layer};
              if (G != 256) { S.on = true; S.S.init(NT, 768, G, bid); }
              pg8::gemm_phase<EpiUQ, SchedSub, true, true>(lds, g, S, E, tid); }
#else
            { PHASE_BEGIN(); pg8::Gemm g{(const bf16_t*)(ws + R_KVLAT), (const bf16_t*)(ws + WB_WUKV), 256, nullptr}; pg8::StaticOrder S; S.init(NT, 1024, G, bid); EpiUKV E{ws, layer};
              pg8::gemm_phase<EpiUKV, pg8::StaticOrder, true, true>(lds, g, S, E, tid); }
            { PHASE_BEGIN(); pg8::Gemm g{(const bf16_t*)(ws + R_QLAT), (const bf16_t*)(ws + WB_WUQ), 384, nullptr}; pg8::StaticOrder S; S.init(NT, 768, G, (bid + 64) % G); EpiUQ E{ws, layer};
              pg8::gemm_phase<EpiUQ, pg8::StaticOrder, true, true>(lds, g, S, E, tid); }
#endif
        }
        { PHASE_BEGIN(); __syncthreads(); indexer_phase(ws, lds, G, bid, wave, lane, tid); }
#ifdef IDX_PROBE_REPS
#pragma unroll 1
        for (int rep_ = 0; rep_ < IDX_PROBE_REPS; ++rep_) { PHASE_BEGIN(); __syncthreads(); indexer_phase(ws, lds, G, bid, wave, lane, tid); }
#endif
        GRID_BAR();
        { PHASE_BEGIN(); attention_phase2(ws, lds, P->c_sinks + layer * 8, G, bid, tid, wave, lane); }
#ifdef A5_PROBE_WHICH
#ifndef A5_PROBE_REPS
#define A5_PROBE_REPS 1
#endif
#pragma unroll 1
        for (int rep_ = 0; rep_ < A5_PROBE_REPS; ++rep_) { PHASE_BEGIN(); attention_phase2(ws, lds, P->c_sinks + layer * 8, G, bid, tid, wave, lane, A5_PROBE_WHICH, true); }
#endif
        GRID_BAR();
        {
            PHASE_BEGIN();
#if GATE_F8
            pg8::Gemm g{(const bf16_t*)(ws + R_XB8), (const bf16_t*)(ws + WB_WG), 512, nullptr}; SchedGate S; S.S.init(NT, 1024, G, bid);
            EpiGate E{(bf16_t*)(ws + R_GATES), 1.0f / 32.0f};
            pg8::gemm_phase<EpiGate, SchedGate, GB_ALIGN != 0, true, false, GATE_F8MMA>(lds, g, S, E, tid);
#else
            pg8::Gemm g{(const bf16_t*)(ws + WS_XB), (const bf16_t*)(ws + WB_WG), 1024, nullptr}; SchedGate S; S.S.init(NT, 1024, G, bid);
            EpiGate E{(bf16_t*)(ws + R_GATES)};
            pg8::gemm_phase<EpiGate, SchedGate, true, true>(lds, g, S, E, tid);
#endif
        }
#ifdef P5_PROBE_REPS
#pragma unroll 1
        for (int rep_ = 0; rep_ < P5_PROBE_REPS; ++rep_) {
            PHASE_BEGIN();
            pg8::Gemm g{(const bf16_t*)(ws + WS_XB), (const bf16_t*)(ws + WB_WG), 1024, nullptr}; SchedGate S; S.S.init(NT, 1024, G, bid);
            EpiGate E{(bf16_t*)(ws + R_GATES)};
            pg8::gemm_phase<EpiGate, SchedGate, true, true>(lds, g, S, E, tid);
        }
#endif
        {
            PHASE_BEGIN();
#if BR_F8
            pg8::Gemm g{(const bf16_t*)(ws + WS_OABC), (const bf16_t*)(ws + WB_WBR), 256, nullptr}; SchedBr S; S.S.init(NT, 1024, G, bid);
            EpiBr E{(const bf16_t*)(ws + R_GATES), (bf16_t*)(ws + R_MERGED), 1.0f / 512.0f, OUT_F8 != 0};
            pg8::gemm_phase<EpiBr, SchedBr, GB_ALIGN != 0, true, false, true>(lds, g, S, E, tid);
#else
            pg8::Gemm g{(const bf16_t*)(ws + WS_OABC), (const bf16_t*)(ws + WB_WBR), 512, nullptr}; SchedBr S; S.S.init(NT, 1024, G, bid);
            EpiBr E{(const bf16_t*)(ws + R_GATES), (bf16_t*)(ws + R_MERGED)};
            pg8::gemm_phase<EpiBr, SchedBr, true, true>(lds, g, S, E, tid);
#endif
        }
#ifdef P6_PROBE_REPS
#pragma unroll 1
        for (int rep_ = 0; rep_ < P6_PROBE_REPS; ++rep_)
        {
            PHASE_BEGIN();
            pg8::Gemm g{(const bf16_t*)(ws + WS_OABC), (const bf16_t*)(ws + WB_WBR), 256, nullptr}; SchedBr S; S.S.init(NT, 1024, G, bid);
            EpiBr E{(const bf16_t*)(ws + R_GATES), (bf16_t*)(ws + R_MERGED), 1.0f / 512.0f, OUT_F8 != 0};
            pg8::gemm_phase<EpiBr, SchedBr, true, true, false, true>(lds, g, S, E, tid);
        }
#endif
        GRID_BAR();
        {
            PHASE_BEGIN();
            pg8::Gemm g{(const bf16_t*)(ws + R_MERGED), (const bf16_t*)(ws + WB_WOUT), OUT_F8 ? 512 : 1024, nullptr}; pg8::StaticOrder S; S.init(NT, 1024, G, bid);
            PanelStats st{(u64*)(ws + WS_XBUF), (unsigned*)(ws + WS_PCNT) + layer * 4096, LN_EPS};
            EpiOutLn E{P->out, (bf16_t*)(ws + WS_XB), P->ln1_g + layer * DM, P->ln1_b + layer * DM, st, (MOE_F8 && !X_HILO) ? (unsigned char*)(ws + R_XB8) : nullptr, OUT_F8 ? 1.0f / 512.0f : 1.0f};
            pg8::gemm_phase<EpiOutLn, pg8::StaticOrder, false, true, false, OUT_F8 != 0, OUT_CONTIG != 0>(lds, g, S, E, tid);
        }
        GRID_BAR();
        { PHASE_BEGIN(); ln1_router_phase(P, ws, layer, lds, gw, NGW, lane, tid, bid); }
        GRID_BAR();
        { PHASE_BEGIN(); gather_phase(ws, layer, lds, gw, NGW, lane, tid, bid, G); }
        GRID_BAR();
        {
            PHASE_BEGIN();
            SchedMoE S; int cn[16]; moe_tiles((const unsigned*)(ws + WS_CNT) + layer * 16, S.ts, cn, S.ntiles); S.G = G; S.c = (G == 256) ? ((bid & 7) * 32 + (bid >> 3)) : bid; S.hrdy = (unsigned*)(ws + WS_HRDY) + layer * 144 * 64;
#if MOE_F8
            pg8::Gemm g{(const bf16_t*)(ws + R_XB8), (const bf16_t*)(ws + WB_WGU), 512, (const int*)(ws + WS_ROWTOK)}; EpiGU E{(const float*)(ws + WS_ROWW), (bf16_t*)(ws + WS_H), 1.0f / 32.0f, true};
            pg8::gemm_phase<EpiGU, SchedMoE, true, true, true, true>(lds, g, S, E, tid);
#else
            pg8::Gemm g{(const bf16_t*)(ws + WS_XB), (const bf16_t*)(ws + WB_WGU), 1024, (const int*)(ws + WS_ROWTOK)}; EpiGU E{(const float*)(ws + WS_ROWW), (bf16_t*)(ws + WS_H)};
            pg8::gemm_phase<EpiGU, SchedMoE, true, true, true>(lds, g, S, E, tid);
#endif
        }
        {
            PHASE_BEGIN();
            SchedMoEDown S; int cn[16]; moe_tiles((const unsigned*)(ws + WS_CNT) + layer * 16, S.ts, cn, S.ntiles); S.G = G; S.c = (G == 256) ? ((bid & 7) * 32 + (bid >> 3)) : bid; S.hrdy = (unsigned*)(ws + WS_HRDY) + layer * 144 * 64;
            { const int rem = (4 * S.ntiles) % G; S.nheavy = (rem > 0 && 4 * rem <= G) ? rem : 0; }
#if MOE_F8
            pg8::Gemm g{(const bf16_t*)(ws + WS_H), (const bf16_t*)(ws + WB_WDN), 256, nullptr}; EpiDN E{(const int*)(ws + WS_ROWTOK), (bf16_t*)(ws + R_Y2), 1.0f / 256.0f};
            pg8::gemm_phase<EpiDN, SchedMoEDown, true, true, false, true, DN_CONTIG != 0>(lds, g, S, E, tid);
#else
            pg8::Gemm g{(const bf16_t*)(ws + WS_H), (const bf16_t*)(ws + WB_WDN), 512, nullptr}; EpiDN E{(const int*)(ws + WS_ROWTOK), (bf16_t*)(ws + R_Y2)};
            pg8::gemm_phase<EpiDN, SchedMoEDown, true, true>(lds, g, S, E, tid);
#endif
        }
#ifdef MOE_PROBE_REPS
#pragma unroll 1
        for (int rep_ = 0; rep_ < MOE_PROBE_REPS; ++rep_) {
        {
            PHASE_BEGIN();
            SchedMoE S; int cn[16]; moe_tiles((const unsigned*)(ws + WS_CNT) + layer * 16, S.ts, cn, S.ntiles); S.G = G; S.c = (G == 256) ? ((bid & 7) * 32 + (bid >> 3)) : bid; S.hrdy = (unsigned*)(ws + WS_HRDY) + layer * 144 * 64;
            pg8::Gemm g{(const bf16_t*)(ws + WS_XB), (const bf16_t*)(ws + WB_WGU), 1024, (const int*)(ws + WS_ROWTOK)}; EpiGU E{(const float*)(ws + WS_ROWW), (bf16_t*)(ws + WS_H)};
            pg8::gemm_phase<EpiGU, SchedMoE, true, true, true>(lds, g, S, E, tid);
        }
        {
            PHASE_BEGIN();
            SchedMoEDown S; int cn[16]; moe_tiles((const unsigned*)(ws + WS_CNT) + layer * 16, S.ts, cn, S.ntiles); S.G = G; S.c = (G == 256) ? ((bid & 7) * 32 + (bid >> 3)) : bid; S.hrdy = (unsigned*)(ws + WS_HRDY) + layer * 144 * 64;
            { const int rem = (4 * S.ntiles) % G; S.nheavy = (rem > 0 && 4 * rem <= G) ? rem : 0; }
            pg8::Gemm g{(const bf16_t*)(ws + WS_H), (const bf16_t*)(ws + WB_WDN), 512, nullptr}; EpiDN E{(const int*)(ws + WS_ROWTOK), (bf16_t*)(ws + R_Y2)};
            pg8::gemm_phase<EpiDN, SchedMoEDown, true, true>(lds, g, S, E, tid);
        }
        }
#endif
        GRID_BAR();
        { PHASE_BEGIN(); ln2_phase(P, ws, layer, gw, NGW, lane, (layer + 1 == DEPTH) ? P->out : nullptr, (layer + 1 == DEPTH) ? nullptr : (bf16_t*)(ws + WS_XB)); }
        if (layer + 1 < DEPTH) { PHASE_BEGIN(); __syncthreads(); convert_phase(P, ws, layer + 1, lds, gw, NGW, wave, lane); }
    }
}

extern "C" void kernel_launch(void* const* d_in, const int* in_sizes, int n_in, void* d_out, int out_size, void* d_ws, size_t ws_size, hipStream_t stream) {
    static int grid_blocks = 0;
    if (grid_blocks == 0) {
        if (n_in != 22 || out_size != NT * DM || ws_size < WS_END) { fprintf(stderr, "kernel_launch: unexpected problem (n_in %d, out %d, ws %zu < %zu)\n", n_in, out_size, ws_size, (size_t)WS_END); grid_blocks = -1; return; }
        int dev = 0, cus = 0, per_cu = 0;
        (void)hipGetDevice(&dev);
        (void)hipDeviceGetAttribute(&cus, hipDeviceAttributeMultiprocessorCount, dev);
        (void)hipFuncSetAttribute((const void*)mk_forward, hipFuncAttributeMaxDynamicSharedMemorySize, LDS_BYTES);
        if (hipOccupancyMaxActiveBlocksPerMultiprocessor(&per_cu, (const void*)mk_forward, 512, LDS_BYTES) != hipSuccess || per_cu < 1) { fprintf(stderr, "kernel_launch: occupancy query says %d blocks per CU\n", per_cu); grid_blocks = -1; return; }
        grid_blocks = 256; if (cus < 256) { fprintf(stderr, "kernel_launch: needs 256 CUs (fused LayerNorm epilogue: one 256x256 unit per workgroup)\n"); grid_blocks = -1; return; }
    }
    if (grid_blocks < 0) return;
    if (hipMemsetAsync((char*)d_ws + WS_BAR, 0, WS_SSQ - WS_BAR, stream) != hipSuccess) { fprintf(stderr, "kernel_launch: memset of the barrier words failed\n"); return; }
    Params p{};
    p.x = (const float*)d_in[0]; p.ln_in_g = (const float*)d_in[1]; p.ln_in_b = (const float*)d_in[2]; p.w_in = (const float*)d_in[3];
    p.a_q_ln_g = (const float*)d_in[4]; p.a_kv_ln_g = (const float*)d_in[5]; p.a_w_uq = (const float*)d_in[6]; p.a_w_ukv = (const float*)d_in[7];
    p.c_sinks = (const float*)d_in[8]; p.w_br_a = (const float*)d_in[9]; p.w_br_b = (const float*)d_in[10]; p.w_br_c = (const float*)d_in[11];
    p.w_out = (const float*)d_in[12]; p.ln1_g = (const float*)d_in[13]; p.ln1_b = (const float*)d_in[14]; p.w_router = (const float*)d_in[15];
    p.router_bias = (const float*)d_in[16]; p.w_exp_gate = (const float*)d_in[17]; p.w_exp_up = (const float*)d_in[18]; p.w_exp_down = (const float*)d_in[19];
    p.ln2_g = (const float*)d_in[20]; p.ln2_b = (const float*)d_in[21];
    p.out = (float*)d_out; p.ws = (unsigned char*)d_ws;
    void* args[] = {&p};
    hipError_t e = hipLaunchCooperativeKernel((void*)mk_forward, dim3(grid_blocks), dim3(512), args, LDS_BYTES, stream);
    if (e != hipSuccess) fprintf(stderr, "kernel_launch: cooperative launch failed: %s (grid %d)\n", hipGetErrorString(e), grid_blocks);
}
```
